# Optimizing an MI355X kernel written in HIP

```python
import jax, jax.numpy as jnp
from jax import lax
import numpy as np

D_MODEL = 1024
BATCH = 8
SEQ = 4096
DEPTH = 1

D_RNN = 512
RNN_BLOCKS = 8
RNN_BLOCK_DIM = D_RNN // RNN_BLOCKS
CONV_WIDTH = 4
LRU_C = 8.0
N_HEADS = 8
N_KV = 2
HPG = N_HEADS // N_KV
HEAD_DIM = 64
D_ATTN = N_HEADS * HEAD_DIM
D_MIX = D_RNN + D_ATTN
KV_W = N_KV * HEAD_DIM
CMP_LEN = 32
CMP_STRIDE = 16
CMP_HIDDEN = 256
SLC_BLK = 64
SLC_TOPN = 16
WIN = 512
WIN_Q_BLK = 128
SLC_Q_BLK = 64
FORCE_SCORE = 1.0e4
ROPE_THETA = 500000.0
ROPE_DIM = HEAD_DIM // 4
D_FF = -(-8 * D_MODEL // (3 * 256)) * 256
EPS = 1e-6
IN_SIZES = (D_RNN, D_RNN, D_ATTN, KV_W, KV_W, KV_W, KV_W, KV_W, KV_W, 3 * N_HEADS)
D_IN = sum(IN_SIZES)
SPLIT_POINTS = tuple(int(v) for v in np.cumsum(IN_SIZES)[:-1])

kernel_name = "hymba_rglru_nsa_hybrid"


def rms_norm(x, w):
    xf = x.astype(jnp.float32)
    y = xf * lax.rsqrt(jnp.mean(xf * xf, axis=-1, keepdims=True) + EPS)
    return (y * w.astype(jnp.float32)).astype(x.dtype)


def partial_rope(x, pos):
    half = ROPE_DIM // 2
    inv_freq = jnp.power(ROPE_THETA, -jnp.arange(half, dtype=jnp.float32) * 2.0 / ROPE_DIM)
    ang = pos.astype(jnp.float32)[..., None] * inv_freq
    cos = jnp.cos(ang)[:, :, None, :]
    sin = jnp.sin(ang)[:, :, None, :]
    xf = x.astype(jnp.float32)
    x1 = xf[..., :half]
    x2 = xf[..., half:ROPE_DIM]
    out = jnp.concatenate([x1 * cos - x2 * sin, x2 * cos + x1 * sin, xf[..., ROPE_DIM:]], axis=-1)
    return out.astype(x.dtype)


def masked_softmax(s, mask):
    s = jnp.where(mask, s.astype(jnp.float32), -jnp.inf)
    m = jnp.max(s, axis=-1, keepdims=True)
    m = jnp.where(jnp.isfinite(m), m, 0.0)
    e = jnp.where(mask, jnp.exp(s - m), 0.0)
    return e / jnp.maximum(jnp.sum(e, axis=-1, keepdims=True), 1e-30)


def block_diag_linear(x, w, b):
    B, T, _ = x.shape
    xb = x.reshape(B, T, RNN_BLOCKS, RNN_BLOCK_DIM)
    return jnp.einsum('btnd,nde->btne', xb, w).reshape(B, T, D_RNN) + b


def lru_combine(c1, c2):
    a1, b1 = c1
    a2, b2 = c2
    return a1 * a2, a2 * b1 + b2


def rglru_mixer(xr, gr, conv_w, conv_b, gate_a_w, gate_a_b, gate_x_w, gate_x_b, lru_lambda):
    T = xr.shape[1]
    xp = jnp.pad(xr, ((0, 0), (CONV_WIDTH - 1, 0), (0, 0)))
    xc = conv_b
    for k in range(CONV_WIDTH):
        xc = xc + conv_w[k] * xp[:, k:k + T]
    r = jax.nn.sigmoid(block_diag_linear(xc, gate_a_w, gate_a_b)).astype(jnp.float32)
    i = jax.nn.sigmoid(block_diag_linear(xc, gate_x_w, gate_x_b))
    log_a = -LRU_C * r * jax.nn.softplus(-lru_lambda.astype(jnp.float32))
    a = jnp.exp(log_a)
    b = jnp.sqrt(-jnp.expm1(2.0 * log_a)) * (i * xc).astype(jnp.float32)
    _, h = lax.associative_scan(lru_combine, (a, b), axis=1)
    return jax.nn.gelu(gr) * h.astype(xr.dtype)


def nsa_mixer(q, kc_tok, vc_tok, ks_tok, vs_tok, kw_tok, vw_tok, gate_logits, positions,
              q_norm_w, k_norm_w, cmp_pos, cmp_k_w1, cmp_k_w2, cmp_v_w1, cmp_v_w2):
    B, T, _ = q.shape
    scale = HEAD_DIM ** -0.5
    t_idx = jnp.arange(T)

    def kv(t):
        return t.reshape(B, T, N_KV, HEAD_DIM)

    q = partial_rope(rms_norm(q.reshape(B, T, N_HEADS, HEAD_DIM), q_norm_w), positions)
    qg = q.reshape(B, T, N_KV, HPG, HEAD_DIM)

    n_cmp = (T - CMP_LEN) // CMP_STRIDE + 1
    cmp_start = jnp.arange(n_cmp) * CMP_STRIDE
    tok_idx = cmp_start[:, None] + jnp.arange(CMP_LEN)[None, :]
    cmp_end = cmp_start + CMP_LEN - 1

    def compress(t, w1, w2):
        blk = t[:, tok_idx] + cmp_pos[None, None, :, None, :]
        blk = blk.transpose(0, 1, 3, 2, 4).reshape(B, n_cmp, N_KV, CMP_LEN * HEAD_DIM)
        return jax.nn.gelu(blk @ w1) @ w2

    kc = partial_rope(rms_norm(compress(kv(kc_tok), cmp_k_w1, cmp_k_w2), k_norm_w), positions[:, cmp_end])
    vc = compress(kv(vc_tok), cmp_v_w1, cmp_v_w2)
    s_c = jnp.einsum('btghd,bcgd->bghtc', qg, kc).astype(jnp.float32) * scale
    p_c = masked_softmax(s_c, cmp_end[None, :] <= t_idx[:, None])
    o_cmp = jnp.einsum('bghtc,bcgd->btghd', p_c.astype(vc.dtype), vc)

    nb = T // SLC_BLK
    blk_start = jnp.arange(nb) * SLC_BLK
    lo = jnp.maximum(cmp_start[:, None], blk_start[None, :])
    hi = jnp.minimum(cmp_start[:, None] + CMP_LEN, blk_start[None, :] + SLC_BLK)
    cover = jnp.clip(hi - lo, 0).astype(jnp.float32) / CMP_LEN
    imp = jnp.einsum('bghtc,cj->bgtj', p_c, cover)
    cur = t_idx // SLC_BLK
    jb = jnp.arange(nb)
    valid_blk = blk_start[None, :] <= t_idx[:, None]
    forced = (jb[None, :] == 0) | (jb[None, :] == cur[:, None]) | (jb[None, :] == cur[:, None] - 1)
    score = jnp.where(forced, FORCE_SCORE, jnp.where(valid_blk, imp, -jnp.inf))
    n_top = min(SLC_TOPN, nb)
    _, sel_idx = lax.top_k(score, n_top)

    ks = partial_rope(rms_norm(kv(ks_tok), k_norm_w), positions)
    kb = ks.transpose(0, 2, 1, 3).reshape(B, N_KV, nb, SLC_BLK, HEAD_DIM)
    vb = kv(vs_tok).transpose(0, 2, 1, 3).reshape(B, N_KV, nb, SLC_BLK, HEAD_DIM)
    nqs = T // SLC_Q_BLK
    q_s = qg.reshape(B, nqs, SLC_Q_BLK, N_KV, HPG, HEAD_DIM).transpose(1, 0, 3, 4, 2, 5)
    i_s = sel_idx.reshape(B, N_KV, nqs, SLC_Q_BLK, n_top).transpose(2, 0, 1, 3, 4)
    t_s = t_idx.reshape(nqs, SLC_Q_BLK)
    b_ix = jnp.arange(B)[:, None, None, None]
    g_ix = jnp.arange(N_KV)[None, :, None, None]

    def sel_step(args):
        qb, ib, tb = args
        kg = kb[b_ix, g_ix, ib]
        vg = vb[b_ix, g_ix, ib]
        s = jnp.einsum('bghqd,bgqnkd->bghqnk', qb, kg).astype(jnp.float32) * scale
        key_pos = ib[..., None] * SLC_BLK + jnp.arange(SLC_BLK)
        mask = (key_pos <= tb[None, None, :, None, None])[:, :, None]
        p = masked_softmax(s.reshape(s.shape[:4] + (-1,)), mask.reshape(mask.shape[:4] + (-1,)))
        p = p.reshape(s.shape)
        return jnp.einsum('bghqnk,bgqnkd->bghqd', p.astype(vg.dtype), vg)

    o_s = lax.map(sel_step, (q_s, i_s, t_s))
    o_slc = o_s.transpose(1, 0, 4, 2, 3, 5).reshape(B, T, N_KV, HPG, HEAD_DIM)

    kw = partial_rope(rms_norm(kv(kw_tok), k_norm_w), positions)
    kwp = jnp.pad(kw.transpose(0, 2, 1, 3), ((0, 0), (0, 0), (WIN, 0), (0, 0)))
    vwp = jnp.pad(kv(vw_tok).transpose(0, 2, 1, 3), ((0, 0), (0, 0), (WIN, 0), (0, 0)))
    nqw = T // WIN_Q_BLK
    q_w = qg.reshape(B, nqw, WIN_Q_BLK, N_KV, HPG, HEAD_DIM).transpose(1, 0, 3, 4, 2, 5)
    starts = jnp.arange(nqw) * WIN_Q_BLK
    span = WIN + WIN_Q_BLK

    def win_step(args):
        qb, start = args
        kblk = lax.dynamic_slice_in_dim(kwp, start, span, axis=2)
        vblk = lax.dynamic_slice_in_dim(vwp, start, span, axis=2)
        s = jnp.einsum('bghqd,bgkd->bghqk', qb, kblk).astype(jnp.float32) * scale
        tq = start + jnp.arange(WIN_Q_BLK)
        sk = start - WIN + jnp.arange(span)
        mask = (sk[None, :] <= tq[:, None]) & (tq[:, None] - sk[None, :] < WIN) & (sk[None, :] >= 0)
        p = masked_softmax(s, mask)
        return jnp.einsum('bghqk,bgkd->bghqd', p.astype(vblk.dtype), vblk)

    o_w = lax.map(win_step, (q_w, starts))
    o_win = o_w.transpose(1, 0, 4, 2, 3, 5).reshape(B, T, N_KV, HPG, HEAD_DIM)

    g = jax.nn.sigmoid(gate_logits.astype(jnp.float32)).reshape(B, T, N_KV, HPG, 3).astype(q.dtype)
    o = g[..., 0:1] * o_cmp + g[..., 1:2] * o_slc + g[..., 2:3] * o_win
    return o.reshape(B, T, D_ATTN)


def setup_inputs(seed: int = 0) -> dict:
    key = jax.random.key(seed)
    ks = jax.random.split(key, 26)
    f32 = jnp.float32
    L = DEPTH

    def nrm(k, shape, scale):
        return jax.random.normal(k, shape, f32) * scale

    def gain(k, shape):
        return 1.0 + 0.01 * jax.random.normal(k, shape, f32)

    offset = jax.random.randint(ks[1], (BATCH, 1), 0, 1024, jnp.int32)
    positions = jnp.arange(SEQ, dtype=jnp.int32)[None, :] + offset
    u = jax.random.uniform(ks[10], (L, D_RNN), f32, 0.9, 0.999)
    s = u ** (1.0 / LRU_C)
    lru_lambda = jnp.log(s) - jnp.log1p(-s)
    return {
        "x": nrm(ks[0], (BATCH, SEQ, D_MODEL), 1.0),
        "positions": positions,
        "attn_norm_w": gain(ks[2], (L, D_MODEL)),
        "w_in": nrm(ks[3], (L, D_MODEL, D_IN), D_MODEL ** -0.5),
        "conv_w": nrm(ks[4], (L, CONV_WIDTH, D_RNN), CONV_WIDTH ** -0.5),
        "conv_b": nrm(ks[5], (L, D_RNN), 0.01),
        "gate_a_w": nrm(ks[6], (L, RNN_BLOCKS, RNN_BLOCK_DIM, RNN_BLOCK_DIM), RNN_BLOCK_DIM ** -0.5),
        "gate_a_b": nrm(ks[7], (L, D_RNN), 0.1),
        "gate_x_w": nrm(ks[8], (L, RNN_BLOCKS, RNN_BLOCK_DIM, RNN_BLOCK_DIM), RNN_BLOCK_DIM ** -0.5),
        "gate_x_b": nrm(ks[9], (L, D_RNN), 0.1),
        "lru_lambda": lru_lambda,
        "q_norm_w": gain(ks[11], (L, HEAD_DIM)),
        "k_norm_w": gain(ks[12], (L, HEAD_DIM)),
        "cmp_pos": nrm(ks[13], (L, CMP_LEN, HEAD_DIM), 0.1),
        "cmp_k_w1": nrm(ks[14], (L, CMP_LEN * HEAD_DIM, CMP_HIDDEN), (CMP_LEN * HEAD_DIM) ** -0.5),
        "cmp_k_w2": nrm(ks[15], (L, CMP_HIDDEN, HEAD_DIM), CMP_HIDDEN ** -0.5),
        "cmp_v_w1": nrm(ks[16], (L, CMP_LEN * HEAD_DIM, CMP_HIDDEN), (CMP_LEN * HEAD_DIM) ** -0.5),
        "cmp_v_w2": nrm(ks[17], (L, CMP_HIDDEN, HEAD_DIM), CMP_HIDDEN ** -0.5),
        "rnn_out_norm_w": gain(ks[18], (L, D_RNN)),
        "attn_out_norm_w": gain(ks[19], (L, D_ATTN)),
        "w_out": nrm(ks[20], (L, D_MIX, D_MODEL), D_MIX ** -0.5),
        "ffn_norm_w": gain(ks[21], (L, D_MODEL)),
        "w_gate": nrm(ks[22], (L, D_MODEL, D_FF), D_MODEL ** -0.5),
        "w_up": nrm(ks[23], (L, D_MODEL, D_FF), D_MODEL ** -0.5),
        "w_down": nrm(ks[24], (L, D_FF, D_MODEL), D_FF ** -0.5),
    }


def reference(x, positions, attn_norm_w, w_in, conv_w, conv_b, gate_a_w, gate_a_b, gate_x_w, gate_x_b,
              lru_lambda, q_norm_w, k_norm_w, cmp_pos, cmp_k_w1, cmp_k_w2, cmp_v_w1, cmp_v_w2,
              rnn_out_norm_w, attn_out_norm_w, w_out, ffn_norm_w, w_gate, w_up, w_down):
    for l in range(DEPTH):
        h = rms_norm(x, attn_norm_w[l])
        proj = h @ w_in[l]
        xr, gr, q, kc, vc, ks, vs, kw, vw, gl = jnp.split(proj, SPLIT_POINTS, axis=-1)
        y_rnn = rglru_mixer(xr, gr, conv_w[l], conv_b[l], gate_a_w[l], gate_a_b[l],
                            gate_x_w[l], gate_x_b[l], lru_lambda[l])
        y_att = nsa_mixer(q, kc, vc, ks, vs, kw, vw, gl, positions, q_norm_w[l], k_norm_w[l],
                          cmp_pos[l], cmp_k_w1[l], cmp_k_w2[l], cmp_v_w1[l], cmp_v_w2[l])
        y = jnp.concatenate([rms_norm(y_rnn, rnn_out_norm_w[l]), rms_norm(y_att, attn_out_norm_w[l])], axis=-1)
        x = x + y @ w_out[l]
        h = rms_norm(x, ffn_norm_w[l])
        x = x + (jax.nn.silu(h @ w_gate[l]) * (h @ w_up[l])) @ w_down[l]
    return x
```

```cpp
#include <hip/hip_runtime.h>
#include <hip/hip_cooperative_groups.h>
#include <cstdio>
#include <cstdint>
namespace cg = cooperative_groups;

typedef _Float16 h16;
typedef _Float16 h16x8 __attribute__((ext_vector_type(8)));
typedef _Float16 h16x4 __attribute__((ext_vector_type(4)));
typedef _Float16 h16x2 __attribute__((ext_vector_type(2)));
typedef float f32x4 __attribute__((ext_vector_type(4)));
typedef float f32x2 __attribute__((ext_vector_type(2)));
typedef unsigned u32x4 __attribute__((ext_vector_type(4)));
typedef unsigned u32x2 __attribute__((ext_vector_type(2)));

constexpr int BATCH = 8, T = 4096, M = BATCH * T, D = 1024;
constexpr int DRNN = 512, NBLK = 8, DATT = 512, NH = 8, NKV = 2, HPG = 4, HD = 64;
constexpr int DIN = 2328, NP1 = 2560;
constexpr int DFF = 2816;
constexpr int NCMP = 255, NCP = 256;
constexpr int CMPK = 2048, CMPH = 256;
constexpr float EPS = 1e-6f;
constexpr float C2 = 0.125f * 1.4426950408889634f;
constexpr int NTHREADS = 512, NWAVES = 8;

constexpr size_t MiB = 1u << 20;
constexpr size_t WS_WIN = 0;
constexpr size_t WS_WOUT = 6 * MiB;
constexpr size_t WS_WGU = 8 * MiB;
constexpr size_t WS_WD = 20 * MiB;
constexpr size_t WS_W1K = 26 * MiB, WS_W1V = 27 * MiB;
constexpr size_t WS_W2K = 28 * MiB, WS_W2V = 28 * MiB + 65536;
constexpr size_t WS_B1 = 28 * MiB + 131072;
constexpr size_t WS_RSTD1 = 29 * MiB;
constexpr size_t WS_RSTD2 = 29 * MiB + 262144;
constexpr size_t WS_ROPE = 30 * MiB;
constexpr size_t WS_XH = 32 * MiB;
constexpr size_t WS_XR = 96 * MiB;
constexpr size_t WS_GRG = 128 * MiB;
constexpr size_t WS_Q = 160 * MiB;
constexpr size_t WS_HL = 192 * MiB;
constexpr size_t WS_HM = 32 * MiB;
constexpr size_t WS_AC = 224 * MiB;
constexpr size_t WS_KCT = 256 * MiB;
constexpr size_t WS_VCT = 265 * MiB;
constexpr size_t WS_KS = 274 * MiB, WS_VS = 282 * MiB, WS_KW = 290 * MiB, WS_VW = 298 * MiB;
constexpr size_t WS_GATE = 306 * MiB;
constexpr size_t WS_H1 = 310 * MiB;
constexpr size_t WS_CRAW = 314 * MiB;
constexpr size_t WS_KCC = 316 * MiB, WS_VCC = 317 * MiB;
constexpr size_t WS_AGG = 318 * MiB;
constexpr size_t WS_SSR = 326 * MiB, WS_SSA = 327 * MiB;
constexpr size_t WS_Y = 328 * MiB;
constexpr size_t WS_X1H = 392 * MiB;
constexpr size_t WS_END = 456 * MiB;

#define LDS_WAIT() asm volatile("s_waitcnt lgkmcnt(0)" ::: "memory")
__device__ __forceinline__ float wave_sum(float v) {
#pragma unroll
    for (int o = 1; o < 64; o <<= 1) v += __shfl_xor(v, o);
    return v;
}
__device__ __forceinline__ float wave_max(float v) {
#pragma unroll
    for (int o = 1; o < 64; o <<= 1) v = fmaxf(v, __shfl_xor(v, o));
    return v;
}
__device__ __forceinline__ float gelu_tanh(float x) {
    const float u = 0.7978845608028654f * (x + 0.044715f * x * x * x);
    return 0.5f * x * (1.0f + tanhf(u));
}
__device__ __forceinline__ float sigmoidf_(float x) { return 1.0f / (1.0f + __expf(-x)); }

struct Params {
    const float* x; const int* pos; const float* attn_norm_w; const float* w_in; const float* conv_w; const float* conv_b;
    const float* gate_a_w; const float* gate_a_b; const float* gate_x_w; const float* gate_x_b; const float* lru_lambda;
    const float* q_norm_w; const float* k_norm_w; const float* cmp_pos; const float* cmp_k_w1; const float* cmp_k_w2;
    const float* cmp_v_w1; const float* cmp_v_w2; const float* rnn_out_norm_w; const float* attn_out_norm_w; const float* w_out;
    const float* ffn_norm_w; const float* w_gate; const float* w_up; const float* w_down;
    float* out; unsigned char* ws; int ph_lo, ph_hi;
};

__device__ __forceinline__ void p0_transpose_item(const float* W, int K, int N, const float* s0, const float* s1, int ksplit,
                                                  h16* WT, int ldt, int mode, int nblk, float* scr, int item, int lane) {
    const int kb = item / nblk, nb = item % nblk, k0 = 64 * kb, n0 = 32 * nb;
#pragma unroll 8
    for (int i = 0; i < 32; ++i) {
        const int kk = 2 * i + (lane >> 5), n = n0 + (lane & 31), k = k0 + kk;
        float v = 0.f;
        if (n < N) { v = W[(size_t)k * N + n]; if (s0) v *= (k < ksplit) ? s0[k] : s1[k - ksplit]; }
        scr[kk * 33 + (lane & 31)] = v;
    }
    LDS_WAIT();
    const int c = lane & 7;
#pragma unroll
    for (int j = 0; j < 4; ++j) {
        const int nl = (lane >> 3) + 8 * j, n = n0 + nl;
        const float* s = scr + (8 * c) * 33 + nl;
        h16x8 o;
#pragma unroll
        for (int e = 0; e < 8; ++e) o[e] = (h16)s[e * 33];
        int orow = n;
        if (mode == 1) orow = (n >> 7) * 256 + (n & 127);
        else if (mode == 2) orow = (n >> 7) * 256 + (n & 127) + 128;
        *(h16x8*)(WT + (size_t)orow * ldt + k0 + 8 * c) = o;
    }
    LDS_WAIT();
}

__device__ __forceinline__ void phase0(const Params& P, unsigned char* lds, int tid, int lane, int wave, int bid, int nb) {
    unsigned char* ws = P.ws;
    float* scr = (float*)lds + wave * (64 * 33);
    const int gw = bid * NWAVES + wave, ngw = nb * NWAVES;
    constexpr int I_IN = 16 * 80, I_OUT = 16 * 32, I_G = 16 * 88, I_U = 16 * 88, I_D = 44 * 32, I_C1 = 32 * 8, I_C2 = 4 * 2;
    constexpr int NIT = I_IN + I_OUT + I_G + I_U + I_D + 2 * I_C1 + 2 * I_C2;
    for (int it = gw; it < NIT; it += ngw) {
        int r = it;
        const float* W; int K, N; const float* s0 = nullptr; const float* s1 = nullptr; int ksplit = 0; size_t wo; int ldt, mode = 0, nblk;
        if (r < I_IN) { W = P.w_in; K = 1024; N = DIN; s0 = P.attn_norm_w; s1 = P.attn_norm_w; ksplit = 1024; wo = WS_WIN; ldt = 1024; nblk = 80; }
        else if ((r -= I_IN) < I_OUT) { W = P.w_out; K = 1024; N = 1024; s0 = P.rnn_out_norm_w; s1 = P.attn_out_norm_w; ksplit = 512; wo = WS_WOUT; ldt = 1024; nblk = 32; }
        else if ((r -= I_OUT) < I_G) { W = P.w_gate; K = 1024; N = DFF; s0 = P.ffn_norm_w; s1 = P.ffn_norm_w; ksplit = 1024; wo = WS_WGU; ldt = 1024; mode = 1; nblk = 88; }
        else if ((r -= I_G) < I_U) { W = P.w_up; K = 1024; N = DFF; s0 = P.ffn_norm_w; s1 = P.ffn_norm_w; ksplit = 1024; wo = WS_WGU; ldt = 1024; mode = 2; nblk = 88; }
        else if ((r -= I_U) < I_D) { W = P.w_down; K = DFF; N = 1024; wo = WS_WD; ldt = DFF; nblk = 32; }
        else if ((r -= I_D) < I_C1) { W = P.cmp_k_w1; K = CMPK; N = CMPH; wo = WS_W1K; ldt = CMPK; nblk = 8; }
        else if ((r -= I_C1) < I_C1) { W = P.cmp_v_w1; K = CMPK; N = CMPH; wo = WS_W1V; ldt = CMPK; nblk = 8; }
        else if ((r -= I_C1) < I_C2) { W = P.cmp_k_w2; K = CMPH; N = HD; wo = WS_W2K; ldt = CMPH; nblk = 2; }
        else { r -= I_C2; W = P.cmp_v_w2; K = CMPH; N = HD; wo = WS_W2V; ldt = CMPH; nblk = 2; }
        p0_transpose_item(W, K, N, s0, s1, ksplit, (h16*)(ws + wo), ldt, mode, nblk, scr, r, lane);
    }
    h16* XH = (h16*)(ws + WS_XH); float* RSTD1 = (float*)(ws + WS_RSTD1);
    for (int m = gw; m < M; m += ngw) {
        const f32x4* xr = (const f32x4*)(P.x + (size_t)m * D) + lane;
        f32x4 v[4]; float s = 0.f;
#pragma unroll
        for (int j = 0; j < 4; ++j) { v[j] = xr[64 * j]; s += (v[j].x * v[j].x + v[j].y * v[j].y) + (v[j].z * v[j].z + v[j].w * v[j].w); }
        s = wave_sum(s);
        if (lane == 0) RSTD1[m] = 1.0f / sqrtf(s * (1.0f / D) + EPS);
        h16x4* o = (h16x4*)(XH + (size_t)m * D) + lane;
#pragma unroll
        for (int j = 0; j < 4; ++j) { h16x4 h; h.x = (h16)v[j].x; h.y = (h16)v[j].y; h.z = (h16)v[j].z; h.w = (h16)v[j].w; o[64 * j] = h; }
    }
    float* ROPE = (float*)(ws + WS_ROPE);
    for (int e = bid * NTHREADS + tid; e < M * 8; e += nb * NTHREADS) {
        const int m = e >> 3, i = e & 7;
        const float inv = (float)pow(500000.0, -(double)i / 8.0);
        const float ang = (float)P.pos[m] * inv;
        ROPE[m * 16 + i] = (float)cos((double)ang);
        ROPE[m * 16 + 8 + i] = (float)sin((double)ang);
    }
    if (bid < 8) {
        const int which = bid >> 2, n = (bid & 3) * 64 + (tid & 63), ks = tid >> 6;
        const float* w1 = which ? P.cmp_v_w1 : P.cmp_k_w1;
        float s = 0.f;
        for (int k = ks * 256; k < ks * 256 + 256; ++k) s += P.cmp_pos[k] * w1[(size_t)k * CMPH + n];
        float* red = (float*)lds + NWAVES * 64 * 33;
        red[ks * 64 + (tid & 63)] = s;
        __syncthreads();
        if (tid < 64) { float a = 0.f; for (int q = 0; q < 8; ++q) a += red[q * 64 + tid]; ((float*)(ws + WS_B1))[which * 256 + (bid & 3) * 64 + tid] = a; }
        __syncthreads();
    }
    if (bid == 8 % nb) {
        h16* kp = (h16*)(ws + WS_KCT) + (size_t)16 * T * 64; h16* vp = (h16*)(ws + WS_VCT) + (size_t)16 * T * 64;
        for (int e = tid; e < 2048; e += NTHREADS) { kp[e] = (h16)0.f; vp[e] = (h16)0.f; }
    }
}

struct GemmN { const h16* A1; int lda1; const h16* B1; int ldb1; int K1; const h16* A2; int lda2; const h16* B2; int ldb2; int K2; int Mr, Nc; int bmap; };
template <bool DUAL, class Epi>
__device__ __forceinline__ void gemm_naive(const GemmN& g, const Epi& epi, int gw, int ngw, int lane) {
    const int tn = g.Nc / 64, tm = g.Mr / 64, ntile = tm * tn;
    const int fr = lane & 15, fq = lane >> 4;
    for (int tile = gw; tile < ntile; tile += ngw) {
        const int tr = tile / tn, tc = tile % tn;
        f32x4 acc1[4][4], acc2[4][4];
#pragma unroll
        for (int i = 0; i < 4; ++i)
#pragma unroll
            for (int j = 0; j < 4; ++j) { acc1[i][j] = (f32x4){0.f, 0.f, 0.f, 0.f}; acc2[i][j] = (f32x4){0.f, 0.f, 0.f, 0.f}; }
        const int bcol = tc * 64 + fr;
        const int brow0 = g.bmap ? ((bcol >> 7) * 256 + (bcol & 127)) : bcol;
        {
            const h16* ap = g.A1 + (size_t)(tr * 64 + fr) * g.lda1 + fq * 8;
            const h16* bp = g.B1 + (size_t)brow0 * g.ldb1 + fq * 8;
            for (int k0 = 0; k0 < g.K1; k0 += 32) {
                h16x8 a[4], b[4];
#pragma unroll
                for (int i = 0; i < 4; ++i) a[i] = *(const h16x8*)(ap + (size_t)i * 16 * g.lda1 + k0);
#pragma unroll
                for (int j = 0; j < 4; ++j) b[j] = *(const h16x8*)(bp + (size_t)j * 16 * g.ldb1 + k0);
#pragma unroll
                for (int i = 0; i < 4; ++i)
#pragma unroll
                    for (int j = 0; j < 4; ++j) acc1[i][j] = __builtin_amdgcn_mfma_f32_16x16x32_f16(a[i], b[j], acc1[i][j], 0, 0, 0);
            }
        }
        if (DUAL) {
            const h16* ap = g.A2 + (size_t)(tr * 64 + fr) * g.lda2 + fq * 8;
            const h16* bp = g.B2 + (size_t)(brow0 + (g.bmap ? 128 : 0)) * g.ldb2 + fq * 8;
            for (int k0 = 0; k0 < g.K2; k0 += 32) {
                h16x8 a[4], b[4];
#pragma unroll
                for (int i = 0; i < 4; ++i) a[i] = *(const h16x8*)(ap + (size_t)i * 16 * g.lda2 + k0);
#pragma unroll
                for (int j = 0; j < 4; ++j) b[j] = *(const h16x8*)(bp + (size_t)j * 16 * g.ldb2 + k0);
#pragma unroll
                for (int i = 0; i < 4; ++i)
#pragma unroll
                    for (int j = 0; j < 4; ++j) acc2[i][j] = __builtin_amdgcn_mfma_f32_16x16x32_f16(a[i], b[j], acc2[i][j], 0, 0, 0);
            }
        }
#pragma unroll
        for (int i = 0; i < 4; ++i)
#pragma unroll
            for (int j = 0; j < 4; ++j)
#pragma unroll
                for (int r = 0; r < 4; ++r) epi(tr * 64 + 16 * i + 4 * fq + r, tc * 64 + 16 * j + fr, acc1[i][j][r], DUAL ? acc2[i][j][r] : 0.f);
    }
}

struct EpiProj {
    unsigned char* ws;
    __device__ __forceinline__ void operator()(int m, int c, float v, float) const {
        v *= ((const float*)(ws + WS_RSTD1))[m];
        if (c < 512) { ((h16*)(ws + WS_XR))[(size_t)m * 512 + c] = (h16)v; return; }
        if (c < 1024) { ((h16*)(ws + WS_GRG))[(size_t)m * 512 + c - 512] = (h16)gelu_tanh(v); return; }
        if (c < 1536) { ((h16*)(ws + WS_Q))[(size_t)m * 512 + c - 1024] = (h16)v; return; }
        if (c < 2304) {
            const int idx = (c - 1536) >> 7, cc = (c - 1536) & 127, g = cc >> 6, d = cc & 63, b = m >> 12, t = m & 4095;
            const size_t off = ((size_t)(b * 2 + g) * T + t) * 64 + d;
            h16* base = (h16*)(ws + (idx == 0 ? WS_KCT : idx == 1 ? WS_VCT : idx == 2 ? WS_KS : idx == 3 ? WS_VS : idx == 4 ? WS_KW : WS_VW));
            base[off] = (h16)v; return;
        }
        if (c < DIN) ((float*)(ws + WS_GATE))[(size_t)m * 24 + c - 2304] = sigmoidf_(v);
    }
};
struct EpiCmpA {
    h16* H1; const float* b1;
    __device__ __forceinline__ void operator()(int r, int c, float v, float) const { H1[(size_t)r * CMPH + c] = (h16)gelu_tanh(v + b1[c]); }
};
struct EpiCmpB {
    float* O;
    __device__ __forceinline__ void operator()(int r, int c, float v, float) const { O[(size_t)r * HD + c] = v; }
};
struct EpiOut {
    const float* x; float* out; h16* x1h; const float* ssr; const float* ssa;
    __device__ __forceinline__ void operator()(int m, int c, float v1, float v2) const {
        float a = 0.f, b = 0.f;
#pragma unroll
        for (int i = 0; i < 8; ++i) { a += ssr[m * 8 + i]; b += ssa[m * 8 + i]; }
        const float s1 = 1.0f / sqrtf(a * (1.0f / 512.0f) + EPS), s2 = 1.0f / sqrtf(b * (1.0f / 512.0f) + EPS);
        const float x1 = x[(size_t)m * D + c] + s1 * v1 + s2 * v2;
        out[(size_t)m * D + c] = x1; x1h[(size_t)m * D + c] = (h16)x1;
    }
};
struct EpiGU {
    h16* hm; const float* rstd2;
    __device__ __forceinline__ void operator()(int m, int c, float vg, float vu) const {
        const float r = rstd2[m], g = vg * r, u = vu * r;
        hm[(size_t)m * DFF + c] = (h16)(g * sigmoidf_(g) * u);
    }
};
struct EpiDown {
    float* out;
    __device__ __forceinline__ void operator()(int m, int c, float v, float) const { out[(size_t)m * D + c] += v; }
};

__device__ __forceinline__ void normrope_rows(const Params& P, int gw, int ngw, int lane) {
    unsigned char* ws = P.ws;
    const float* ROPE = (const float*)(ws + WS_ROPE);
    const int sub = lane & 7;
    for (int m = gw; m < M; m += ngw) {
        const int b = m >> 12, t = m & 4095;
        float cs[8], sn[8];
#pragma unroll
        for (int i = 0; i < 8; ++i) { cs[i] = ROPE[m * 16 + i]; sn[i] = ROPE[m * 16 + 8 + i]; }
#pragma unroll
        for (int which = 0; which < 3; ++which) {
            h16* p; const float* nw; float scale;
            bool act = true;
            if (which == 0) { p = (h16*)(ws + WS_Q) + (size_t)m * 512 + (lane >> 3) * 64 + sub * 8; nw = P.q_norm_w; scale = C2; }
            else { act = lane < 16; const int g = (lane >> 3) & 1; p = (h16*)(ws + (which == 1 ? WS_KS : WS_KW)) + ((size_t)(b * 2 + g) * T + t) * 64 + sub * 8; nw = P.k_norm_w; scale = 1.0f; }
            float v[8]; float ss = 0.f;
            if (act) { const h16x8 h = *(const h16x8*)p;
#pragma unroll
                for (int e = 0; e < 8; ++e) { v[e] = (float)h[e]; ss += v[e] * v[e]; } }
            else {
#pragma unroll
                for (int e = 0; e < 8; ++e) v[e] = 0.f; }
            ss += __shfl_xor(ss, 1); ss += __shfl_xor(ss, 2); ss += __shfl_xor(ss, 4);
            const float rstd = 1.0f / sqrtf(ss * (1.0f / 64.0f) + EPS);
#pragma unroll
            for (int e = 0; e < 8; ++e) v[e] = v[e] * rstd * nw[sub * 8 + e];
            float o[8];
#pragma unroll
            for (int e = 0; e < 8; ++e) {
                const float other = __shfl_xor(v[e], 1);
                if (sub == 0) o[e] = v[e] * cs[e] - other * sn[e];
                else if (sub == 1) o[e] = v[e] * cs[e] + other * sn[e];
                else o[e] = v[e];
            }
            if (act) { h16x8 h;
#pragma unroll
                for (int e = 0; e < 8; ++e) h[e] = (h16)(o[e] * scale);
                *(h16x8*)p = h; }
        }
    }
}

__device__ __forceinline__ void rglru_local(const Params& P, unsigned char* lds, int tid, int lane, int wave, int bid, int nb) {
    unsigned char* ws = P.ws;
    float* WA = (float*)lds;
    float* WX = WA + 4096;
    float* XC = WX + 4096 + wave * 64;
    const h16* XR = (const h16*)(ws + WS_XR);
    h16* HL = (h16*)(ws + WS_HL); h16* AC = (h16*)(ws + WS_AC); float* AGG = (float*)(ws + WS_AGG);
    for (int item = bid; item < 8 * 8 * 32; item += nb) {
        const int n = item & 7, b = (item >> 3) & 7, ck = item >> 6;
        __syncthreads();
        for (int e = tid; e < 4096; e += NTHREADS) { WA[e] = P.gate_a_w[n * 4096 + e]; WX[e] = P.gate_x_w[n * 4096 + e]; }
        __syncthreads();
        const int ch = n * 64 + lane;
        const float cw0 = P.conv_w[0 * 512 + ch], cw1 = P.conv_w[1 * 512 + ch], cw2 = P.conv_w[2 * 512 + ch], cw3 = P.conv_w[3 * 512 + ch], cb = P.conv_b[ch];
        const float ba = P.gate_a_b[ch], bx = P.gate_x_b[ch];
        const float lam = P.lru_lambda[ch];
        const float sp8 = -8.0f * log1pf(expf(-lam));
        const int seg = ck * 8 + wave, t0 = seg * 16;
        const size_t mrow = (size_t)b * T + t0;
        float x0 = (t0 >= 3) ? (float)XR[(mrow - 3) * 512 + ch] : 0.f;
        float x1 = (t0 >= 2) ? (float)XR[(mrow - 2) * 512 + ch] : 0.f;
        float x2 = (t0 >= 1) ? (float)XR[(mrow - 1) * 512 + ch] : 0.f;
        float h = 0.f, Acum = 1.0f;
        for (int tt = 0; tt < 16; ++tt) {
            const float x3 = (float)XR[(mrow + tt) * 512 + ch];
            const float xc = cb + cw0 * x0 + cw1 * x1 + cw2 * x2 + cw3 * x3;
            x0 = x1; x1 = x2; x2 = x3;
            LDS_WAIT();
            XC[lane] = xc;
            LDS_WAIT();
            float sa = ba, sx = bx;
#pragma unroll 16
            for (int d = 0; d < 64; ++d) { const float xd = XC[d]; sa += xd * WA[d * 64 + lane]; sx += xd * WX[d * 64 + lane]; }
            const float r = sigmoidf_(sa), ig = sigmoidf_(sx);
            const float la = sp8 * r;
            const float a = expf(la);
            const float bq = sqrtf(-expm1f(2.0f * la)) * (ig * xc);
            h = a * h + bq; Acum *= a;
            HL[(mrow + tt) * 512 + ch] = (h16)h; AC[(mrow + tt) * 512 + ch] = (h16)Acum;
        }
        float* ag = AGG + (((size_t)(b * 8 + n) * 256 + seg) * 2) * 64;
        ag[lane] = Acum; ag[64 + lane] = h;
    }
}

__device__ __forceinline__ void rglru_fixup(const Params& P, int gw, int ngw, int lane) {
    unsigned char* ws = P.ws;
    const h16* HL = (const h16*)(ws + WS_HL); const h16* AC = (const h16*)(ws + WS_AC); const h16* GRG = (const h16*)(ws + WS_GRG);
    const float* AGG = (const float*)(ws + WS_AGG);
    h16* Y = (h16*)(ws + WS_Y); float* SSR = (float*)(ws + WS_SSR);
    for (int item = gw; item < 8 * 8 * 256; item += ngw) {
        const int n = item & 7, seg = (item >> 3) & 255, b = item >> 11;
        const float* ag = AGG + ((size_t)(b * 8 + n) * 256) * 128;
        float carry = 0.f;
        for (int s = 0; s < seg; ++s) carry = ag[s * 128 + lane] * carry + ag[s * 128 + 64 + lane];
        const int ch = n * 64 + lane;
        const size_t mrow = (size_t)b * T + seg * 16;
        for (int tt = 0; tt < 16; ++tt) {
            const size_t m = mrow + tt;
            const float hv = (float)HL[m * 512 + ch] + (float)AC[m * 512 + ch] * carry;
            const float y = (float)GRG[m * 512 + ch] * hv;
            Y[m * 1024 + ch] = (h16)y;
            const float ss = wave_sum(y * y);
            if (lane == 0) SSR[m * 8 + n] = ss;
        }
    }
}

__device__ __forceinline__ void compress_finish(const Params& P, int gw, int ngw, int lane) {
    unsigned char* ws = P.ws;
    const float* CR = (const float*)(ws + WS_CRAW); const float* ROPE = (const float*)(ws + WS_ROPE);
    h16* KCC = (h16*)(ws + WS_KCC); h16* VCC = (h16*)(ws + WS_VCC);
    for (int r = gw; r < 4096; r += ngw) {
        const int bg = r >> 8, c = r & 255, b = bg >> 1;
        float kv = CR[(size_t)r * 64 + lane], vv = CR[(size_t)(4096 + r) * 64 + lane];
        if (c == 255) { KCC[(size_t)r * 64 + lane] = (h16)0.f; VCC[(size_t)r * 64 + lane] = (h16)0.f; continue; }
        const float ss = wave_sum(kv * kv);
        kv = kv * (1.0f / sqrtf(ss * (1.0f / 64.0f) + EPS)) * P.k_norm_w[lane];
        const int mp = b * T + 16 * c + 31;
        const float other = __shfl_xor(kv, 8);
        float o = kv;
        if (lane < 8) o = kv * ROPE[mp * 16 + lane] - other * ROPE[mp * 16 + 8 + lane];
        else if (lane < 16) o = kv * ROPE[mp * 16 + lane - 8] + other * ROPE[mp * 16 + 8 + lane - 8];
        KCC[(size_t)r * 64 + lane] = (h16)o; VCC[(size_t)r * 64 + lane] = (h16)vv;
    }
}

__device__ __forceinline__ void qk4(const h16* krow, const float* qs, float (&s)[4]) {
    s[0] = s[1] = s[2] = s[3] = 0.f;
#pragma unroll
    for (int c = 0; c < 8; ++c) {
        const h16x8 k8 = *(const h16x8*)(krow + c * 8);
#pragma unroll
        for (int e = 0; e < 8; ++e) { const float kf = (float)k8[e];
#pragma unroll
            for (int h = 0; h < 4; ++h) s[h] += qs[h * 64 + c * 8 + e] * kf; }
    }
}
__device__ __forceinline__ void attn_group(const h16* Kb, const h16* Vb, int key, bool valid, int nk, const float* qs, float* ps,
                                           float (&mx)[4], float (&l)[4], float (&o)[4], int lane) {
    float s[4];
    qk4(Kb + (size_t)(valid ? key : 0) * 64, qs, s);
    float p[4];
#pragma unroll
    for (int h = 0; h < 4; ++h) {
        const float sv = valid ? s[h] : -INFINITY;
        const float mn = fmaxf(mx[h], wave_max(sv));
        const float f = exp2f(mx[h] - mn);
        p[h] = exp2f(sv - mn);
        l[h] = l[h] * f + wave_sum(p[h]); o[h] *= f; mx[h] = mn;
    }
    LDS_WAIT();
    *(f32x4*)(ps + lane * 4) = (f32x4){p[0], p[1], p[2], p[3]};
    LDS_WAIT();
    const int k0 = key - lane;
    for (int kk = 0; kk < nk; ++kk) {
        const float v = (float)Vb[(size_t)(k0 + kk) * 64 + lane];
        const f32x4 pv = *(const f32x4*)(ps + kk * 4);
        o[0] += pv.x * v; o[1] += pv.y * v; o[2] += pv.z * v; o[3] += pv.w * v;
    }
}
__device__ __forceinline__ void attn_naive(const Params& P, unsigned char* lds, int lane, int wave, int gw, int ngw) {
    unsigned char* ws = P.ws;
    float* qs = (float*)lds + wave * (256 + 1024);
    float* ps = qs + 256;
    const h16* QN = (const h16*)(ws + WS_Q);
    const h16* KCC = (const h16*)(ws + WS_KCC); const h16* VCC = (const h16*)(ws + WS_VCC);
    const h16* KS = (const h16*)(ws + WS_KS); const h16* VS = (const h16*)(ws + WS_VS);
    const h16* KW = (const h16*)(ws + WS_KW); const h16* VW = (const h16*)(ws + WS_VW);
    const float* GATE = (const float*)(ws + WS_GATE);
    h16* Y = (h16*)(ws + WS_Y); float* SSA = (float*)(ws + WS_SSA);
    for (int item = gw; item < M * 2; item += ngw) {
        const int g = item & 1, m = item >> 1, b = m >> 12, t = m & 4095, bg = b * 2 + g;
        LDS_WAIT();
#pragma unroll
        for (int h = 0; h < 4; ++h) qs[h * 64 + lane] = (float)QN[(size_t)m * 512 + (4 * g + h) * 64 + lane];
        LDS_WAIT();
        const int nvalid = (t >= 31) ? ((t - 31) >> 4) + 1 : 0;
        float sc[4][4];
#pragma unroll
        for (int i = 0; i < 4; ++i) {
            const int c = lane + 64 * i;
            float s[4]; qk4(KCC + ((size_t)bg * 256 + c) * 64, qs, s);
#pragma unroll
            for (int h = 0; h < 4; ++h) sc[i][h] = (c < nvalid) ? s[h] : -INFINITY;
        }
#pragma unroll
        for (int h = 0; h < 4; ++h) {
            float mxv = fmaxf(fmaxf(sc[0][h], sc[1][h]), fmaxf(sc[2][h], sc[3][h]));
            mxv = wave_max(mxv);
            if (!(mxv > -INFINITY)) mxv = 0.f;
            float ls = 0.f;
#pragma unroll
            for (int i = 0; i < 4; ++i) { sc[i][h] = exp2f(sc[i][h] - mxv); ls += sc[i][h]; }
            ls = wave_sum(ls);
            const float inv = 1.0f / fmaxf(ls, 1e-30f);
#pragma unroll
            for (int i = 0; i < 4; ++i) sc[i][h] *= inv;
        }
#pragma unroll
        for (int i = 0; i < 4; ++i) *(f32x4*)(ps + (lane + 64 * i) * 4) = (f32x4){sc[i][0], sc[i][1], sc[i][2], sc[i][3]};
        LDS_WAIT();
        float ocmp[4] = {0.f, 0.f, 0.f, 0.f};
        for (int c = 0; c < nvalid; ++c) {
            const float v = (float)VCC[((size_t)bg * 256 + c) * 64 + lane];
            const f32x4 pv = *(const f32x4*)(ps + c * 4);
            ocmp[0] += pv.x * v; ocmp[1] += pv.y * v; ocmp[2] += pv.z * v; ocmp[3] += pv.w * v;
        }
        float imp = 0.f;
        {
#pragma unroll
            for (int e = 0; e < 4; ++e) { const f32x4 pv = *(const f32x4*)(ps + (4 * lane + e) * 4); const float sh = (pv.x + pv.y) + (pv.z + pv.w); imp += (e == 3) ? 0.5f * sh : sh; }
            if (lane >= 1) { const f32x4 pv = *(const f32x4*)(ps + (4 * lane - 1) * 4); imp += 0.5f * ((pv.x + pv.y) + (pv.z + pv.w)); }
        }
        const int cur = t >> 6;
        const bool forced = (lane == 0) || (lane == cur) || (lane == cur - 1);
        const bool cand = !forced && lane < cur - 1;
        const int quota = 16 - (1 + (cur >= 1 ? 1 : 0) + (cur >= 2 ? 1 : 0));
        int rank = 0;
        for (int j2 = 0; j2 < 64; ++j2) {
            const float io = __shfl(imp, j2); const int co = __shfl((int)cand, j2);
            if (co && (io > imp || (io == imp && j2 < lane))) ++rank;
        }
        const bool sel = forced || (cand && rank < quota);
        unsigned long long mask = __ballot(sel);
        float mx[4] = {-INFINITY, -INFINITY, -INFINITY, -INFINITY}, ls[4] = {0.f, 0.f, 0.f, 0.f}, os[4] = {0.f, 0.f, 0.f, 0.f};
        while (mask) {
            const int j = __builtin_ctzll(mask); mask &= mask - 1;
            const int key = 64 * j + lane; const int nk = min(64, t - 64 * j + 1);
            attn_group(KS + (size_t)bg * T * 64, VS + (size_t)bg * T * 64, key, key <= t, nk, qs, ps, mx, ls, os, lane);
        }
        float mw[4] = {-INFINITY, -INFINITY, -INFINITY, -INFINITY}, lw[4] = {0.f, 0.f, 0.f, 0.f}, ow[4] = {0.f, 0.f, 0.f, 0.f};
        for (int k0 = max(0, t - 511); k0 <= t; k0 += 64) {
            const int key = k0 + lane; const int nk = min(64, t - k0 + 1);
            attn_group(KW + (size_t)bg * T * 64, VW + (size_t)bg * T * 64, key, key <= t, nk, qs, ps, mw, lw, ow, lane);
        }
#pragma unroll
        for (int h = 0; h < 4; ++h) {
            const float* gp = GATE + (size_t)m * 24 + (4 * g + h) * 3;
            const float o = gp[0] * ocmp[h] + gp[1] * os[h] / ls[h] + gp[2] * ow[h] / lw[h];
            Y[(size_t)m * 1024 + 512 + (4 * g + h) * 64 + lane] = (h16)o;
            const float ss = wave_sum(o * o);
            if (lane == 0) SSA[m * 8 + 4 * g + h] = ss;
        }
    }
}

#ifndef PHMASK
#define PHMASK 0x3ff
#endif
constexpr int NPHASE = 10;
constexpr int LDS_BYTES = 81920;
__global__ void __launch_bounds__(NTHREADS, 2) hymba_fwd(Params P) {
    extern __shared__ __attribute__((aligned(16))) unsigned char lds[];
    cg::grid_group grid = cg::this_grid();
    const int tid = threadIdx.x, lane = tid & 63, wave = __builtin_amdgcn_readfirstlane(tid >> 6);
    const int bid = blockIdx.x, nb = gridDim.x;
    const int gw = bid * NWAVES + wave, ngw = nb * NWAVES;
    unsigned char* ws = P.ws;
    const int lo = P.ph_lo, hi = P.ph_hi;
#define PH_BEGIN(k) if (lo <= (k) && (k) < hi) { if ((k) > lo) grid.sync();
#define PH_END }
#if PHMASK & (1 << 0)
        PH_BEGIN(0) phase0(P, lds, tid, lane, wave, bid, nb); PH_END
#endif
#if PHMASK & (1 << 1)
        PH_BEGIN(1) {
            GemmN g{(const h16*)(ws + WS_XH), 1024, (const h16*)(ws + WS_WIN), 1024, 1024, nullptr, 0, nullptr, 0, 0, M, NP1, 0};
            gemm_naive<false>(g, EpiProj{ws}, gw, ngw, lane);
        } PH_END
#endif
#if PHMASK & (1 << 2)
        PH_BEGIN(2) {
            normrope_rows(P, gw, ngw, lane);
            rglru_local(P, lds, tid, lane, wave, bid, nb);
            for (int w = 0; w < 2; ++w) {
                GemmN g{(const h16*)(ws + (w ? WS_VCT : WS_KCT)), 1024, (const h16*)(ws + (w ? WS_W1V : WS_W1K)), CMPK, CMPK, nullptr, 0, nullptr, 0, 0, 4096, CMPH, 0};
                gemm_naive<false>(g, EpiCmpA{(h16*)(ws + WS_H1) + (size_t)w * 4096 * CMPH, (const float*)(ws + WS_B1) + w * 256}, gw, ngw, lane);
            }
        } PH_END
#endif
#if PHMASK & (1 << 3)
        PH_BEGIN(3) {
            for (int w = 0; w < 2; ++w) {
                GemmN g{(const h16*)(ws + WS_H1) + (size_t)w * 4096 * CMPH, CMPH, (const h16*)(ws + (w ? WS_W2V : WS_W2K)), CMPH, CMPH, nullptr, 0, nullptr, 0, 0, 4096, HD, 0};
                gemm_naive<false>(g, EpiCmpB{(float*)(ws + WS_CRAW) + (size_t)w * 4096 * HD}, gw, ngw, lane);
            }
        } PH_END
#endif
#if PHMASK & (1 << 4)
        PH_BEGIN(4) compress_finish(P, gw, ngw, lane); PH_END
#endif
#if PHMASK & (1 << 5)
        PH_BEGIN(5) {
            rglru_fixup(P, gw, ngw, lane);
            attn_naive(P, lds, lane, wave, gw, ngw);
        } PH_END
#endif
#if PHMASK & (1 << 6)
        PH_BEGIN(6) {
            const h16* Y = (const h16*)(ws + WS_Y); const h16* W = (const h16*)(ws + WS_WOUT);
            GemmN g{Y, 1024, W, 1024, 512, Y + 512, 1024, W + 512, 1024, 512, M, D, 0};
            gemm_naive<true>(g, EpiOut{P.x, P.out, (h16*)(ws + WS_X1H), (const float*)(ws + WS_SSR), (const float*)(ws + WS_SSA)}, gw, ngw, lane);
        } PH_END
#endif
#if PHMASK & (1 << 7)
        PH_BEGIN(7) {
            float* RSTD2 = (float*)(ws + WS_RSTD2);
            for (int m = gw; m < M; m += ngw) {
                const f32x4* xr = (const f32x4*)(P.out + (size_t)m * D) + lane; float s = 0.f;
#pragma unroll
                for (int j = 0; j < 4; ++j) { const f32x4 v = xr[64 * j]; s += (v.x * v.x + v.y * v.y) + (v.z * v.z + v.w * v.w); }
                s = wave_sum(s);
                if (lane == 0) RSTD2[m] = 1.0f / sqrtf(s * (1.0f / D) + EPS);
            }
        } PH_END
#endif
#if PHMASK & (1 << 8)
        PH_BEGIN(8) {
            const h16* A = (const h16*)(ws + WS_X1H); const h16* W = (const h16*)(ws + WS_WGU);
            GemmN g{A, 1024, W, 1024, 1024, A, 1024, W, 1024, 1024, M, DFF, 1};
            gemm_naive<true>(g, EpiGU{(h16*)(ws + WS_HM), (const float*)(ws + WS_RSTD2)}, gw, ngw, lane);
        } PH_END
#endif
#if PHMASK & (1 << 9)
        PH_BEGIN(9) {
            GemmN g{(const h16*)(ws + WS_HM), DFF, (const h16*)(ws + WS_WD), DFF, DFF, nullptr, 0, nullptr, 0, 0, M, D, 0};
            gemm_naive<false>(g, EpiDown{P.out}, gw, ngw, lane);
        } PH_END
#endif
}

#ifndef N_LAUNCH_PER_PHASE
#define N_LAUNCH_PER_PHASE 1
#endif
extern "C" void kernel_launch(void* const* d_in, const int* in_sizes, int n_in, void* d_out, int out_size, void* d_ws, size_t ws_size, hipStream_t stream) {
    static int grid = 0;
    if (grid == 0) {
        if (n_in != 25 || in_sizes[0] != M * D || out_size != M * D || ws_size < WS_END) {
            fprintf(stderr, "kernel_launch: unexpected problem (n_in %d, in0 %d, out %d, ws %zu)\n", n_in, n_in > 0 ? in_sizes[0] : -1, out_size, ws_size); grid = -1; return; }
        int dev = 0, cus = 0, per_cu = 0;
        hipGetDevice(&dev);
        hipDeviceGetAttribute(&cus, hipDeviceAttributeMultiprocessorCount, dev);
        hipFuncSetAttribute((const void*)hymba_fwd, hipFuncAttributeMaxDynamicSharedMemorySize, LDS_BYTES);
        hipOccupancyMaxActiveBlocksPerMultiprocessor(&per_cu, (const void*)hymba_fwd, NTHREADS, LDS_BYTES);
        if (per_cu < 1) { fprintf(stderr, "kernel_launch: occupancy query says %d blocks per CU\n", per_cu); grid = -1; return; }
        grid = cus;
    }
    if (grid < 0) return;
    Params p{};
    const float** pf = (const float**)&p;
    for (int i = 0; i < 25; ++i) pf[i] = (const float*)d_in[i];
    p.out = (float*)d_out; p.ws = (unsigned char*)d_ws;
#if N_LAUNCH_PER_PHASE
    for (int ph = 0; ph < NPHASE; ++ph) {
        p.ph_lo = ph; p.ph_hi = ph + 1;
        void* args[] = {&p};
        hipError_t e = hipLaunchCooperativeKernel((const void*)hymba_fwd, dim3(grid), dim3(NTHREADS), args, LDS_BYTES, stream);
        if (e != hipSuccess) { fprintf(stderr, "launch failed: %s\n", hipGetErrorString(e)); return; }
    }
#else
    p.ph_lo = 0; p.ph_hi = NPHASE;
    void* args[] = {&p};
    hipError_t e = hipLaunchCooperativeKernel((const void*)hymba_fwd, dim3(grid), dim3(NTHREADS), args, LDS_BYTES, stream);
    if (e != hipSuccess) fprintf(stderr, "launch failed: %s\n", hipGetErrorString(e));
#endif
}
```

```cpp
#include <hip/hip_runtime.h>
#include <hip/hip_cooperative_groups.h>
#include <cstdio>
#include <cstdint>
namespace cg = cooperative_groups;

typedef _Float16 h16;
typedef _Float16 h16x8 __attribute__((ext_vector_type(8)));
typedef _Float16 h16x4 __attribute__((ext_vector_type(4)));
typedef _Float16 h16x2 __attribute__((ext_vector_type(2)));
typedef float f32x4 __attribute__((ext_vector_type(4)));
typedef float f32x2 __attribute__((ext_vector_type(2)));
typedef unsigned u32x4 __attribute__((ext_vector_type(4)));
typedef unsigned u32x2 __attribute__((ext_vector_type(2)));

constexpr int BATCH = 8, T = 4096, M = BATCH * T, D = 1024;
constexpr int DRNN = 512, NBLK = 8, DATT = 512, NH = 8, NKV = 2, HPG = 4, HD = 64;
constexpr int DIN = 2328, NP1 = 2560;
constexpr int DFF = 2816;
constexpr int NCMP = 255, NCP = 256;
constexpr int CMPK = 2048, CMPH = 256;
constexpr float EPS = 1e-6f;
constexpr float C2 = 0.125f * 1.4426950408889634f;
constexpr int NTHREADS = 512, NWAVES = 8;

constexpr size_t MiB = 1u << 20;
constexpr size_t WS_WIN = 0;
constexpr size_t WS_WOUT = 6 * MiB;
constexpr size_t WS_WGU = 8 * MiB;
constexpr size_t WS_WD = 20 * MiB;
constexpr size_t WS_W1K = 26 * MiB, WS_W1V = 27 * MiB;
constexpr size_t WS_W2K = 28 * MiB, WS_W2V = 28 * MiB + 65536;
constexpr size_t WS_B1 = 28 * MiB + 131072;
constexpr size_t WS_RSTD1 = 29 * MiB;
constexpr size_t WS_RSTD2 = 29 * MiB + 262144;
constexpr size_t WS_ROPE = 30 * MiB;
constexpr size_t WS_XH = 32 * MiB;
constexpr size_t WS_XR = 96 * MiB;
constexpr size_t WS_GRG = 128 * MiB;
constexpr size_t WS_Q = 160 * MiB;
constexpr size_t WS_HL = 192 * MiB;
constexpr size_t WS_HM = 32 * MiB;
constexpr size_t WS_AC = 224 * MiB;
constexpr size_t WS_KCT = 256 * MiB;
constexpr size_t WS_VCT = 265 * MiB;
constexpr size_t WS_KS = 274 * MiB, WS_VS = 282 * MiB, WS_KW = 290 * MiB, WS_VW = 298 * MiB;
constexpr size_t WS_GATE = 306 * MiB;
constexpr size_t WS_H1 = 310 * MiB;
constexpr size_t WS_CRAW = 314 * MiB;
constexpr size_t WS_KCC = 316 * MiB, WS_VCC = 317 * MiB;
constexpr size_t WS_AGG = 318 * MiB;
constexpr size_t WS_SSR = 326 * MiB, WS_SSA = 327 * MiB;
constexpr size_t WS_Y = 328 * MiB;
constexpr size_t WS_X1H = 392 * MiB;
constexpr size_t WS_END = 456 * MiB;

#define LDS_WAIT() asm volatile("s_waitcnt lgkmcnt(0)" ::: "memory")
__device__ __forceinline__ float wave_sum(float v) {
#pragma unroll
    for (int o = 1; o < 64; o <<= 1) v += __shfl_xor(v, o);
    return v;
}
__device__ __forceinline__ float wave_max(float v) {
#pragma unroll
    for (int o = 1; o < 64; o <<= 1) v = fmaxf(v, __shfl_xor(v, o));
    return v;
}
__device__ __forceinline__ float gelu_tanh(float x) {
    const float u = 0.7978845608028654f * (x + 0.044715f * x * x * x);
    return 0.5f * x * (1.0f + tanhf(u));
}
__device__ __forceinline__ float sigmoidf_(float x) { return 1.0f / (1.0f + __expf(-x)); }

struct Params {
    const float* x; const int* pos; const float* attn_norm_w; const float* w_in; const float* conv_w; const float* conv_b;
    const float* gate_a_w; const float* gate_a_b; const float* gate_x_w; const float* gate_x_b; const float* lru_lambda;
    const float* q_norm_w; const float* k_norm_w; const float* cmp_pos; const float* cmp_k_w1; const float* cmp_k_w2;
    const float* cmp_v_w1; const float* cmp_v_w2; const float* rnn_out_norm_w; const float* attn_out_norm_w; const float* w_out;
    const float* ffn_norm_w; const float* w_gate; const float* w_up; const float* w_down;
    float* out; unsigned char* ws; int ph_lo, ph_hi;
};

__device__ __forceinline__ void p0_transpose_item(const float* W, int K, int N, const float* s0, const float* s1, int ksplit,
                                                  h16* WT, int ldt, int mode, int nblk, float* scr, int item, int lane) {
    const int kb = item / nblk, nb = item % nblk, k0 = 64 * kb, n0 = 32 * nb;
#pragma unroll 8
    for (int i = 0; i < 32; ++i) {
        const int kk = 2 * i + (lane >> 5), n = n0 + (lane & 31), k = k0 + kk;
        float v = 0.f;
        if (n < N) { v = W[(size_t)k * N + n]; if (s0) v *= (k < ksplit) ? s0[k] : s1[k - ksplit]; }
        scr[kk * 33 + (lane & 31)] = v;
    }
    LDS_WAIT();
    const int c = lane & 7;
#pragma unroll
    for (int j = 0; j < 4; ++j) {
        const int nl = (lane >> 3) + 8 * j, n = n0 + nl;
        const float* s = scr + (8 * c) * 33 + nl;
        h16x8 o;
#pragma unroll
        for (int e = 0; e < 8; ++e) o[e] = (h16)s[e * 33];
        int orow = n;
        if (mode == 1) orow = (n >> 7) * 256 + (n & 127);
        else if (mode == 2) orow = (n >> 7) * 256 + (n & 127) + 128;
        *(h16x8*)(WT + (size_t)orow * ldt + k0 + 8 * c) = o;
    }
    LDS_WAIT();
}

__device__ __forceinline__ void phase0(const Params& P, unsigned char* lds, int tid, int lane, int wave, int bid, int nb) {
    unsigned char* ws = P.ws;
    float* scr = (float*)lds + wave * (64 * 33);
    const int gw = bid * NWAVES + wave, ngw = nb * NWAVES;
    constexpr int I_IN = 16 * 80, I_OUT = 16 * 32, I_G = 16 * 88, I_U = 16 * 88, I_D = 44 * 32, I_C1 = 32 * 8, I_C2 = 4 * 2;
    constexpr int NIT = I_IN + I_OUT + I_G + I_U + I_D + 2 * I_C1 + 2 * I_C2;
    for (int it = gw; it < NIT; it += ngw) {
        int r = it;
        const float* W; int K, N; const float* s0 = nullptr; const float* s1 = nullptr; int ksplit = 0; size_t wo; int ldt, mode = 0, nblk;
        if (r < I_IN) { W = P.w_in; K = 1024; N = DIN; s0 = P.attn_norm_w; s1 = P.attn_norm_w; ksplit = 1024; wo = WS_WIN; ldt = 1024; nblk = 80; }
        else if ((r -= I_IN) < I_OUT) { W = P.w_out; K = 1024; N = 1024; s0 = P.rnn_out_norm_w; s1 = P.attn_out_norm_w; ksplit = 512; wo = WS_WOUT; ldt = 1024; nblk = 32; }
        else if ((r -= I_OUT) < I_G) { W = P.w_gate; K = 1024; N = DFF; s0 = P.ffn_norm_w; s1 = P.ffn_norm_w; ksplit = 1024; wo = WS_WGU; ldt = 1024; mode = 1; nblk = 88; }
        else if ((r -= I_G) < I_U) { W = P.w_up; K = 1024; N = DFF; s0 = P.ffn_norm_w; s1 = P.ffn_norm_w; ksplit = 1024; wo = WS_WGU; ldt = 1024; mode = 2; nblk = 88; }
        else if ((r -= I_U) < I_D) { W = P.w_down; K = DFF; N = 1024; wo = WS_WD; ldt = DFF; nblk = 32; }
        else if ((r -= I_D) < I_C1) { W = P.cmp_k_w1; K = CMPK; N = CMPH; wo = WS_W1K; ldt = CMPK; nblk = 8; }
        else if ((r -= I_C1) < I_C1) { W = P.cmp_v_w1; K = CMPK; N = CMPH; wo = WS_W1V; ldt = CMPK; nblk = 8; }
        else if ((r -= I_C1) < I_C2) { W = P.cmp_k_w2; K = CMPH; N = HD; wo = WS_W2K; ldt = CMPH; nblk = 2; }
        else { r -= I_C2; W = P.cmp_v_w2; K = CMPH; N = HD; wo = WS_W2V; ldt = CMPH; nblk = 2; }
        p0_transpose_item(W, K, N, s0, s1, ksplit, (h16*)(ws + wo), ldt, mode, nblk, scr, r, lane);
    }
    h16* XH = (h16*)(ws + WS_XH); float* RSTD1 = (float*)(ws + WS_RSTD1);
    for (int m = gw; m < M; m += ngw) {
        const f32x4* xr = (const f32x4*)(P.x + (size_t)m * D) + lane;
        f32x4 v[4]; float s = 0.f;
#pragma unroll
        for (int j = 0; j < 4; ++j) { v[j] = xr[64 * j]; s += (v[j].x * v[j].x + v[j].y * v[j].y) + (v[j].z * v[j].z + v[j].w * v[j].w); }
        s = wave_sum(s);
        if (lane == 0) RSTD1[m] = 1.0f / sqrtf(s * (1.0f / D) + EPS);
        h16x4* o = (h16x4*)(XH + (size_t)m * D) + lane;
#pragma unroll
        for (int j = 0; j < 4; ++j) { h16x4 h; h.x = (h16)v[j].x; h.y = (h16)v[j].y; h.z = (h16)v[j].z; h.w = (h16)v[j].w; o[64 * j] = h; }
    }
    float* ROPE = (float*)(ws + WS_ROPE);
    for (int e = bid * NTHREADS + tid; e < M * 8; e += nb * NTHREADS) {
        const int m = e >> 3, i = e & 7;
        const float inv = (float)pow(500000.0, -(double)i / 8.0);
        const float ang = (float)P.pos[m] * inv;
        ROPE[m * 16 + i] = (float)cos((double)ang);
        ROPE[m * 16 + 8 + i] = (float)sin((double)ang);
    }
    if (bid < 8) {
        const int which = bid >> 2, n = (bid & 3) * 64 + (tid & 63), ks = tid >> 6;
        const float* w1 = which ? P.cmp_v_w1 : P.cmp_k_w1;
        float s = 0.f;
        for (int k = ks * 256; k < ks * 256 + 256; ++k) s += P.cmp_pos[k] * w1[(size_t)k * CMPH + n];
        float* red = (float*)lds + NWAVES * 64 * 33;
        red[ks * 64 + (tid & 63)] = s;
        __syncthreads();
        if (tid < 64) { float a = 0.f; for (int q = 0; q < 8; ++q) a += red[q * 64 + tid]; ((float*)(ws + WS_B1))[which * 256 + (bid & 3) * 64 + tid] = a; }
        __syncthreads();
    }
    if (bid == 8 % nb) {
        h16* kp = (h16*)(ws + WS_KCT) + (size_t)16 * T * 64; h16* vp = (h16*)(ws + WS_VCT) + (size_t)16 * T * 64;
        for (int e = tid; e < 2048; e += NTHREADS) { kp[e] = (h16)0.f; vp[e] = (h16)0.f; }
    }
}

struct GemmN { const h16* A1; int lda1; const h16* B1; int ldb1; int K1; const h16* A2; int lda2; const h16* B2; int ldb2; int K2; int Mr, Nc; int bmap; };
template <bool DUAL, class Epi>
__device__ __forceinline__ void gemm_naive(const GemmN& g, const Epi& epi, int gw, int ngw, int lane) {
    const int tn = g.Nc / 64, tm = g.Mr / 64, ntile = tm * tn;
    const int fr = lane & 15, fq = lane >> 4;
    for (int tile = gw; tile < ntile; tile += ngw) {
        const int tr = tile / tn, tc = tile % tn;
        f32x4 acc1[4][4], acc2[4][4];
#pragma unroll
        for (int i = 0; i < 4; ++i)
#pragma unroll
            for (int j = 0; j < 4; ++j) { acc1[i][j] = (f32x4){0.f, 0.f, 0.f, 0.f}; acc2[i][j] = (f32x4){0.f, 0.f, 0.f, 0.f}; }
        const int bcol = tc * 64 + fr;
        const int brow0 = g.bmap ? ((bcol >> 7) * 256 + (bcol & 127)) : bcol;
        {
            const h16* ap = g.A1 + (size_t)(tr * 64 + fr) * g.lda1 + fq * 8;
            const h16* bp = g.B1 + (size_t)brow0 * g.ldb1 + fq * 8;
            for (int k0 = 0; k0 < g.K1; k0 += 32) {
                h16x8 a[4], b[4];
#pragma unroll
                for (int i = 0; i < 4; ++i) a[i] = *(const h16x8*)(ap + (size_t)i * 16 * g.lda1 + k0);
#pragma unroll
                for (int j = 0; j < 4; ++j) b[j] = *(const h16x8*)(bp + (size_t)j * 16 * g.ldb1 + k0);
#pragma unroll
                for (int i = 0; i < 4; ++i)
#pragma unroll
                    for (int j = 0; j < 4; ++j) acc1[i][j] = __builtin_amdgcn_mfma_f32_16x16x32_f16(a[i], b[j], acc1[i][j], 0, 0, 0);
            }
        }
        if (DUAL) {
            const h16* ap = g.A2 + (size_t)(tr * 64 + fr) * g.lda2 + fq * 8;
            const h16* bp = g.B2 + (size_t)(brow0 + (g.bmap ? 128 : 0)) * g.ldb2 + fq * 8;
            for (int k0 = 0; k0 < g.K2; k0 += 32) {
                h16x8 a[4], b[4];
#pragma unroll
                for (int i = 0; i < 4; ++i) a[i] = *(const h16x8*)(ap + (size_t)i * 16 * g.lda2 + k0);
#pragma unroll
                for (int j = 0; j < 4; ++j) b[j] = *(const h16x8*)(bp + (size_t)j * 16 * g.ldb2 + k0);
#pragma unroll
                for (int i = 0; i < 4; ++i)
#pragma unroll
                    for (int j = 0; j < 4; ++j) acc2[i][j] = __builtin_amdgcn_mfma_f32_16x16x32_f16(a[i], b[j], acc2[i][j], 0, 0, 0);
            }
        }
#pragma unroll
        for (int i = 0; i < 4; ++i)
#pragma unroll
            for (int j = 0; j < 4; ++j)
#pragma unroll
                for (int r = 0; r < 4; ++r) epi(tr * 64 + 16 * i + 4 * fq + r, tc * 64 + 16 * j + fr, acc1[i][j][r], DUAL ? acc2[i][j][r] : 0.f);
    }
}

struct EpiProj {
    unsigned char* ws;
    __device__ __forceinline__ void operator()(int m, int c, float v, float) const {
        v *= ((const float*)(ws + WS_RSTD1))[m];
        if (c < 512) { ((h16*)(ws + WS_XR))[(size_t)m * 512 + c] = (h16)v; return; }
        if (c < 1024) { ((h16*)(ws + WS_GRG))[(size_t)m * 512 + c - 512] = (h16)gelu_tanh(v); return; }
        if (c < 1536) { ((h16*)(ws + WS_Q))[(size_t)m * 512 + c - 1024] = (h16)v; return; }
        if (c < 2304) {
            const int idx = (c - 1536) >> 7, cc = (c - 1536) & 127, g = cc >> 6, d = cc & 63, b = m >> 12, t = m & 4095;
            const size_t off = ((size_t)(b * 2 + g) * T + t) * 64 + d;
            h16* base = (h16*)(ws + (idx == 0 ? WS_KCT : idx == 1 ? WS_VCT : idx == 2 ? WS_KS : idx == 3 ? WS_VS : idx == 4 ? WS_KW : WS_VW));
            base[off] = (h16)v; return;
        }
        if (c < DIN) ((float*)(ws + WS_GATE))[(size_t)m * 24 + c - 2304] = sigmoidf_(v);
    }
};
struct EpiCmpA {
    h16* H1; const float* b1;
    __device__ __forceinline__ void operator()(int r, int c, float v, float) const { H1[(size_t)r * CMPH + c] = (h16)gelu_tanh(v + b1[c]); }
};
struct EpiCmpB {
    float* O;
    __device__ __forceinline__ void operator()(int r, int c, float v, float) const { O[(size_t)r * HD + c] = v; }
};
struct EpiOut {
    const float* x; float* out; h16* x1h; const float* ssr; const float* ssa;
    __device__ __forceinline__ void operator()(int m, int c, float v1, float v2) const {
        float a = 0.f, b = 0.f;
#pragma unroll
        for (int i = 0; i < 8; ++i) { a += ssr[m * 8 + i]; b += ssa[m * 8 + i]; }
        const float s1 = 1.0f / sqrtf(a * (1.0f / 512.0f) + EPS), s2 = 1.0f / sqrtf(b * (1.0f / 512.0f) + EPS);
        const float x1 = x[(size_t)m * D + c] + s1 * v1 + s2 * v2;
        out[(size_t)m * D + c] = x1; x1h[(size_t)m * D + c] = (h16)x1;
    }
};
struct EpiGU {
    h16* hm; const float* rstd2;
    __device__ __forceinline__ void operator()(int m, int c, float vg, float vu) const {
        const float r = rstd2[m], g = vg * r, u = vu * r;
        hm[(size_t)m * DFF + c] = (h16)(g * sigmoidf_(g) * u);
    }
};
struct EpiDown {
    float* out;
    __device__ __forceinline__ void operator()(int m, int c, float v, float) const { out[(size_t)m * D + c] += v; }
};

__device__ __forceinline__ void normrope_rows(const Params& P, int gw, int ngw, int lane) {
    unsigned char* ws = P.ws;
    const float* ROPE = (const float*)(ws + WS_ROPE);
    const int sub = lane & 7;
    for (int m = gw; m < M; m += ngw) {
        const int b = m >> 12, t = m & 4095;
        float cs[8], sn[8];
#pragma unroll
        for (int i = 0; i < 8; ++i) { cs[i] = ROPE[m * 16 + i]; sn[i] = ROPE[m * 16 + 8 + i]; }
#pragma unroll
        for (int which = 0; which < 3; ++which) {
            h16* p; const float* nw; float scale;
            bool act = true;
            if (which == 0) { p = (h16*)(ws + WS_Q) + (size_t)m * 512 + (lane >> 3) * 64 + sub * 8; nw = P.q_norm_w; scale = C2; }
            else { act = lane < 16; const int g = (lane >> 3) & 1; p = (h16*)(ws + (which == 1 ? WS_KS : WS_KW)) + ((size_t)(b * 2 + g) * T + t) * 64 + sub * 8; nw = P.k_norm_w; scale = 1.0f; }
            float v[8]; float ss = 0.f;
            if (act) { const h16x8 h = *(const h16x8*)p;
#pragma unroll
                for (int e = 0; e < 8; ++e) { v[e] = (float)h[e]; ss += v[e] * v[e]; } }
            else {
#pragma unroll
                for (int e = 0; e < 8; ++e) v[e] = 0.f; }
            ss += __shfl_xor(ss, 1); ss += __shfl_xor(ss, 2); ss += __shfl_xor(ss, 4);
            const float rstd = 1.0f / sqrtf(ss * (1.0f / 64.0f) + EPS);
#pragma unroll
            for (int e = 0; e < 8; ++e) v[e] = v[e] * rstd * nw[sub * 8 + e];
            float o[8];
#pragma unroll
            for (int e = 0; e < 8; ++e) {
                const float other = __shfl_xor(v[e], 1);
                if (sub == 0) o[e] = v[e] * cs[e] - other * sn[e];
                else if (sub == 1) o[e] = v[e] * cs[e] + other * sn[e];
                else o[e] = v[e];
            }
            if (act) { h16x8 h;
#pragma unroll
                for (int e = 0; e < 8; ++e) h[e] = (h16)(o[e] * scale);
                *(h16x8*)p = h; }
        }
    }
}

__device__ __forceinline__ void rglru_local(const Params& P, unsigned char* lds, int tid, int lane, int wave, int bid, int nb) {
    unsigned char* ws = P.ws;
    float* WA = (float*)lds;
    float* WX = WA + 4096;
    float* XC = WX + 4096 + wave * 64;
    const h16* XR = (const h16*)(ws + WS_XR);
    h16* HL = (h16*)(ws + WS_HL); h16* AC = (h16*)(ws + WS_AC); float* AGG = (float*)(ws + WS_AGG);
    for (int item = bid; item < 8 * 8 * 32; item += nb) {
        const int n = item & 7, b = (item >> 3) & 7, ck = item >> 6;
        __syncthreads();
        for (int e = tid; e < 4096; e += NTHREADS) { WA[e] = P.gate_a_w[n * 4096 + e]; WX[e] = P.gate_x_w[n * 4096 + e]; }
        __syncthreads();
        const int ch = n * 64 + lane;
        const float cw0 = P.conv_w[0 * 512 + ch], cw1 = P.conv_w[1 * 512 + ch], cw2 = P.conv_w[2 * 512 + ch], cw3 = P.conv_w[3 * 512 + ch], cb = P.conv_b[ch];
        const float ba = P.gate_a_b[ch], bx = P.gate_x_b[ch];
        const float lam = P.lru_lambda[ch];
        const float sp8 = -8.0f * log1pf(expf(-lam));
        const int seg = ck * 8 + wave, t0 = seg * 16;
        const size_t mrow = (size_t)b * T + t0;
        float x0 = (t0 >= 3) ? (float)XR[(mrow - 3) * 512 + ch] : 0.f;
        float x1 = (t0 >= 2) ? (float)XR[(mrow - 2) * 512 + ch] : 0.f;
        float x2 = (t0 >= 1) ? (float)XR[(mrow - 1) * 512 + ch] : 0.f;
        float h = 0.f, Acum = 1.0f;
        for (int tt = 0; tt < 16; ++tt) {
            const float x3 = (float)XR[(mrow + tt) * 512 + ch];
            const float xc = cb + cw0 * x0 + cw1 * x1 + cw2 * x2 + cw3 * x3;
            x0 = x1; x1 = x2; x2 = x3;
            LDS_WAIT();
            XC[lane] = xc;
            LDS_WAIT();
            float sa = ba, sx = bx;
#pragma unroll 16
            for (int d = 0; d < 64; ++d) { const float xd = XC[d]; sa += xd * WA[d * 64 + lane]; sx += xd * WX[d * 64 + lane]; }
            const float r = sigmoidf_(sa), ig = sigmoidf_(sx);
            const float la = sp8 * r;
            const float a = expf(la);
            const float bq = sqrtf(-expm1f(2.0f * la)) * (ig * xc);
            h = a * h + bq; Acum *= a;
            HL[(mrow + tt) * 512 + ch] = (h16)h; AC[(mrow + tt) * 512 + ch] = (h16)Acum;
        }
        float* ag = AGG + (((size_t)(b * 8 + n) * 256 + seg) * 2) * 64;
        ag[lane] = Acum; ag[64 + lane] = h;
    }
}

__device__ __forceinline__ void rglru_fixup(const Params& P, int gw, int ngw, int lane) {
    unsigned char* ws = P.ws;
    const h16* HL = (const h16*)(ws + WS_HL); const h16* AC = (const h16*)(ws + WS_AC); const h16* GRG = (const h16*)(ws + WS_GRG);
    const float* AGG = (const float*)(ws + WS_AGG);
    h16* Y = (h16*)(ws + WS_Y); float* SSR = (float*)(ws + WS_SSR);
    for (int item = gw; item < 8 * 8 * 256; item += ngw) {
        const int n = item & 7, seg = (item >> 3) & 255, b = item >> 11;
        const float* ag = AGG + ((size_t)(b * 8 + n) * 256) * 128;
        float carry = 0.f;
        for (int s = 0; s < seg; ++s) carry = ag[s * 128 + lane] * carry + ag[s * 128 + 64 + lane];
        const int ch = n * 64 + lane;
        const size_t mrow = (size_t)b * T + seg * 16;
        for (int tt = 0; tt < 16; ++tt) {
            const size_t m = mrow + tt;
            const float hv = (float)HL[m * 512 + ch] + (float)AC[m * 512 + ch] * carry;
            const float y = (float)GRG[m * 512 + ch] * hv;
            Y[m * 1024 + ch] = (h16)y;
            const float ss = wave_sum(y * y);
            if (lane == 0) SSR[m * 8 + n] = ss;
        }
    }
}

__device__ __forceinline__ void compress_finish(const Params& P, int gw, int ngw, int lane) {
    unsigned char* ws = P.ws;
    const float* CR = (const float*)(ws + WS_CRAW); const float* ROPE = (const float*)(ws + WS_ROPE);
    h16* KCC = (h16*)(ws + WS_KCC); h16* VCC = (h16*)(ws + WS_VCC);
    for (int r = gw; r < 4096; r += ngw) {
        const int bg = r >> 8, c = r & 255, b = bg >> 1;
        float kv = CR[(size_t)r * 64 + lane], vv = CR[(size_t)(4096 + r) * 64 + lane];
        if (c == 255) { KCC[(size_t)r * 64 + lane] = (h16)0.f; VCC[(size_t)r * 64 + lane] = (h16)0.f; continue; }
        const float ss = wave_sum(kv * kv);
        kv = kv * (1.0f / sqrtf(ss * (1.0f / 64.0f) + EPS)) * P.k_norm_w[lane];
        const int mp = b * T + 16 * c + 31;
        const float other = __shfl_xor(kv, 8);
        float o = kv;
        if (lane < 8) o = kv * ROPE[mp * 16 + lane] - other * ROPE[mp * 16 + 8 + lane];
        else if (lane < 16) o = kv * ROPE[mp * 16 + lane - 8] + other * ROPE[mp * 16 + 8 + lane - 8];
        KCC[(size_t)r * 64 + lane] = (h16)o; VCC[(size_t)r * 64 + lane] = (h16)vv;
    }
}

__device__ __forceinline__ void qk4(const h16* krow, const float* qs, float (&s)[4]) {
    s[0] = s[1] = s[2] = s[3] = 0.f;
#pragma unroll
    for (int c = 0; c < 8; ++c) {
        const h16x8 k8 = *(const h16x8*)(krow + c * 8);
#pragma unroll
        for (int e = 0; e < 8; ++e) { const float kf = (float)k8[e];
#pragma unroll
            for (int h = 0; h < 4; ++h) s[h] += qs[h * 64 + c * 8 + e] * kf; }
    }
}
__device__ __forceinline__ void attn_group(const h16* Kb, const h16* Vb, int key, bool valid, int nk, const float* qs, float* ps,
                                           float (&mx)[4], float (&l)[4], float (&o)[4], int lane) {
    float s[4];
    qk4(Kb + (size_t)(valid ? key : 0) * 64, qs, s);
    float p[4];
#pragma unroll
    for (int h = 0; h < 4; ++h) {
        const float sv = valid ? s[h] : -INFINITY;
        const float mn = fmaxf(mx[h], wave_max(sv));
        const float f = exp2f(mx[h] - mn);
        p[h] = exp2f(sv - mn);
        l[h] = l[h] * f + wave_sum(p[h]); o[h] *= f; mx[h] = mn;
    }
    LDS_WAIT();
    *(f32x4*)(ps + lane * 4) = (f32x4){p[0], p[1], p[2], p[3]};
    LDS_WAIT();
    const int k0 = key - lane;
    for (int kk = 0; kk < nk; ++kk) {
        const float v = (float)Vb[(size_t)(k0 + kk) * 64 + lane];
        const f32x4 pv = *(const f32x4*)(ps + kk * 4);
        o[0] += pv.x * v; o[1] += pv.y * v; o[2] += pv.z * v; o[3] += pv.w * v;
    }
}
__device__ __forceinline__ void attn_naive(const Params& P, unsigned char* lds, int lane, int wave, int gw, int ngw) {
    unsigned char* ws = P.ws;
    float* qs = (float*)lds + wave * (256 + 1024);
    float* ps = qs + 256;
    const h16* QN = (const h16*)(ws + WS_Q);
    const h16* KCC = (const h16*)(ws + WS_KCC); const h16* VCC = (const h16*)(ws + WS_VCC);
    const h16* KS = (const h16*)(ws + WS_KS); const h16* VS = (const h16*)(ws + WS_VS);
    const h16* KW = (const h16*)(ws + WS_KW); const h16* VW = (const h16*)(ws + WS_VW);
    const float* GATE = (const float*)(ws + WS_GATE);
    h16* Y = (h16*)(ws + WS_Y); float* SSA = (float*)(ws + WS_SSA);
    for (int item = gw; item < M * 2; item += ngw) {
        const int g = item & 1, m = item >> 1, b = m >> 12, t = m & 4095, bg = b * 2 + g;
        LDS_WAIT();
#pragma unroll
        for (int h = 0; h < 4; ++h) qs[h * 64 + lane] = (float)QN[(size_t)m * 512 + (4 * g + h) * 64 + lane];
        LDS_WAIT();
        const int nvalid = (t >= 31) ? ((t - 31) >> 4) + 1 : 0;
        float sc[4][4];
#pragma unroll
        for (int i = 0; i < 4; ++i) {
            const int c = lane + 64 * i;
            float s[4]; qk4(KCC + ((size_t)bg * 256 + c) * 64, qs, s);
#pragma unroll
            for (int h = 0; h < 4; ++h) sc[i][h] = (c < nvalid) ? s[h] : -INFINITY;
        }
#pragma unroll
        for (int h = 0; h < 4; ++h) {
            float mxv = fmaxf(fmaxf(sc[0][h], sc[1][h]), fmaxf(sc[2][h], sc[3][h]));
            mxv = wave_max(mxv);
            if (!(mxv > -INFINITY)) mxv = 0.f;
            float ls = 0.f;
#pragma unroll
            for (int i = 0; i < 4; ++i) { sc[i][h] = exp2f(sc[i][h] - mxv); ls += sc[i][h]; }
            ls = wave_sum(ls);
            const float inv = 1.0f / fmaxf(ls, 1e-30f);
#pragma unroll
            for (int i = 0; i < 4; ++i) sc[i][h] *= inv;
        }
#pragma unroll
        for (int i = 0; i < 4; ++i) *(f32x4*)(ps + (lane + 64 * i) * 4) = (f32x4){sc[i][0], sc[i][1], sc[i][2], sc[i][3]};
        LDS_WAIT();
        float ocmp[4] = {0.f, 0.f, 0.f, 0.f};
        for (int c = 0; c < nvalid; ++c) {
            const float v = (float)VCC[((size_t)bg * 256 + c) * 64 + lane];
            const f32x4 pv = *(const f32x4*)(ps + c * 4);
            ocmp[0] += pv.x * v; ocmp[1] += pv.y * v; ocmp[2] += pv.z * v; ocmp[3] += pv.w * v;
        }
        float imp = 0.f;
        {
#pragma unroll
            for (int e = 0; e < 4; ++e) { const f32x4 pv = *(const f32x4*)(ps + (4 * lane + e) * 4); const float sh = (pv.x + pv.y) + (pv.z + pv.w); imp += (e == 3) ? 0.5f * sh : sh; }
            if (lane >= 1) { const f32x4 pv = *(const f32x4*)(ps + (4 * lane - 1) * 4); imp += 0.5f * ((pv.x + pv.y) + (pv.z + pv.w)); }
        }
        const int cur = t >> 6;
        const bool forced = (lane == 0) || (lane == cur) || (lane == cur - 1);
        const bool cand = !forced && lane < cur - 1;
        const int quota = 16 - (1 + (cur >= 1 ? 1 : 0) + (cur >= 2 ? 1 : 0));
        int rank = 0;
        for (int j2 = 0; j2 < 64; ++j2) {
            const float io = __shfl(imp, j2); const int co = __shfl((int)cand, j2);
            if (co && (io > imp || (io == imp && j2 < lane))) ++rank;
        }
        const bool sel = forced || (cand && rank < quota);
        unsigned long long mask = __ballot(sel);
        float mx[4] = {-INFINITY, -INFINITY, -INFINITY, -INFINITY}, ls[4] = {0.f, 0.f, 0.f, 0.f}, os[4] = {0.f, 0.f, 0.f, 0.f};
        while (mask) {
            const int j = __builtin_ctzll(mask); mask &= mask - 1;
            const int key = 64 * j + lane; const int nk = min(64, t - 64 * j + 1);
            attn_group(KS + (size_t)bg * T * 64, VS + (size_t)bg * T * 64, key, key <= t, nk, qs, ps, mx, ls, os, lane);
        }
        float mw[4] = {-INFINITY, -INFINITY, -INFINITY, -INFINITY}, lw[4] = {0.f, 0.f, 0.f, 0.f}, ow[4] = {0.f, 0.f, 0.f, 0.f};
        for (int k0 = max(0, t - 511); k0 <= t; k0 += 64) {
            const int key = k0 + lane; const int nk = min(64, t - k0 + 1);
            attn_group(KW + (size_t)bg * T * 64, VW + (size_t)bg * T * 64, key, key <= t, nk, qs, ps, mw, lw, ow, lane);
        }
#pragma unroll
        for (int h = 0; h < 4; ++h) {
            const float* gp = GATE + (size_t)m * 24 + (4 * g + h) * 3;
            const float o = gp[0] * ocmp[h] + gp[1] * os[h] / ls[h] + gp[2] * ow[h] / lw[h];
            Y[(size_t)m * 1024 + 512 + (4 * g + h) * 64 + lane] = (h16)o;
            const float ss = wave_sum(o * o);
            if (lane == 0) SSA[m * 8 + 4 * g + h] = ss;
        }
    }
}

#ifndef PHMASK
#define PHMASK 0x3ff
#endif
constexpr int NPHASE = 10;
constexpr int LDS_BYTES = 81920;
__global__ void __launch_bounds__(NTHREADS, 2) hymba_fwd(Params P) {
    extern __shared__ __attribute__((aligned(16))) unsigned char lds[];
    cg::grid_group grid = cg::this_grid();
    const int tid = threadIdx.x, lane = tid & 63, wave = __builtin_amdgcn_readfirstlane(tid >> 6);
    const int bid = blockIdx.x, nb = gridDim.x;
    const int gw = bid * NWAVES + wave, ngw = nb * NWAVES;
    unsigned char* ws = P.ws;
    const int lo = P.ph_lo, hi = P.ph_hi;
#define PH_BEGIN(k) if (lo <= (k) && (k) < hi) { if ((k) > lo) grid.sync();
#define PH_END }
#if PHMASK & (1 << 0)
        PH_BEGIN(0) phase0(P, lds, tid, lane, wave, bid, nb); PH_END
#endif
#if PHMASK & (1 << 1)
        PH_BEGIN(1) {
            GemmN g{(const h16*)(ws + WS_XH), 1024, (const h16*)(ws + WS_WIN), 1024, 1024, nullptr, 0, nullptr, 0, 0, M, NP1, 0};
            gemm_naive<false>(g, EpiProj{ws}, gw, ngw, lane);
        } PH_END
#endif
#if PHMASK & (1 << 2)
        PH_BEGIN(2) {
            normrope_rows(P, gw, ngw, lane);
            rglru_local(P, lds, tid, lane, wave, bid, nb);
            for (int w = 0; w < 2; ++w) {
                GemmN g{(const h16*)(ws + (w ? WS_VCT : WS_KCT)), 1024, (const h16*)(ws + (w ? WS_W1V : WS_W1K)), CMPK, CMPK, nullptr, 0, nullptr, 0, 0, 4096, CMPH, 0};
                gemm_naive<false>(g, EpiCmpA{(h16*)(ws + WS_H1) + (size_t)w * 4096 * CMPH, (const float*)(ws + WS_B1) + w * 256}, gw, ngw, lane);
            }
        } PH_END
#endif
#if PHMASK & (1 << 3)
        PH_BEGIN(3) {
            for (int w = 0; w < 2; ++w) {
                GemmN g{(const h16*)(ws + WS_H1) + (size_t)w * 4096 * CMPH, CMPH, (const h16*)(ws + (w ? WS_W2V : WS_W2K)), CMPH, CMPH, nullptr, 0, nullptr, 0, 0, 4096, HD, 0};
                gemm_naive<false>(g, EpiCmpB{(float*)(ws + WS_CRAW) + (size_t)w * 4096 * HD}, gw, ngw, lane);
            }
        } PH_END
#endif
#if PHMASK & (1 << 4)
        PH_BEGIN(4) compress_finish(P, gw, ngw, lane); PH_END
#endif
#if PHMASK & (1 << 5)
        PH_BEGIN(5) {
            rglru_fixup(P, gw, ngw, lane);
            attn_naive(P, lds, lane, wave, gw, ngw);
        } PH_END
#endif
#if PHMASK & (1 << 6)
        PH_BEGIN(6) {
            const h16* Y = (const h16*)(ws + WS_Y); const h16* W = (const h16*)(ws + WS_WOUT);
            GemmN g{Y, 1024, W, 1024, 512, Y + 512, 1024, W + 512, 1024, 512, M, D, 0};
            gemm_naive<true>(g, EpiOut{P.x, P.out, (h16*)(ws + WS_X1H), (const float*)(ws + WS_SSR), (const float*)(ws + WS_SSA)}, gw, ngw, lane);
        } PH_END
#endif
#if PHMASK & (1 << 7)
        PH_BEGIN(7) {
            float* RSTD2 = (float*)(ws + WS_RSTD2);
            for (int m = gw; m < M; m += ngw) {
                const f32x4* xr = (const f32x4*)(P.out + (size_t)m * D) + lane; float s = 0.f;
#pragma unroll
                for (int j = 0; j < 4; ++j) { const f32x4 v = xr[64 * j]; s += (v.x * v.x + v.y * v.y) + (v.z * v.z + v.w * v.w); }
                s = wave_sum(s);
                if (lane == 0) RSTD2[m] = 1.0f / sqrtf(s * (1.0f / D) + EPS);
            }
        } PH_END
#endif
#if PHMASK & (1 << 8)
        PH_BEGIN(8) {
            const h16* A = (const h16*)(ws + WS_X1H); const h16* W = (const h16*)(ws + WS_WGU);
            GemmN g{A, 1024, W, 1024, 1024, A, 1024, W, 1024, 1024, M, DFF, 1};
            gemm_naive<true>(g, EpiGU{(h16*)(ws + WS_HM), (const float*)(ws + WS_RSTD2)}, gw, ngw, lane);
        } PH_END
#endif
#if PHMASK & (1 << 9)
        PH_BEGIN(9) {
            GemmN g{(const h16*)(ws + WS_HM), DFF, (const h16*)(ws + WS_WD), DFF, DFF, nullptr, 0, nullptr, 0, 0, M, D, 0};
            gemm_naive<false>(g, EpiDown{P.out}, gw, ngw, lane);
        } PH_END
#endif
}

#ifndef N_LAUNCH_PER_PHASE
#define N_LAUNCH_PER_PHASE 0
#endif
extern "C" void kernel_launch(void* const* d_in, const int* in_sizes, int n_in, void* d_out, int out_size, void* d_ws, size_t ws_size, hipStream_t stream) {
    static int grid = 0;
    if (grid == 0) {
        if (n_in != 25 || in_sizes[0] != M * D || out_size != M * D || ws_size < WS_END) {
            fprintf(stderr, "kernel_launch: unexpected problem (n_in %d, in0 %d, out %d, ws %zu)\n", n_in, n_in > 0 ? in_sizes[0] : -1, out_size, ws_size); grid = -1; return; }
        int dev = 0, cus = 0, per_cu = 0;
        hipGetDevice(&dev);
        hipDeviceGetAttribute(&cus, hipDeviceAttributeMultiprocessorCount, dev);
        hipFuncSetAttribute((const void*)hymba_fwd, hipFuncAttributeMaxDynamicSharedMemorySize, LDS_BYTES);
        hipOccupancyMaxActiveBlocksPerMultiprocessor(&per_cu, (const void*)hymba_fwd, NTHREADS, LDS_BYTES);
        if (per_cu < 1) { fprintf(stderr, "kernel_launch: occupancy query says %d blocks per CU\n", per_cu); grid = -1; return; }
        grid = cus;
    }
    if (grid < 0) return;
    Params p{};
    const float** pf = (const float**)&p;
    for (int i = 0; i < 25; ++i) pf[i] = (const float*)d_in[i];
    p.out = (float*)d_out; p.ws = (unsigned char*)d_ws;
#if N_LAUNCH_PER_PHASE
    for (int ph = 0; ph < NPHASE; ++ph) {
        p.ph_lo = ph; p.ph_hi = ph + 1;
        void* args[] = {&p};
        hipError_t e = hipLaunchCooperativeKernel((const void*)hymba_fwd, dim3(grid), dim3(NTHREADS), args, LDS_BYTES, stream);
        if (e != hipSuccess) { fprintf(stderr, "launch failed: %s\n", hipGetErrorString(e)); return; }
    }
#else
    p.ph_lo = 0; p.ph_hi = NPHASE;
    void* args[] = {&p};
    hipError_t e = hipLaunchCooperativeKernel((const void*)hymba_fwd, dim3(grid), dim3(NTHREADS), args, LDS_BYTES, stream);
    if (e != hipSuccess) fprintf(stderr, "launch failed: %s\n", hipGetErrorString(e));
#endif
}
```

```cpp
#include <hip/hip_runtime.h>
#include <hip/hip_cooperative_groups.h>
#include <cstdio>
#include <cstdint>
namespace cg = cooperative_groups;

typedef _Float16 h16;
typedef _Float16 h16x8 __attribute__((ext_vector_type(8)));
typedef _Float16 h16x4 __attribute__((ext_vector_type(4)));
typedef _Float16 h16x2 __attribute__((ext_vector_type(2)));
typedef float f32x4 __attribute__((ext_vector_type(4)));
typedef float f32x2 __attribute__((ext_vector_type(2)));
typedef unsigned u32x4 __attribute__((ext_vector_type(4)));
typedef unsigned u32x2 __attribute__((ext_vector_type(2)));

constexpr int BATCH = 8, T = 4096, M = BATCH * T, D = 1024;
constexpr int DRNN = 512, NBLK = 8, DATT = 512, NH = 8, NKV = 2, HPG = 4, HD = 64;
constexpr int DIN = 2328, NP1 = 2560;
constexpr int DFF = 2816;
constexpr int NCMP = 255, NCP = 256;
constexpr int CMPK = 2048, CMPH = 256;
constexpr float EPS = 1e-6f;
constexpr float C2 = 0.125f * 1.4426950408889634f;
constexpr int NTHREADS = 512, NWAVES = 8;

constexpr size_t MiB = 1u << 20;
constexpr size_t WS_WIN = 0;
constexpr size_t WS_WOUT = 6 * MiB;
constexpr size_t WS_WGU = 8 * MiB;
constexpr size_t WS_WD = 20 * MiB;
constexpr size_t WS_W1K = 26 * MiB, WS_W1V = 27 * MiB;
constexpr size_t WS_W2K = 28 * MiB, WS_W2V = 28 * MiB + 65536;
constexpr size_t WS_B1 = 28 * MiB + 131072;
constexpr size_t WS_RSTD1 = 29 * MiB;
constexpr size_t WS_RSTD2 = 29 * MiB + 262144;
constexpr size_t WS_SS2P = 456 * MiB;
constexpr size_t WS_ROPE = 30 * MiB;
constexpr size_t WS_XH = 32 * MiB;
constexpr size_t WS_XR = 96 * MiB;
constexpr size_t WS_GRG = 128 * MiB;
constexpr size_t WS_Q = 160 * MiB;
constexpr size_t WS_HL = 192 * MiB;
constexpr size_t WS_HM = 32 * MiB;
constexpr size_t WS_AC = 224 * MiB;
constexpr size_t WS_KCT = 256 * MiB;
constexpr size_t WS_VCT = 265 * MiB;
constexpr size_t WS_KS = 274 * MiB, WS_VS = 282 * MiB, WS_KW = 290 * MiB, WS_VW = 298 * MiB;
constexpr size_t WS_GATE = 306 * MiB;
constexpr size_t WS_H1 = 310 * MiB;
constexpr size_t WS_CRAW = 314 * MiB;
constexpr size_t WS_KCC = 316 * MiB, WS_VCC = 317 * MiB;
constexpr size_t WS_AGG = 318 * MiB;
constexpr size_t WS_SSR = 326 * MiB, WS_SSA = 327 * MiB;
constexpr size_t WS_Y = 328 * MiB;
constexpr size_t WS_X1H = 392 * MiB;
constexpr size_t WS_END = 458 * MiB;

#define LDS_WAIT() asm volatile("s_waitcnt lgkmcnt(0)" ::: "memory")
__device__ __forceinline__ float wave_sum(float v) {
#pragma unroll
    for (int o = 1; o < 64; o <<= 1) v += __shfl_xor(v, o);
    return v;
}
__device__ __forceinline__ float wave_max(float v) {
#pragma unroll
    for (int o = 1; o < 64; o <<= 1) v = fmaxf(v, __shfl_xor(v, o));
    return v;
}
__device__ __forceinline__ float gelu_tanh(float x) {
    const float u = 0.7978845608028654f * (x + 0.044715f * x * x * x);
    return 0.5f * x * (1.0f + tanhf(u));
}
__device__ __forceinline__ float sigmoidf_(float x) { return 1.0f / (1.0f + __expf(-x)); }

struct Params {
    const float* x; const int* pos; const float* attn_norm_w; const float* w_in; const float* conv_w; const float* conv_b;
    const float* gate_a_w; const float* gate_a_b; const float* gate_x_w; const float* gate_x_b; const float* lru_lambda;
    const float* q_norm_w; const float* k_norm_w; const float* cmp_pos; const float* cmp_k_w1; const float* cmp_k_w2;
    const float* cmp_v_w1; const float* cmp_v_w2; const float* rnn_out_norm_w; const float* attn_out_norm_w; const float* w_out;
    const float* ffn_norm_w; const float* w_gate; const float* w_up; const float* w_down;
    float* out; unsigned char* ws; int ph_lo, ph_hi;
};

__device__ __forceinline__ void p0_transpose_item(const float* W, int K, int N, const float* s0, const float* s1, int ksplit,
                                                  h16* WT, int ldt, int mode, int nblk, float* scr, int item, int lane) {
    const int kb = item / nblk, nb = item % nblk, k0 = 64 * kb, n0 = 32 * nb;
#pragma unroll 8
    for (int i = 0; i < 32; ++i) {
        const int kk = 2 * i + (lane >> 5), n = n0 + (lane & 31), k = k0 + kk;
        float v = 0.f;
        if (n < N) { v = W[(size_t)k * N + n]; if (s0) v *= (k < ksplit) ? s0[k] : s1[k - ksplit]; }
        scr[kk * 33 + (lane & 31)] = v;
    }
    LDS_WAIT();
    const int c = lane & 7;
#pragma unroll
    for (int j = 0; j < 4; ++j) {
        const int nl = (lane >> 3) + 8 * j, n = n0 + nl;
        const float* s = scr + (8 * c) * 33 + nl;
        h16x8 o;
#pragma unroll
        for (int e = 0; e < 8; ++e) o[e] = (h16)s[e * 33];
        int orow = n;
        if (mode == 1) orow = (n >> 7) * 256 + (n & 127);
        else if (mode == 2) orow = (n >> 7) * 256 + (n & 127) + 128;
        *(h16x8*)(WT + (size_t)orow * ldt + k0 + 8 * c) = o;
    }
    LDS_WAIT();
}

__device__ __forceinline__ void phase0(const Params& P, unsigned char* lds, int tid, int lane, int wave, int bid, int nb) {
    unsigned char* ws = P.ws;
    float* scr = (float*)lds + wave * (64 * 33);
    const int gw = bid * NWAVES + wave, ngw = nb * NWAVES;
    constexpr int I_IN = 16 * 80, I_OUT = 16 * 32, I_G = 16 * 88, I_U = 16 * 88, I_D = 44 * 32, I_C1 = 32 * 8, I_C2 = 4 * 2;
    constexpr int NIT = I_IN + I_OUT + I_G + I_U + I_D + 2 * I_C1 + 2 * I_C2;
    for (int it = gw; it < NIT; it += ngw) {
        int r = it;
        const float* W; int K, N; const float* s0 = nullptr; const float* s1 = nullptr; int ksplit = 0; size_t wo; int ldt, mode = 0, nblk;
        if (r < I_IN) { W = P.w_in; K = 1024; N = DIN; s0 = P.attn_norm_w; s1 = P.attn_norm_w; ksplit = 1024; wo = WS_WIN; ldt = 1024; nblk = 80; }
        else if ((r -= I_IN) < I_OUT) { W = P.w_out; K = 1024; N = 1024; s0 = P.rnn_out_norm_w; s1 = P.attn_out_norm_w; ksplit = 512; wo = WS_WOUT; ldt = 1024; nblk = 32; }
        else if ((r -= I_OUT) < I_G) { W = P.w_gate; K = 1024; N = DFF; s0 = P.ffn_norm_w; s1 = P.ffn_norm_w; ksplit = 1024; wo = WS_WGU; ldt = 1024; mode = 1; nblk = 88; }
        else if ((r -= I_G) < I_U) { W = P.w_up; K = 1024; N = DFF; s0 = P.ffn_norm_w; s1 = P.ffn_norm_w; ksplit = 1024; wo = WS_WGU; ldt = 1024; mode = 2; nblk = 88; }
        else if ((r -= I_U) < I_D) { W = P.w_down; K = DFF; N = 1024; wo = WS_WD; ldt = DFF; nblk = 32; }
        else if ((r -= I_D) < I_C1) { W = P.cmp_k_w1; K = CMPK; N = CMPH; wo = WS_W1K; ldt = CMPK; nblk = 8; }
        else if ((r -= I_C1) < I_C1) { W = P.cmp_v_w1; K = CMPK; N = CMPH; wo = WS_W1V; ldt = CMPK; nblk = 8; }
        else if ((r -= I_C1) < I_C2) { W = P.cmp_k_w2; K = CMPH; N = HD; wo = WS_W2K; ldt = CMPH; nblk = 2; }
        else { r -= I_C2; W = P.cmp_v_w2; K = CMPH; N = HD; wo = WS_W2V; ldt = CMPH; nblk = 2; }
        p0_transpose_item(W, K, N, s0, s1, ksplit, (h16*)(ws + wo), ldt, mode, nblk, scr, r, lane);
    }
    h16* XH = (h16*)(ws + WS_XH); float* RSTD1 = (float*)(ws + WS_RSTD1);
    for (int m = gw; m < M; m += ngw) {
        const f32x4* xr = (const f32x4*)(P.x + (size_t)m * D) + lane;
        f32x4 v[4]; float s = 0.f;
#pragma unroll
        for (int j = 0; j < 4; ++j) { v[j] = xr[64 * j]; s += (v[j].x * v[j].x + v[j].y * v[j].y) + (v[j].z * v[j].z + v[j].w * v[j].w); }
        s = wave_sum(s);
        if (lane == 0) RSTD1[m] = 1.0f / sqrtf(s * (1.0f / D) + EPS);
        h16x4* o = (h16x4*)(XH + (size_t)m * D) + lane;
#pragma unroll
        for (int j = 0; j < 4; ++j) { h16x4 h; h.x = (h16)v[j].x; h.y = (h16)v[j].y; h.z = (h16)v[j].z; h.w = (h16)v[j].w; o[64 * j] = h; }
    }
    float* ROPE = (float*)(ws + WS_ROPE);
    for (int e = bid * NTHREADS + tid; e < M * 8; e += nb * NTHREADS) {
        const int m = e >> 3, i = e & 7;
        const float inv = (float)pow(500000.0, -(double)i / 8.0);
        const float ang = (float)P.pos[m] * inv;
        ROPE[m * 16 + i] = (float)cos((double)ang);
        ROPE[m * 16 + 8 + i] = (float)sin((double)ang);
    }
    if (bid < 8) {
        const int which = bid >> 2, n = (bid & 3) * 64 + (tid & 63), ks = tid >> 6;
        const float* w1 = which ? P.cmp_v_w1 : P.cmp_k_w1;
        float s = 0.f;
        for (int k = ks * 256; k < ks * 256 + 256; ++k) s += P.cmp_pos[k] * w1[(size_t)k * CMPH + n];
        float* red = (float*)lds + NWAVES * 64 * 33;
        red[ks * 64 + (tid & 63)] = s;
        __syncthreads();
        if (tid < 64) { float a = 0.f; for (int q = 0; q < 8; ++q) a += red[q * 64 + tid]; ((float*)(ws + WS_B1))[which * 256 + (bid & 3) * 64 + tid] = a; }
        __syncthreads();
    }
    if (bid == 8 % nb) {
        h16* kp = (h16*)(ws + WS_KCT) + (size_t)16 * T * 64; h16* vp = (h16*)(ws + WS_VCT) + (size_t)16 * T * 64;
        for (int e = tid; e < 2048; e += NTHREADS) { kp[e] = (h16)0.f; vp[e] = (h16)0.f; }
    }
}

struct GemmN { const h16* A1; int lda1; const h16* B1; int ldb1; int K1; const h16* A2; int lda2; const h16* B2; int ldb2; int K2; int Mr, Nc; int bmap; };
template <bool DUAL, class Epi>
__device__ __forceinline__ void gemm_naive(const GemmN& g, const Epi& epi, int gw, int ngw, int lane) {
    const int tn = g.Nc / 64, tm = g.Mr / 64, ntile = tm * tn;
    const int fr = lane & 15, fq = lane >> 4;
    for (int tile = gw; tile < ntile; tile += ngw) {
        const int tr = tile / tn, tc = tile % tn;
        f32x4 acc1[4][4], acc2[4][4];
#pragma unroll
        for (int i = 0; i < 4; ++i)
#pragma unroll
            for (int j = 0; j < 4; ++j) { acc1[i][j] = (f32x4){0.f, 0.f, 0.f, 0.f}; acc2[i][j] = (f32x4){0.f, 0.f, 0.f, 0.f}; }
        const int bcol = tc * 64 + fr;
        const int brow0 = g.bmap ? ((bcol >> 7) * 256 + (bcol & 127)) : bcol;
        {
            const h16* ap = g.A1 + (size_t)(tr * 64 + fr) * g.lda1 + fq * 8;
            const h16* bp = g.B1 + (size_t)brow0 * g.ldb1 + fq * 8;
            for (int k0 = 0; k0 < g.K1; k0 += 32) {
                h16x8 a[4], b[4];
#pragma unroll
                for (int i = 0; i < 4; ++i) a[i] = *(const h16x8*)(ap + (size_t)i * 16 * g.lda1 + k0);
#pragma unroll
                for (int j = 0; j < 4; ++j) b[j] = *(const h16x8*)(bp + (size_t)j * 16 * g.ldb1 + k0);
#pragma unroll
                for (int i = 0; i < 4; ++i)
#pragma unroll
                    for (int j = 0; j < 4; ++j) acc1[i][j] = __builtin_amdgcn_mfma_f32_16x16x32_f16(a[i], b[j], acc1[i][j], 0, 0, 0);
            }
        }
        if (DUAL) {
            const h16* ap = g.A2 + (size_t)(tr * 64 + fr) * g.lda2 + fq * 8;
            const h16* bp = g.B2 + (size_t)(brow0 + (g.bmap ? 128 : 0)) * g.ldb2 + fq * 8;
            for (int k0 = 0; k0 < g.K2; k0 += 32) {
                h16x8 a[4], b[4];
#pragma unroll
                for (int i = 0; i < 4; ++i) a[i] = *(const h16x8*)(ap + (size_t)i * 16 * g.lda2 + k0);
#pragma unroll
                for (int j = 0; j < 4; ++j) b[j] = *(const h16x8*)(bp + (size_t)j * 16 * g.ldb2 + k0);
#pragma unroll
                for (int i = 0; i < 4; ++i)
#pragma unroll
                    for (int j = 0; j < 4; ++j) acc2[i][j] = __builtin_amdgcn_mfma_f32_16x16x32_f16(a[i], b[j], acc2[i][j], 0, 0, 0);
            }
        }
#pragma unroll
        for (int i = 0; i < 4; ++i)
#pragma unroll
            for (int j = 0; j < 4; ++j)
#pragma unroll
                for (int r = 0; r < 4; ++r) epi(tr * 64 + 16 * i + 4 * fq + r, tc * 64 + 16 * j + fr, acc1[i][j][r], DUAL ? acc2[i][j][r] : 0.f);
    }
}

struct EpiProj {
    unsigned char* ws;
    __device__ __forceinline__ void operator()(int m, int c, float v, float) const {
        v *= ((const float*)(ws + WS_RSTD1))[m];
        if (c < 512) { ((h16*)(ws + WS_XR))[(size_t)m * 512 + c] = (h16)v; return; }
        if (c < 1024) { ((h16*)(ws + WS_GRG))[(size_t)m * 512 + c - 512] = (h16)gelu_tanh(v); return; }
        if (c < 1536) { ((h16*)(ws + WS_Q))[(size_t)m * 512 + c - 1024] = (h16)v; return; }
        if (c < 2304) {
            const int idx = (c - 1536) >> 7, cc = (c - 1536) & 127, g = cc >> 6, d = cc & 63, b = m >> 12, t = m & 4095;
            const size_t off = ((size_t)(b * 2 + g) * T + t) * 64 + d;
            h16* base = (h16*)(ws + (idx == 0 ? WS_KCT : idx == 1 ? WS_VCT : idx == 2 ? WS_KS : idx == 3 ? WS_VS : idx == 4 ? WS_KW : WS_VW));
            base[off] = (h16)v; return;
        }
        if (c < DIN) ((float*)(ws + WS_GATE))[(size_t)m * 24 + c - 2304] = sigmoidf_(v);
    }
};
struct EpiCmpA {
    h16* H1; const float* b1;
    __device__ __forceinline__ void operator()(int r, int c, float v, float) const { H1[(size_t)r * CMPH + c] = (h16)gelu_tanh(v + b1[c]); }
};
struct EpiCmpB {
    float* O;
    __device__ __forceinline__ void operator()(int r, int c, float v, float) const { O[(size_t)r * HD + c] = v; }
};
struct EpiOut {
    const float* x; float* out; h16* x1h; const float* rsr; const float* ssa2;
    __device__ __forceinline__ void operator()(int m, int c, float v1, float v2) const {
        const float s1 = rsr[m], s2 = 1.0f / sqrtf((ssa2[m * 2] + ssa2[m * 2 + 1]) * (1.0f / 512.0f) + EPS);
        const float x1 = x[(size_t)m * D + c] + s1 * v1 + s2 * v2;
        out[(size_t)m * D + c] = x1; x1h[(size_t)m * D + c] = (h16)x1;
    }
};
struct EpiGU {
    h16* hm; const float* rstd2;
    __device__ __forceinline__ void operator()(int m, int c, float vg, float vu) const {
        const float r = rstd2[m], g = vg * r, u = vu * r;
        hm[(size_t)m * DFF + c] = (h16)(g * sigmoidf_(g) * u);
    }
};
struct EpiDown {
    float* out;
    __device__ __forceinline__ void operator()(int m, int c, float v, float) const { out[(size_t)m * D + c] += v; }
};

namespace pg8 {
#define PG8_LAS __attribute__((address_space(3)))
typedef unsigned short bf16_t;
typedef _Float16 bf16x8 __attribute__((ext_vector_type(8)));
typedef float f32x4 __attribute__((ext_vector_type(4)));
typedef unsigned u32x4 __attribute__((ext_vector_type(4)));
constexpr int BM = 256, BK = 64, HALF = 128, HTB = HALF * BK * 2  , STAGE_BYTES = 8 * HTB, NXCD = 8, WGM = 8;

__host__ __device__ __forceinline__ int lds_byte(int r, int c) { const int st = (r >> 4) * 2 + (c >> 5), rr = r & 15, cc = c & 31, ob = rr * 64 + cc * 2; return st * 1024 + (ob ^ (((ob >> 9) & 1) << 5)); }
__host__ __device__ __forceinline__ void stage_rc(int b, int& R, int& C) { const int st = b / 1024, sb = b % 1024, swz = sb ^ (((sb >> 9) & 1) << 5); R = (st >> 1) * 16 + swz / 64; C = (st & 1) * 32 + (swz % 64) / 2; }
__host__ __device__ __forceinline__ int perm32(int rho) { const int n = rho >> 4, i = rho & 15; return 8 * (i >> 2) + 4 * n + (i & 3); }

struct Unit { int pm, pn; };
struct Gemm { const bf16_t* A; const bf16_t* Bt; int M, N, K; };

struct StaticOrder {
    int nM, nN, nwg, G, c;
    __host__ __device__ void init(int M, int N, int G_, int c_) { nM = M / BM; nN = N / BM; nwg = nM * nN; G = G_; c = c_; }
    __host__ __device__ bool next(int i, Unit& u) const {
        const long L = (long)i * G + c; if (L >= nwg) return false;
        int wgid = (int)L; { const int q = nwg / NXCD, r = nwg % NXCD, xcd = wgid % NXCD, off = wgid / NXCD; wgid = (xcd < r ? xcd * (q + 1) : r * (q + 1) + (xcd - r) * q) + off; }
        const int nig = WGM * nN, gid = wgid / nig, fm = gid * WGM, gsz = (nM - fm) < WGM ? (nM - fm) : WGM;
        u.pm = fm + ((wgid % nig) % gsz); u.pn = (wgid % nig) / gsz; return true;
    }
    __device__ __forceinline__ void a_ready(const Unit&) const {}
    __device__ __forceinline__ void done(const Unit&) const {}
};
template <class Epi, class Sched, bool ALIGN_EPI = false, bool SP2 = false>
__device__ __forceinline__ void gemm_phase(PG8_LAS unsigned char* lds, const Gemm g, const Sched& S, const Epi& E) {
    const int tid = threadIdx.x, wid = __builtin_amdgcn_readfirstlane(tid >> 6), lane = tid & 63, wr = wid >> 2, wc = wid & 3, fr = lane & 15, fq = lane >> 4;
    const int K = g.K, nt = K / BK;
    unsigned voffA[2], voffB[2];
#pragma unroll
    for (int i = 0; i < 2; ++i) { int R, C; stage_rc(tid * 16 + i * 8192, R, C); const int Rb = Epi::PERM ? ((R & ~31) + perm32(R & 31)) : R;
        voffA[i] = (unsigned)(R * K + C) * 2u; voffB[i] = (unsigned)(Rb * K + C) * 2u; }
    const size_t kstep = (size_t)(BK * 2);
    const size_t hstep = (size_t)HALF * K * 2;
    const size_t tstep = 2 * hstep;
    const unsigned ldsw = (unsigned)wid * 1024u;
    const int aoff = lds_byte(wr * 64 + fr, fq * 8), boff = lds_byte(wc * 32 + fr, fq * 8);
#define PG8_SA(b, h) (((b) * 2 + (h)) * HTB)
#define PG8_SB(b, h) ((4 + (b) * 2 + (h)) * HTB)
#define PG8_STAGE(bufoff, gbase, voff) do { _Pragma("unroll") for (int _i = 0; _i < 2; ++_i) \
        __builtin_amdgcn_global_load_lds((const unsigned*)((const char*)(gbase) + (voff)[_i]), (PG8_LAS unsigned*)(lds + (bufoff) + ldsw + _i * 8192), 16, 0, 0); } while (0)
#define PG8_LDA(dst, b, h) do { _Pragma("unroll") for (int m = 0; m < 4; ++m) _Pragma("unroll") for (int k = 0; k < 2; ++k) dst[m][k] = *(const PG8_LAS bf16x8*)(lds + PG8_SA(b, h) + aoff + m * 2048 + k * 1024); } while (0)
#define PG8_LDB(dst, b, h) do { _Pragma("unroll") for (int n = 0; n < 2; ++n) _Pragma("unroll") for (int k = 0; k < 2; ++k) dst[n][k] = *(const PG8_LAS bf16x8*)(lds + PG8_SB(b, h) + boff + n * 2048 + k * 1024); } while (0)
#define PG8_MMA(ai, bj, At, Bt) do { __builtin_amdgcn_s_setprio(1); _Pragma("unroll") for (int m = 0; m < 4; ++m) _Pragma("unroll") for (int n = 0; n < 2; ++n) _Pragma("unroll") for (int k = 0; k < 2; ++k) \
        acc[ai][bj][m][n] = __builtin_amdgcn_mfma_f32_16x16x32_f16(Bt[n][k], At[m][k], acc[ai][bj][m][n], 0, 0, 0); __builtin_amdgcn_s_setprio(0); } while (0)
#define PG8_WAIT_V(n) asm volatile("s_waitcnt vmcnt(" #n ")" ::: "memory")
#define PG8_WAIT_L(n) asm volatile("s_waitcnt lgkmcnt(" #n ")" ::: "memory")
#define PG8_BAR __builtin_amdgcn_s_barrier()
#define PG8_SCHED __builtin_amdgcn_sched_barrier(0)
    Unit cur, nxt; int ui = 0;
    if (!S.next(0, cur)) return;
    f32x4 acc[2][2][4][2];
#pragma unroll
    for (int a = 0; a < 2; ++a)
#pragma unroll
        for (int b = 0; b < 2; ++b)
#pragma unroll
            for (int m = 0; m < 4; ++m)
#pragma unroll
                for (int n = 0; n < 2; ++n) acc[a][b][m][n] = (f32x4){0.f, 0.f, 0.f, 0.f};
    bf16x8 At[4][2], B0[2][2], B1[2][2];
    const char* cA = (const char*)g.A + (size_t)cur.pm * tstep; const char* cB = (const char*)g.Bt + (size_t)cur.pn * tstep;
    S.a_ready(cur);
    if constexpr (SP2) {
        PG8_STAGE(PG8_SB(0, 0), cB, voffB); PG8_STAGE(PG8_SB(0, 1), cB + hstep, voffB); PG8_STAGE(PG8_SA(0, 0), cA, voffA); PG8_STAGE(PG8_SA(0, 1), cA + hstep, voffA);
        if (wr == 1) PG8_BAR;
        PG8_WAIT_V(2); PG8_BAR;
        PG8_STAGE(PG8_SB(1, 0), cB + kstep, voffB); PG8_STAGE(PG8_SA(1, 0), cA + kstep, voffA); PG8_STAGE(PG8_SB(1, 1), cB + hstep + kstep, voffB);
        PG8_WAIT_V(6); PG8_BAR;
    } else {
        PG8_STAGE(PG8_SB(0, 0), cB, voffB); PG8_STAGE(PG8_SA(0, 0), cA, voffA); PG8_STAGE(PG8_SB(0, 1), cB + hstep, voffB); PG8_STAGE(PG8_SA(0, 1), cA + hstep, voffA);
        if (wr == 1) PG8_BAR;
        PG8_WAIT_V(4); PG8_BAR;
        PG8_STAGE(PG8_SB(1, 0), cB + kstep, voffB); PG8_STAGE(PG8_SA(1, 0), cA + kstep, voffA); PG8_STAGE(PG8_SB(1, 1), cB + hstep + kstep, voffB);
        PG8_WAIT_V(6); PG8_BAR;
    }
    for (;;) {
        const bool has_next = S.next(ui + 1, nxt);
        const char* nA = has_next ? (const char*)g.A + (size_t)nxt.pm * tstep : cA; const char* nB = has_next ? (const char*)g.Bt + (size_t)nxt.pn * tstep : cB;
        for (int t = 0; t < nt; t += 2) {
            const bool last = (t == nt - 2);
            const char* a1 = cA + (size_t)(t + 1) * kstep;
            const char* a2 = last ? nA : cA + (size_t)(t + 2) * kstep; const char* b2 = last ? nB : cB + (size_t)(t + 2) * kstep;
            const char* a3 = a2 + kstep; const char* b3 = b2 + kstep;
            if (last && has_next) S.a_ready(nxt);
            if constexpr (Epi::MIDK) { if (t == nt / 2) E.mid(acc, cur, wr, wc, fr, fq); }
            if constexpr (SP2) {
            PG8_LDB(B0, 0, 0); PG8_LDB(B1, 0, 1); PG8_SCHED; PG8_LDA(At, 0, 0); PG8_STAGE(PG8_SA(1, 1), a1 + hstep, voffA);
            PG8_WAIT_V(8); PG8_WAIT_L(0); PG8_BAR; PG8_MMA(0, 0, At, B0); PG8_MMA(0, 1, At, B1); PG8_BAR; PG8_SCHED;
            PG8_LDA(At, 0, 1); PG8_STAGE(PG8_SB(0, 0), b2, voffB); PG8_STAGE(PG8_SB(0, 1), b2 + hstep, voffB); PG8_STAGE(PG8_SA(0, 0), a2, voffA);
            PG8_WAIT_V(8); PG8_WAIT_L(0); PG8_BAR; PG8_MMA(1, 0, At, B0); PG8_MMA(1, 1, At, B1); PG8_BAR; PG8_SCHED;
            PG8_LDB(B0, 1, 0); PG8_LDB(B1, 1, 1); PG8_SCHED; PG8_LDA(At, 1, 0); PG8_STAGE(PG8_SA(0, 1), a2 + hstep, voffA);
            PG8_WAIT_V(8); PG8_WAIT_L(0); PG8_BAR; PG8_MMA(0, 0, At, B0); PG8_MMA(0, 1, At, B1); PG8_BAR; PG8_SCHED;
            PG8_LDA(At, 1, 1); PG8_STAGE(PG8_SB(1, 0), b3, voffB); PG8_STAGE(PG8_SB(1, 1), b3 + hstep, voffB); PG8_STAGE(PG8_SA(1, 0), a3, voffA);
            PG8_WAIT_V(8); PG8_WAIT_L(0); PG8_BAR; PG8_MMA(1, 0, At, B0); PG8_MMA(1, 1, At, B1); PG8_BAR; PG8_SCHED;
            } else {
            PG8_LDB(B0, 0, 0); PG8_SCHED; PG8_LDA(At, 0, 0); PG8_STAGE(PG8_SA(1, 1), a1 + hstep, voffA);
            PG8_WAIT_L(8); PG8_BAR; PG8_WAIT_L(0); PG8_MMA(0, 0, At, B0); PG8_BAR; PG8_SCHED;
            PG8_LDB(B1, 0, 1); PG8_STAGE(PG8_SB(0, 0), b2, voffB);
            PG8_BAR; PG8_WAIT_L(0); PG8_MMA(0, 1, At, B1); PG8_BAR;
            PG8_LDA(At, 0, 1); PG8_STAGE(PG8_SA(0, 0), a2, voffA);
            PG8_BAR; PG8_WAIT_L(0); PG8_MMA(1, 0, At, B0); PG8_BAR; PG8_SCHED;
            PG8_STAGE(PG8_SB(0, 1), b2 + hstep, voffB);
            PG8_WAIT_V(6); PG8_BAR; PG8_MMA(1, 1, At, B1); PG8_BAR;
            PG8_LDB(B0, 1, 0); PG8_SCHED; PG8_LDA(At, 1, 0); PG8_STAGE(PG8_SA(0, 1), a2 + hstep, voffA);
            PG8_WAIT_L(8); PG8_BAR; PG8_WAIT_L(0); PG8_MMA(0, 0, At, B0); PG8_BAR; PG8_SCHED;
            PG8_LDB(B1, 1, 1); PG8_STAGE(PG8_SB(1, 0), b3, voffB);
            PG8_BAR; PG8_WAIT_L(0); PG8_MMA(0, 1, At, B1); PG8_BAR;
            PG8_LDA(At, 1, 1); PG8_STAGE(PG8_SA(1, 0), a3, voffA);
            PG8_BAR; PG8_WAIT_L(0); PG8_MMA(1, 0, At, B0); PG8_BAR; PG8_SCHED;
            PG8_STAGE(PG8_SB(1, 1), b3 + hstep, voffB);
            PG8_WAIT_V(6); PG8_BAR; PG8_MMA(1, 1, At, B1); PG8_BAR;
            }
        }
        if constexpr (ALIGN_EPI) { if (wr == 0) PG8_BAR; }
        if constexpr (!Epi::AFTER_DRAIN) { E(acc, cur, wr, wc, fr, fq); S.done(cur); }
        if (!has_next) break;
#pragma unroll
        for (int a = 0; a < 2; ++a)
#pragma unroll
            for (int b = 0; b < 2; ++b)
#pragma unroll
                for (int m = 0; m < 4; ++m)
#pragma unroll
                    for (int n = 0; n < 2; ++n) acc[a][b][m][n] = (f32x4){0.f, 0.f, 0.f, 0.f};
        cur = nxt; cA = nA; cB = nB; ++ui;
        if constexpr (ALIGN_EPI) { if (wr == 1) PG8_BAR; }
    }
    PG8_WAIT_V(0);
    if constexpr (!ALIGN_EPI) { if (wr == 0) PG8_BAR; }
    PG8_BAR;
    if constexpr (Epi::AFTER_DRAIN) { E.fused(acc, cur, wr, wc, fr, fq, lds, wid, lane); S.done(cur); }
#undef PG8_SA
#undef PG8_SB
#undef PG8_STAGE
#undef PG8_LDA
#undef PG8_LDB
#undef PG8_MMA
#undef PG8_WAIT_V
#undef PG8_WAIT_L
#undef PG8_BAR
#undef PG8_SCHED
}
}

__device__ __forceinline__ float fsigmoid(float x) { return __builtin_amdgcn_rcpf(1.0f + __builtin_amdgcn_exp2f(-1.4426950408889634f * x)); }
__device__ __forceinline__ float fgelu_tanh(float x) { const float u2 = 1.5957691216057308f * (x + 0.044715f * x * x * x); return x * fsigmoid(u2); }
__device__ __forceinline__ h16x8 pack8(const f32x4 a, const f32x4 b) {
    h16x8 o; o[0] = (h16)a[0]; o[1] = (h16)a[1]; o[2] = (h16)a[2]; o[3] = (h16)a[3]; o[4] = (h16)b[0]; o[5] = (h16)b[1]; o[6] = (h16)b[2]; o[7] = (h16)b[3]; return o;
}
struct EpiProjF {
    static constexpr bool PERM = true, AFTER_DRAIN = false, MIDK = false;
    unsigned char* ws;
    __device__ __forceinline__ void operator()(const f32x4 (&acc)[2][2][4][2], const pg8::Unit& u, int wr, int wc, int fr, int fq) const {
        const float* RSTD1 = (const float*)(ws + WS_RSTD1);
        const int row0 = u.pm * 256 + wr * 64 + fr, pn = u.pn, c8 = wc * 32 + 8 * fq;
#pragma unroll
        for (int ai = 0; ai < 2; ++ai)
#pragma unroll
            for (int m = 0; m < 4; ++m) {
                const int row = row0 + ai * 128 + m * 16; const float rs = RSTD1[row];
#pragma unroll
                for (int bj = 0; bj < 2; ++bj) {
                    f32x4 v0 = acc[ai][bj][m][0] * rs, v1 = acc[ai][bj][m][1] * rs;
                    const int cb = bj * 128 + c8;
                    if (pn < 2) { *(h16x8*)((h16*)(ws + WS_XR) + (size_t)row * 512 + pn * 256 + cb) = pack8(v0, v1); }
                    else if (pn < 4) {
#pragma unroll
                        for (int e = 0; e < 4; ++e) { v0[e] = fgelu_tanh(v0[e]); v1[e] = fgelu_tanh(v1[e]); }
                        *(h16x8*)((h16*)(ws + WS_GRG) + (size_t)row * 512 + (pn - 2) * 256 + cb) = pack8(v0, v1); }
                    else if (pn < 6) { *(h16x8*)((h16*)(ws + WS_Q) + (size_t)row * 512 + (pn - 4) * 256 + cb) = pack8(v0, v1); }
                    else if (pn < 9) {
                        const int idx = 2 * (pn - 6) + bj, g = c8 >> 6, d = c8 & 63, b = row >> 12, t = row & 4095;
                        h16* base = (h16*)(ws + (idx == 0 ? WS_KCT : idx == 1 ? WS_VCT : idx == 2 ? WS_KS : idx == 3 ? WS_VS : idx == 4 ? WS_KW : WS_VW));
                        *(h16x8*)(base + ((size_t)(b * 2 + g) * T + t) * 64 + d) = pack8(v0, v1); }
                    else if (bj == 0 && c8 < 24) {
                        float* gp = (float*)(ws + WS_GATE) + (size_t)row * 24 + c8;
#pragma unroll
                        for (int e = 0; e < 4; ++e) { v0[e] = fsigmoid(v0[e]); v1[e] = fsigmoid(v1[e]); }
                        *(f32x4*)gp = v0; *(f32x4*)(gp + 4) = v1; }
                }
            }
    }
};
struct EpiOutF {
    static constexpr bool PERM = false, AFTER_DRAIN = false, MIDK = true;
    const float* x; float* out; h16* x1h; const float* rsr; const float* ssa2; float* ss2p;
    __device__ __forceinline__ float rsa_of(int row) const { const f32x2 a = *(const f32x2*)(ssa2 + (size_t)row * 2); return 1.0f / sqrtf((a[0] + a[1]) * (1.0f / 512.0f) + EPS); }
    __device__ __forceinline__ void mid(f32x4 (&acc)[2][2][4][2], const pg8::Unit& u, int wr, int wc, int fr, int fq) const {
        int row0 = u.pm * 256 + wr * 64 + fr; asm volatile("" : "+v"(row0));
#pragma unroll
        for (int ai = 0; ai < 2; ++ai)
#pragma unroll
            for (int m = 0; m < 4; ++m) { const int row = row0 + ai * 128 + m * 16; const float ratio = rsr[row] / rsa_of(row);
#pragma unroll
                for (int bj = 0; bj < 2; ++bj)
#pragma unroll
                    for (int n = 0; n < 2; ++n) acc[ai][bj][m][n] *= ratio; }
    }
    __device__ __forceinline__ void operator()(const f32x4 (&acc)[2][2][4][2], const pg8::Unit& u, int wr, int wc, int fr, int fq) const {
        const int row0 = u.pm * 256 + wr * 64 + fr, col0 = u.pn * 256 + wc * 32 + 4 * fq;
#pragma unroll
        for (int ai = 0; ai < 2; ++ai)
#pragma unroll
            for (int m = 0; m < 4; ++m) { const int row = row0 + ai * 128 + m * 16; const float s2 = rsa_of(row); float ss = 0.f;
#pragma unroll
                for (int bj = 0; bj < 2; ++bj)
#pragma unroll
                    for (int n = 0; n < 2; ++n) { const size_t off = (size_t)row * D + col0 + bj * 128 + n * 16;
                        const f32x4 v = *(const f32x4*)(x + off) + acc[ai][bj][m][n] * s2;
                        *(f32x4*)(out + off) = v; h16x4 h; h[0] = (h16)v[0]; h[1] = (h16)v[1]; h[2] = (h16)v[2]; h[3] = (h16)v[3]; *(h16x4*)(x1h + off) = h;
                        ss += (v[0] * v[0] + v[1] * v[1]) + (v[2] * v[2] + v[3] * v[3]); }
                ss += __shfl_xor(ss, 16); ss += __shfl_xor(ss, 32);
                if (fq == 0) ss2p[(size_t)row * 16 + u.pn * 4 + wc] = ss;
                if (m & 1) asm volatile("" ::: "memory"); }
    }
};
struct EpiGUF {
    static constexpr bool PERM = true, AFTER_DRAIN = false, MIDK = false;
    h16* hm; const float* ss2p;
    __device__ __forceinline__ void operator()(const f32x4 (&acc)[2][2][4][2], const pg8::Unit& u, int wr, int wc, int fr, int fq) const {
        const int row0 = u.pm * 256 + wr * 64 + fr, col = u.pn * 128 + wc * 32 + 8 * fq;
#pragma unroll
        for (int ai = 0; ai < 2; ++ai)
#pragma unroll
            for (int m = 0; m < 4; ++m) { const int row = row0 + ai * 128 + m * 16; const f32x4* sp = (const f32x4*)(ss2p + (size_t)row * 16);
                const f32x4 s0 = sp[0], s1 = sp[1], s2 = sp[2], s3 = sp[3];
                const float tot = ((s0[0] + s0[1]) + (s0[2] + s0[3])) + ((s1[0] + s1[1]) + (s1[2] + s1[3])) + ((s2[0] + s2[1]) + (s2[2] + s2[3])) + ((s3[0] + s3[1]) + (s3[2] + s3[3]));
                const float rs = 1.0f / sqrtf(tot * (1.0f / D) + EPS);
                f32x4 o[2];
#pragma unroll
                for (int n = 0; n < 2; ++n) { const f32x4 g = acc[ai][0][m][n] * rs, uu = acc[ai][1][m][n] * rs;
#pragma unroll
                    for (int e = 0; e < 4; ++e) o[n][e] = g[e] * fsigmoid(g[e]) * uu[e]; }
                *(h16x8*)(hm + (size_t)row * DFF + col) = pack8(o[0], o[1]); }
    }
};
struct EpiDownF {
    static constexpr bool PERM = false, AFTER_DRAIN = false, MIDK = false;
    float* out;
    __device__ __forceinline__ void operator()(const f32x4 (&acc)[2][2][4][2], const pg8::Unit& u, int wr, int wc, int fr, int fq) const {
        const int row0 = u.pm * 256 + wr * 64 + fr, col0 = u.pn * 256 + wc * 32 + 4 * fq;
#pragma unroll
        for (int ai = 0; ai < 2; ++ai)
#pragma unroll
            for (int m = 0; m < 4; ++m) { const int row = row0 + ai * 128 + m * 16;
#pragma unroll
                for (int bj = 0; bj < 2; ++bj)
#pragma unroll
                    for (int n = 0; n < 2; ++n) { float* p = out + (size_t)row * D + col0 + bj * 128 + n * 16; *(f32x4*)p = *(const f32x4*)p + acc[ai][bj][m][n]; } }
    }
};

__device__ __forceinline__ void normrope_rows(const Params& P, int gw, int ngw, int lane) {
    unsigned char* ws = P.ws;
    const float* ROPE = (const float*)(ws + WS_ROPE);
    const int sub = lane & 7;
    for (int m = gw; m < M; m += ngw) {
        const int b = m >> 12, t = m & 4095;
        float cs[8], sn[8];
#pragma unroll
        for (int i = 0; i < 8; ++i) { cs[i] = ROPE[m * 16 + i]; sn[i] = ROPE[m * 16 + 8 + i]; }
#pragma unroll
        for (int which = 0; which < 3; ++which) {
            h16* p; const float* nw; float scale;
            bool act = true;
            if (which == 0) { p = (h16*)(ws + WS_Q) + (size_t)m * 512 + (lane >> 3) * 64 + sub * 8; nw = P.q_norm_w; scale = C2; }
            else { act = lane < 16; const int g = (lane >> 3) & 1; p = (h16*)(ws + (which == 1 ? WS_KS : WS_KW)) + ((size_t)(b * 2 + g) * T + t) * 64 + sub * 8; nw = P.k_norm_w; scale = 1.0f; }
            float v[8]; float ss = 0.f;
            if (act) { const h16x8 h = *(const h16x8*)p;
#pragma unroll
                for (int e = 0; e < 8; ++e) { v[e] = (float)h[e]; ss += v[e] * v[e]; } }
            else {
#pragma unroll
                for (int e = 0; e < 8; ++e) v[e] = 0.f; }
            ss += __shfl_xor(ss, 1); ss += __shfl_xor(ss, 2); ss += __shfl_xor(ss, 4);
            const float rstd = 1.0f / sqrtf(ss * (1.0f / 64.0f) + EPS);
#pragma unroll
            for (int e = 0; e < 8; ++e) v[e] = v[e] * rstd * nw[sub * 8 + e];
            float o[8];
#pragma unroll
            for (int e = 0; e < 8; ++e) {
                const float other = __shfl_xor(v[e], 1);
                if (sub == 0) o[e] = v[e] * cs[e] - other * sn[e];
                else if (sub == 1) o[e] = v[e] * cs[e] + other * sn[e];
                else o[e] = v[e];
            }
            if (act) { h16x8 h;
#pragma unroll
                for (int e = 0; e < 8; ++e) h[e] = (h16)(o[e] * scale);
                *(h16x8*)p = h; }
        }
    }
}

__device__ __forceinline__ void rglru_local(const Params& P, unsigned char* lds, int tid, int lane, int wave, int bid, int nb) {
    unsigned char* ws = P.ws;
    float* WA = (float*)lds;
    float* WX = WA + 4096;
    float* XC = WX + 4096 + wave * 64;
    const h16* XR = (const h16*)(ws + WS_XR);
    h16* HL = (h16*)(ws + WS_HL); h16* AC = (h16*)(ws + WS_AC); float* AGG = (float*)(ws + WS_AGG);
    for (int item = bid; item < 8 * 8 * 32; item += nb) {
        const int n = item & 7, b = (item >> 3) & 7, ck = item >> 6;
        __syncthreads();
        for (int e = tid; e < 4096; e += NTHREADS) { WA[e] = P.gate_a_w[n * 4096 + e]; WX[e] = P.gate_x_w[n * 4096 + e]; }
        __syncthreads();
        const int ch = n * 64 + lane;
        const float cw0 = P.conv_w[0 * 512 + ch], cw1 = P.conv_w[1 * 512 + ch], cw2 = P.conv_w[2 * 512 + ch], cw3 = P.conv_w[3 * 512 + ch], cb = P.conv_b[ch];
        const float ba = P.gate_a_b[ch], bx = P.gate_x_b[ch];
        const float lam = P.lru_lambda[ch];
        const float sp8 = -8.0f * log1pf(expf(-lam));
        const int seg = ck * 8 + wave, t0 = seg * 16;
        const size_t mrow = (size_t)b * T + t0;
        float x0 = (t0 >= 3) ? (float)XR[(mrow - 3) * 512 + ch] : 0.f;
        float x1 = (t0 >= 2) ? (float)XR[(mrow - 2) * 512 + ch] : 0.f;
        float x2 = (t0 >= 1) ? (float)XR[(mrow - 1) * 512 + ch] : 0.f;
        float h = 0.f, Acum = 1.0f;
        for (int tt = 0; tt < 16; ++tt) {
            const float x3 = (float)XR[(mrow + tt) * 512 + ch];
            const float xc = cb + cw0 * x0 + cw1 * x1 + cw2 * x2 + cw3 * x3;
            x0 = x1; x1 = x2; x2 = x3;
            LDS_WAIT();
            XC[lane] = xc;
            LDS_WAIT();
            float sa = ba, sx = bx;
#pragma unroll 16
            for (int d = 0; d < 64; ++d) { const float xd = XC[d]; sa += xd * WA[d * 64 + lane]; sx += xd * WX[d * 64 + lane]; }
            const float r = sigmoidf_(sa), ig = sigmoidf_(sx);
            const float la = sp8 * r;
            const float a = expf(la);
            const float bq = sqrtf(-expm1f(2.0f * la)) * (ig * xc);
            h = a * h + bq; Acum *= a;
            HL[(mrow + tt) * 512 + ch] = (h16)h; AC[(mrow + tt) * 512 + ch] = (h16)Acum;
        }
        float* ag = AGG + (((size_t)(b * 8 + n) * 256 + seg) * 2) * 64;
        ag[lane] = Acum; ag[64 + lane] = h;
    }
}

__device__ __forceinline__ void rglru_fixup(const Params& P, int gw, int ngw, int lane) {
    unsigned char* ws = P.ws;
    const h16* HL = (const h16*)(ws + WS_HL); const h16* AC = (const h16*)(ws + WS_AC); const h16* GRG = (const h16*)(ws + WS_GRG);
    const float* AGG = (const float*)(ws + WS_AGG);
    h16* Y = (h16*)(ws + WS_Y); float* RSR = (float*)(ws + WS_SSR);
    for (int item = gw; item < 8 * 256; item += ngw) {
        const int seg = item & 255, b = item >> 8;
        const size_t mrow = (size_t)b * T + seg * 16;
        float ssq = 0.f;
        for (int n = 0; n < 8; ++n) {
            const float* ag = AGG + ((size_t)(b * 8 + n) * 256) * 128;
            float carry = 0.f;
            for (int s = 0; s < seg; ++s) carry = ag[s * 128 + lane] * carry + ag[s * 128 + 64 + lane];
            const int ch = n * 64 + lane;
            for (int tt = 0; tt < 16; ++tt) {
                const size_t m = mrow + tt;
                const float hv = (float)HL[m * 512 + ch] + (float)AC[m * 512 + ch] * carry;
                const float y = (float)GRG[m * 512 + ch] * hv;
                Y[m * 1024 + ch] = (h16)y;
                const float ss = wave_sum(y * y);
                if (lane == tt) ssq += ss;
            }
        }
        if (lane < 16) RSR[mrow + lane] = 1.0f / sqrtf(ssq * (1.0f / 512.0f) + EPS);
    }
}

__device__ __forceinline__ void compress_finish(const Params& P, int gw, int ngw, int lane) {
    unsigned char* ws = P.ws;
    const float* CR = (const float*)(ws + WS_CRAW); const float* ROPE = (const float*)(ws + WS_ROPE);
    h16* KCC = (h16*)(ws + WS_KCC); h16* VCC = (h16*)(ws + WS_VCC);
    for (int r = gw; r < 4096; r += ngw) {
        const int bg = r >> 8, c = r & 255, b = bg >> 1;
        float kv = CR[(size_t)r * 64 + lane], vv = CR[(size_t)(4096 + r) * 64 + lane];
        if (c == 255) { KCC[(size_t)r * 64 + lane] = (h16)0.f; VCC[(size_t)r * 64 + lane] = (h16)0.f; continue; }
        const float ss = wave_sum(kv * kv);
        kv = kv * (1.0f / sqrtf(ss * (1.0f / 64.0f) + EPS)) * P.k_norm_w[lane];
        const int mp = b * T + 16 * c + 31;
        const float other = __shfl_xor(kv, 8);
        float o = kv;
        if (lane < 8) o = kv * ROPE[mp * 16 + lane] - other * ROPE[mp * 16 + 8 + lane];
        else if (lane < 16) o = kv * ROPE[mp * 16 + lane - 8] + other * ROPE[mp * 16 + 8 + lane - 8];
        KCC[(size_t)r * 64 + lane] = (h16)o; VCC[(size_t)r * 64 + lane] = (h16)vv;
    }
}

__device__ __forceinline__ void qk4(const h16* krow, const float* qs, float (&s)[4]) {
    s[0] = s[1] = s[2] = s[3] = 0.f;
#pragma unroll
    for (int c = 0; c < 8; ++c) {
        const h16x8 k8 = *(const h16x8*)(krow + c * 8);
#pragma unroll
        for (int e = 0; e < 8; ++e) { const float kf = (float)k8[e];
#pragma unroll
            for (int h = 0; h < 4; ++h) s[h] += qs[h * 64 + c * 8 + e] * kf; }
    }
}
__device__ __forceinline__ void attn_group(const h16* Kb, const h16* Vb, int key, bool valid, int nk, const float* qs, float* ps,
                                           float (&mx)[4], float (&l)[4], float (&o)[4], int lane) {
    float s[4];
    qk4(Kb + (size_t)(valid ? key : 0) * 64, qs, s);
    float p[4];
#pragma unroll
    for (int h = 0; h < 4; ++h) {
        const float sv = valid ? s[h] : -INFINITY;
        const float mn = fmaxf(mx[h], wave_max(sv));
        const float f = exp2f(mx[h] - mn);
        p[h] = exp2f(sv - mn);
        l[h] = l[h] * f + wave_sum(p[h]); o[h] *= f; mx[h] = mn;
    }
    LDS_WAIT();
    *(f32x4*)(ps + lane * 4) = (f32x4){p[0], p[1], p[2], p[3]};
    LDS_WAIT();
    const int k0 = key - lane;
    for (int kk = 0; kk < nk; ++kk) {
        const float v = (float)Vb[(size_t)(k0 + kk) * 64 + lane];
        const f32x4 pv = *(const f32x4*)(ps + kk * 4);
        o[0] += pv.x * v; o[1] += pv.y * v; o[2] += pv.z * v; o[3] += pv.w * v;
    }
}
__device__ __forceinline__ void attn_naive(const Params& P, unsigned char* lds, int lane, int wave, int gw, int ngw) {
    unsigned char* ws = P.ws;
    float* qs = (float*)lds + wave * (256 + 1024);
    float* ps = qs + 256;
    const h16* QN = (const h16*)(ws + WS_Q);
    const h16* KCC = (const h16*)(ws + WS_KCC); const h16* VCC = (const h16*)(ws + WS_VCC);
    const h16* KS = (const h16*)(ws + WS_KS); const h16* VS = (const h16*)(ws + WS_VS);
    const h16* KW = (const h16*)(ws + WS_KW); const h16* VW = (const h16*)(ws + WS_VW);
    const float* GATE = (const float*)(ws + WS_GATE);
    h16* Y = (h16*)(ws + WS_Y); float* SSA = (float*)(ws + WS_SSA);
    for (int item = gw; item < M * 2; item += ngw) {
        const int g = item & 1, m = item >> 1, b = m >> 12, t = m & 4095, bg = b * 2 + g;
        LDS_WAIT();
#pragma unroll
        for (int h = 0; h < 4; ++h) qs[h * 64 + lane] = (float)QN[(size_t)m * 512 + (4 * g + h) * 64 + lane];
        LDS_WAIT();
        const int nvalid = (t >= 31) ? ((t - 31) >> 4) + 1 : 0;
        float sc[4][4];
#pragma unroll
        for (int i = 0; i < 4; ++i) {
            const int c = lane + 64 * i;
            float s[4]; qk4(KCC + ((size_t)bg * 256 + c) * 64, qs, s);
#pragma unroll
            for (int h = 0; h < 4; ++h) sc[i][h] = (c < nvalid) ? s[h] : -INFINITY;
        }
#pragma unroll
        for (int h = 0; h < 4; ++h) {
            float mxv = fmaxf(fmaxf(sc[0][h], sc[1][h]), fmaxf(sc[2][h], sc[3][h]));
            mxv = wave_max(mxv);
            if (!(mxv > -INFINITY)) mxv = 0.f;
            float ls = 0.f;
#pragma unroll
            for (int i = 0; i < 4; ++i) { sc[i][h] = exp2f(sc[i][h] - mxv); ls += sc[i][h]; }
            ls = wave_sum(ls);
            const float inv = 1.0f / fmaxf(ls, 1e-30f);
#pragma unroll
            for (int i = 0; i < 4; ++i) sc[i][h] *= inv;
        }
#pragma unroll
        for (int i = 0; i < 4; ++i) *(f32x4*)(ps + (lane + 64 * i) * 4) = (f32x4){sc[i][0], sc[i][1], sc[i][2], sc[i][3]};
        LDS_WAIT();
        float ocmp[4] = {0.f, 0.f, 0.f, 0.f};
        for (int c = 0; c < nvalid; ++c) {
            const float v = (float)VCC[((size_t)bg * 256 + c) * 64 + lane];
            const f32x4 pv = *(const f32x4*)(ps + c * 4);
            ocmp[0] += pv.x * v; ocmp[1] += pv.y * v; ocmp[2] += pv.z * v; ocmp[3] += pv.w * v;
        }
        float imp = 0.f;
        {
#pragma unroll
            for (int e = 0; e < 4; ++e) { const f32x4 pv = *(const f32x4*)(ps + (4 * lane + e) * 4); const float sh = (pv.x + pv.y) + (pv.z + pv.w); imp += (e == 3) ? 0.5f * sh : sh; }
            if (lane >= 1) { const f32x4 pv = *(const f32x4*)(ps + (4 * lane - 1) * 4); imp += 0.5f * ((pv.x + pv.y) + (pv.z + pv.w)); }
        }
        const int cur = t >> 6;
        const bool forced = (lane == 0) || (lane == cur) || (lane == cur - 1);
        const bool cand = !forced && lane < cur - 1;
        const int quota = 16 - (1 + (cur >= 1 ? 1 : 0) + (cur >= 2 ? 1 : 0));
        int rank = 0;
        for (int j2 = 0; j2 < 64; ++j2) {
            const float io = __shfl(imp, j2); const int co = __shfl((int)cand, j2);
            if (co && (io > imp || (io == imp && j2 < lane))) ++rank;
        }
        const bool sel = forced || (cand && rank < quota);
        unsigned long long mask = __ballot(sel);
        float mx[4] = {-INFINITY, -INFINITY, -INFINITY, -INFINITY}, ls[4] = {0.f, 0.f, 0.f, 0.f}, os[4] = {0.f, 0.f, 0.f, 0.f};
        while (mask) {
            const int j = __builtin_ctzll(mask); mask &= mask - 1;
            const int key = 64 * j + lane; const int nk = min(64, t - 64 * j + 1);
            attn_group(KS + (size_t)bg * T * 64, VS + (size_t)bg * T * 64, key, key <= t, nk, qs, ps, mx, ls, os, lane);
        }
        float mw[4] = {-INFINITY, -INFINITY, -INFINITY, -INFINITY}, lw[4] = {0.f, 0.f, 0.f, 0.f}, ow[4] = {0.f, 0.f, 0.f, 0.f};
        for (int k0 = max(0, t - 511); k0 <= t; k0 += 64) {
            const int key = k0 + lane; const int nk = min(64, t - k0 + 1);
            attn_group(KW + (size_t)bg * T * 64, VW + (size_t)bg * T * 64, key, key <= t, nk, qs, ps, mw, lw, ow, lane);
        }
        float ssq = 0.f;
#pragma unroll
        for (int h = 0; h < 4; ++h) {
            const float* gp = GATE + (size_t)m * 24 + (4 * g + h) * 3;
            const float o = gp[0] * ocmp[h] + gp[1] * os[h] / ls[h] + gp[2] * ow[h] / lw[h];
            Y[(size_t)m * 1024 + 512 + (4 * g + h) * 64 + lane] = (h16)o;
            ssq += o * o;
        }
        ssq = wave_sum(ssq);
        if (lane == 0) SSA[m * 2 + g] = ssq;
    }
}

#ifndef PHMASK
#define PHMASK 0x3ff
#endif
constexpr int NPHASE = 10;
#ifndef FAST_GEMM
#define FAST_GEMM 7
#endif
constexpr int LDS_BYTES = 147456;
__global__ void __launch_bounds__(NTHREADS, 2) hymba_fwd(Params P) {
    extern __shared__ __attribute__((aligned(16))) unsigned char lds[];
    cg::grid_group grid = cg::this_grid();
    const int tid = threadIdx.x, lane = tid & 63, wave = __builtin_amdgcn_readfirstlane(tid >> 6);
    const int bid = blockIdx.x, nb = gridDim.x;
    const int gw = bid * NWAVES + wave, ngw = nb * NWAVES;
    unsigned char* ws = P.ws;
    const int lo = P.ph_lo, hi = P.ph_hi;
#define PH_BEGIN(k) if (lo <= (k) && (k) < hi) { if ((k) > lo) grid.sync();
#define PH_END }
#if PHMASK & (1 << 0)
        PH_BEGIN(0) phase0(P, lds, tid, lane, wave, bid, nb); PH_END
#endif
#if PHMASK & (1 << 1)
        PH_BEGIN(1) {
#if FAST_GEMM & 1
            pg8::Gemm g{(const pg8::bf16_t*)(ws + WS_XH), (const pg8::bf16_t*)(ws + WS_WIN), M, NP1, 1024}; pg8::StaticOrder S; S.init(M, NP1, nb, bid);
            pg8::gemm_phase<EpiProjF, pg8::StaticOrder, true, true>((PG8_LAS unsigned char*)lds, g, S, EpiProjF{ws});
#else
            GemmN g{(const h16*)(ws + WS_XH), 1024, (const h16*)(ws + WS_WIN), 1024, 1024, nullptr, 0, nullptr, 0, 0, M, NP1, 0};
            gemm_naive<false>(g, EpiProj{ws}, gw, ngw, lane);
#endif
        } PH_END
#endif
#if PHMASK & (1 << 2)
        PH_BEGIN(2) {
            normrope_rows(P, gw, ngw, lane);
            rglru_local(P, lds, tid, lane, wave, bid, nb);
            for (int w = 0; w < 2; ++w) {
                GemmN g{(const h16*)(ws + (w ? WS_VCT : WS_KCT)), 1024, (const h16*)(ws + (w ? WS_W1V : WS_W1K)), CMPK, CMPK, nullptr, 0, nullptr, 0, 0, 4096, CMPH, 0};
                gemm_naive<false>(g, EpiCmpA{(h16*)(ws + WS_H1) + (size_t)w * 4096 * CMPH, (const float*)(ws + WS_B1) + w * 256}, gw, ngw, lane);
            }
        } PH_END
#endif
#if PHMASK & (1 << 3)
        PH_BEGIN(3) {
            for (int w = 0; w < 2; ++w) {
                GemmN g{(const h16*)(ws + WS_H1) + (size_t)w * 4096 * CMPH, CMPH, (const h16*)(ws + (w ? WS_W2V : WS_W2K)), CMPH, CMPH, nullptr, 0, nullptr, 0, 0, 4096, HD, 0};
                gemm_naive<false>(g, EpiCmpB{(float*)(ws + WS_CRAW) + (size_t)w * 4096 * HD}, gw, ngw, lane);
            }
        } PH_END
#endif
#if PHMASK & (1 << 4)
        PH_BEGIN(4) compress_finish(P, gw, ngw, lane); PH_END
#endif
#if PHMASK & (1 << 5)
        PH_BEGIN(5) {
            rglru_fixup(P, gw, ngw, lane);
            attn_naive(P, lds, lane, wave, gw, ngw);
        } PH_END
#endif
#if PHMASK & (1 << 6)
        PH_BEGIN(6) {
#if FAST_GEMM & 2
            pg8::Gemm g{(const pg8::bf16_t*)(ws + WS_Y), (const pg8::bf16_t*)(ws + WS_WOUT), M, D, 1024}; pg8::StaticOrder S; S.init(M, D, nb, bid);
            pg8::gemm_phase<EpiOutF, pg8::StaticOrder, true, true>((PG8_LAS unsigned char*)lds, g, S,
                EpiOutF{P.x, P.out, (h16*)(ws + WS_X1H), (const float*)(ws + WS_SSR), (const float*)(ws + WS_SSA), (float*)(ws + WS_SS2P)});
#else
            const h16* Y = (const h16*)(ws + WS_Y); const h16* W = (const h16*)(ws + WS_WOUT);
            GemmN g{Y, 1024, W, 1024, 512, Y + 512, 1024, W + 512, 1024, 512, M, D, 0};
            gemm_naive<true>(g, EpiOut{P.x, P.out, (h16*)(ws + WS_X1H), (const float*)(ws + WS_SSR), (const float*)(ws + WS_SSA)}, gw, ngw, lane);
#endif
        } PH_END
#endif
#if PHMASK & (1 << 7)
        PH_BEGIN(7) {
            float* RSTD2 = (float*)(ws + WS_RSTD2);
            for (int m = gw; m < ((FAST_GEMM & 2) ? 0 : M); m += ngw) {
                const f32x4* xr = (const f32x4*)(P.out + (size_t)m * D) + lane; float s = 0.f;
#pragma unroll
                for (int j = 0; j < 4; ++j) { const f32x4 v = xr[64 * j]; s += (v.x * v.x + v.y * v.y) + (v.z * v.z + v.w * v.w); }
                s = wave_sum(s);
                if (lane == 0) RSTD2[m] = 1.0f / sqrtf(s * (1.0f / D) + EPS);
            }
        } PH_END
#endif
#if PHMASK & (1 << 8)
        PH_BEGIN(8) {
#if FAST_GEMM & 2
            pg8::Gemm g{(const pg8::bf16_t*)(ws + WS_X1H), (const pg8::bf16_t*)(ws + WS_WGU), M, 2 * DFF, 1024}; pg8::StaticOrder S; S.init(M, 2 * DFF, nb, bid);
            pg8::gemm_phase<EpiGUF, pg8::StaticOrder, true, true>((PG8_LAS unsigned char*)lds, g, S, EpiGUF{(h16*)(ws + WS_HM), (const float*)(ws + WS_SS2P)});
#else
            const h16* A = (const h16*)(ws + WS_X1H); const h16* W = (const h16*)(ws + WS_WGU);
            GemmN g{A, 1024, W, 1024, 1024, A, 1024, W, 1024, 1024, M, DFF, 1};
            gemm_naive<true>(g, EpiGU{(h16*)(ws + WS_HM), (const float*)(ws + WS_RSTD2)}, gw, ngw, lane);
#endif
        } PH_END
#endif
#if PHMASK & (1 << 9)
        PH_BEGIN(9) {
#if FAST_GEMM & 4
            pg8::Gemm g{(const pg8::bf16_t*)(ws + WS_HM), (const pg8::bf16_t*)(ws + WS_WD), M, D, DFF}; pg8::StaticOrder S; S.init(M, D, nb, bid);
            pg8::gemm_phase<EpiDownF, pg8::StaticOrder, true, true>((PG8_LAS unsigned char*)lds, g, S, EpiDownF{P.out});
#else
            GemmN g{(const h16*)(ws + WS_HM), DFF, (const h16*)(ws + WS_WD), DFF, DFF, nullptr, 0, nullptr, 0, 0, M, D, 0};
            gemm_naive<false>(g, EpiDown{P.out}, gw, ngw, lane);
#endif
        } PH_END
#endif
}

#ifndef N_LAUNCH_PER_PHASE
#define N_LAUNCH_PER_PHASE 0
#endif
extern "C" void kernel_launch(void* const* d_in, const int* in_sizes, int n_in, void* d_out, int out_size, void* d_ws, size_t ws_size, hipStream_t stream) {
    static int grid = 0;
    if (grid == 0) {
        if (n_in != 25 || in_sizes[0] != M * D || out_size != M * D || ws_size < WS_END) {
            fprintf(stderr, "kernel_launch: unexpected problem (n_in %d, in0 %d, out %d, ws %zu)\n", n_in, n_in > 0 ? in_sizes[0] : -1, out_size, ws_size); grid = -1; return; }
        int dev = 0, cus = 0, per_cu = 0;
        hipGetDevice(&dev);
        hipDeviceGetAttribute(&cus, hipDeviceAttributeMultiprocessorCount, dev);
        hipFuncSetAttribute((const void*)hymba_fwd, hipFuncAttributeMaxDynamicSharedMemorySize, LDS_BYTES);
        hipOccupancyMaxActiveBlocksPerMultiprocessor(&per_cu, (const void*)hymba_fwd, NTHREADS, LDS_BYTES);
        if (per_cu < 1) { fprintf(stderr, "kernel_launch: occupancy query says %d blocks per CU\n", per_cu); grid = -1; return; }
        grid = cus;
    }
    if (grid < 0) return;
    Params p{};
    const float** pf = (const float**)&p;
    for (int i = 0; i < 25; ++i) pf[i] = (const float*)d_in[i];
    p.out = (float*)d_out; p.ws = (unsigned char*)d_ws;
#if N_LAUNCH_PER_PHASE
    for (int ph = 0; ph < NPHASE; ++ph) {
        p.ph_lo = ph; p.ph_hi = ph + 1;
        void* args[] = {&p};
        hipError_t e = hipLaunchCooperativeKernel((const void*)hymba_fwd, dim3(grid), dim3(NTHREADS), args, LDS_BYTES, stream);
        if (e != hipSuccess) { fprintf(stderr, "launch failed: %s\n", hipGetErrorString(e)); return; }
    }
#else
    p.ph_lo = 0; p.ph_hi = NPHASE;
    void* args[] = {&p};
    hipError_t e = hipLaunchCooperativeKernel((const void*)hymba_fwd, dim3(grid), dim3(NTHREADS), args, LDS_BYTES, stream);
    if (e != hipSuccess) fprintf(stderr, "launch failed: %s\n", hipGetErrorString(e));
#endif
}
```

```cpp
#include <hip/hip_runtime.h>
#include <hip/hip_cooperative_groups.h>
#include <cstdio>
#include <cstdint>
namespace cg = cooperative_groups;

typedef _Float16 h16;
typedef _Float16 h16x8 __attribute__((ext_vector_type(8)));
typedef _Float16 h16x4 __attribute__((ext_vector_type(4)));
typedef _Float16 h16x2 __attribute__((ext_vector_type(2)));
typedef float f32x4 __attribute__((ext_vector_type(4)));
typedef float f32x2 __attribute__((ext_vector_type(2)));
typedef unsigned u32x4 __attribute__((ext_vector_type(4)));
typedef unsigned u32x2 __attribute__((ext_vector_type(2)));

constexpr int BATCH = 8, T = 4096, M = BATCH * T, D = 1024;
constexpr int DRNN = 512, NBLK = 8, DATT = 512, NH = 8, NKV = 2, HPG = 4, HD = 64;
constexpr int DIN = 2328, NP1 = 2560;
constexpr int DFF = 2816;
constexpr int NCMP = 255, NCP = 256;
constexpr int CMPK = 2048, CMPH = 256;
constexpr float EPS = 1e-6f;
constexpr float C2 = 0.125f * 1.4426950408889634f;
constexpr int NTHREADS = 512, NWAVES = 8;

constexpr size_t MiB = 1u << 20;
constexpr size_t WS_WIN = 0;
constexpr size_t WS_WOUT = 6 * MiB;
constexpr size_t WS_WGU = 8 * MiB;
constexpr size_t WS_WD = 20 * MiB;
constexpr size_t WS_W1K = 26 * MiB, WS_W1V = 27 * MiB;
constexpr size_t WS_W2K = 28 * MiB, WS_W2V = 28 * MiB + 65536;
constexpr size_t WS_B1 = 28 * MiB + 131072;
constexpr size_t WS_RSTD1 = 29 * MiB;
constexpr size_t WS_RSTD2 = 29 * MiB + 262144;
constexpr size_t WS_SS2P = 456 * MiB;
constexpr size_t WS_ROPE = 30 * MiB;
constexpr size_t WS_XH = 32 * MiB;
constexpr size_t WS_XR = 96 * MiB;
constexpr size_t WS_GRG = 128 * MiB;
constexpr size_t WS_Q = 160 * MiB;
constexpr size_t WS_HL = 192 * MiB;
constexpr size_t WS_HM = 32 * MiB;
constexpr size_t WS_AC = 224 * MiB;
constexpr size_t WS_KCT = 256 * MiB;
constexpr size_t WS_VCT = 265 * MiB;
constexpr size_t WS_KS = 274 * MiB, WS_VS = 282 * MiB, WS_KW = 290 * MiB, WS_VW = 298 * MiB;
constexpr size_t WS_GATE = 306 * MiB;
constexpr size_t WS_H1 = 310 * MiB;
constexpr size_t WS_CRAW = 314 * MiB;
constexpr size_t WS_KCC = 316 * MiB, WS_VCC = 317 * MiB;
constexpr size_t WS_AGG = 318 * MiB;
constexpr size_t WS_SSR = 326 * MiB, WS_SSA = 327 * MiB;
constexpr size_t WS_Y = 328 * MiB;
constexpr size_t WS_X1H = 392 * MiB;
constexpr size_t WS_END = 458 * MiB;

#define LDS_WAIT() asm volatile("s_waitcnt lgkmcnt(0)" ::: "memory")
__device__ __forceinline__ float wave_sum(float v) {
#pragma unroll
    for (int o = 1; o < 64; o <<= 1) v += __shfl_xor(v, o);
    return v;
}
__device__ __forceinline__ float wave_max(float v) {
#pragma unroll
    for (int o = 1; o < 64; o <<= 1) v = fmaxf(v, __shfl_xor(v, o));
    return v;
}
__device__ __forceinline__ float gelu_tanh(float x) {
    const float u = 0.7978845608028654f * (x + 0.044715f * x * x * x);
    return 0.5f * x * (1.0f + tanhf(u));
}
__device__ __forceinline__ float sigmoidf_(float x) { return 1.0f / (1.0f + __expf(-x)); }

struct Params {
    const float* x; const int* pos; const float* attn_norm_w; const float* w_in; const float* conv_w; const float* conv_b;
    const float* gate_a_w; const float* gate_a_b; const float* gate_x_w; const float* gate_x_b; const float* lru_lambda;
    const float* q_norm_w; const float* k_norm_w; const float* cmp_pos; const float* cmp_k_w1; const float* cmp_k_w2;
    const float* cmp_v_w1; const float* cmp_v_w2; const float* rnn_out_norm_w; const float* attn_out_norm_w; const float* w_out;
    const float* ffn_norm_w; const float* w_gate; const float* w_up; const float* w_down;
    float* out; unsigned char* ws; int ph_lo, ph_hi;
};

__device__ __forceinline__ void p0_transpose_item(const float* W, int K, int N, const float* s0, const float* s1, int ksplit,
                                                  h16* WT, int ldt, int mode, int nblk, float* scr, int item, int lane) {
    const int kb = item / nblk, nb = item % nblk, k0 = 64 * kb, n0 = 32 * nb;
#pragma unroll 8
    for (int i = 0; i < 32; ++i) {
        const int kk = 2 * i + (lane >> 5), n = n0 + (lane & 31), k = k0 + kk;
        float v = 0.f;
        if (n < N) { v = W[(size_t)k * N + n]; if (s0) v *= (k < ksplit) ? s0[k] : s1[k - ksplit]; }
        scr[kk * 33 + (lane & 31)] = v;
    }
    LDS_WAIT();
    const int c = lane & 7;
#pragma unroll
    for (int j = 0; j < 4; ++j) {
        const int nl = (lane >> 3) + 8 * j, n = n0 + nl;
        const float* s = scr + (8 * c) * 33 + nl;
        h16x8 o;
#pragma unroll
        for (int e = 0; e < 8; ++e) o[e] = (h16)s[e * 33];
        int orow = n;
        if (mode == 1) orow = (n >> 7) * 256 + (n & 127);
        else if (mode == 2) orow = (n >> 7) * 256 + (n & 127) + 128;
        *(h16x8*)(WT + (size_t)orow * ldt + k0 + 8 * c) = o;
    }
    LDS_WAIT();
}

__device__ __forceinline__ void phase0(const Params& P, unsigned char* lds, int tid, int lane, int wave, int bid, int nb) {
    unsigned char* ws = P.ws;
    float* scr = (float*)lds + wave * (64 * 33);
    const int gw = bid * NWAVES + wave, ngw = nb * NWAVES;
    constexpr int I_IN = 16 * 80, I_OUT = 16 * 32, I_G = 16 * 88, I_U = 16 * 88, I_D = 44 * 32, I_C1 = 32 * 8, I_C2 = 4 * 2;
    constexpr int NIT = I_IN + I_OUT + I_G + I_U + I_D + 2 * I_C1 + 2 * I_C2;
    for (int it = gw; it < NIT; it += ngw) {
        int r = it;
        const float* W; int K, N; const float* s0 = nullptr; const float* s1 = nullptr; int ksplit = 0; size_t wo; int ldt, mode = 0, nblk;
        if (r < I_IN) { W = P.w_in; K = 1024; N = DIN; s0 = P.attn_norm_w; s1 = P.attn_norm_w; ksplit = 1024; wo = WS_WIN; ldt = 1024; nblk = 80; }
        else if ((r -= I_IN) < I_OUT) { W = P.w_out; K = 1024; N = 1024; s0 = P.rnn_out_norm_w; s1 = P.attn_out_norm_w; ksplit = 512; wo = WS_WOUT; ldt = 1024; nblk = 32; }
        else if ((r -= I_OUT) < I_G) { W = P.w_gate; K = 1024; N = DFF; s0 = P.ffn_norm_w; s1 = P.ffn_norm_w; ksplit = 1024; wo = WS_WGU; ldt = 1024; mode = 1; nblk = 88; }
        else if ((r -= I_G) < I_U) { W = P.w_up; K = 1024; N = DFF; s0 = P.ffn_norm_w; s1 = P.ffn_norm_w; ksplit = 1024; wo = WS_WGU; ldt = 1024; mode = 2; nblk = 88; }
        else if ((r -= I_U) < I_D) { W = P.w_down; K = DFF; N = 1024; wo = WS_WD; ldt = DFF; nblk = 32; }
        else if ((r -= I_D) < I_C1) { W = P.cmp_k_w1; K = CMPK; N = CMPH; wo = WS_W1K; ldt = CMPK; nblk = 8; }
        else if ((r -= I_C1) < I_C1) { W = P.cmp_v_w1; K = CMPK; N = CMPH; wo = WS_W1V; ldt = CMPK; nblk = 8; }
        else if ((r -= I_C1) < I_C2) { W = P.cmp_k_w2; K = CMPH; N = HD; wo = WS_W2K; ldt = CMPH; nblk = 2; }
        else { r -= I_C2; W = P.cmp_v_w2; K = CMPH; N = HD; wo = WS_W2V; ldt = CMPH; nblk = 2; }
        p0_transpose_item(W, K, N, s0, s1, ksplit, (h16*)(ws + wo), ldt, mode, nblk, scr, r, lane);
    }
    h16* XH = (h16*)(ws + WS_XH); float* RSTD1 = (float*)(ws + WS_RSTD1);
    for (int m = gw; m < M; m += ngw) {
        const f32x4* xr = (const f32x4*)(P.x + (size_t)m * D) + lane;
        f32x4 v[4]; float s = 0.f;
#pragma unroll
        for (int j = 0; j < 4; ++j) { v[j] = xr[64 * j]; s += (v[j].x * v[j].x + v[j].y * v[j].y) + (v[j].z * v[j].z + v[j].w * v[j].w); }
        s = wave_sum(s);
        if (lane == 0) RSTD1[m] = 1.0f / sqrtf(s * (1.0f / D) + EPS);
        h16x4* o = (h16x4*)(XH + (size_t)m * D) + lane;
#pragma unroll
        for (int j = 0; j < 4; ++j) { h16x4 h; h.x = (h16)v[j].x; h.y = (h16)v[j].y; h.z = (h16)v[j].z; h.w = (h16)v[j].w; o[64 * j] = h; }
    }
    float* ROPE = (float*)(ws + WS_ROPE);
    for (int e = bid * NTHREADS + tid; e < M * 8; e += nb * NTHREADS) {
        const int m = e >> 3, i = e & 7;
        const float inv = (float)pow(500000.0, -(double)i / 8.0);
        const float ang = (float)P.pos[m] * inv;
        ROPE[m * 16 + i] = (float)cos((double)ang);
        ROPE[m * 16 + 8 + i] = (float)sin((double)ang);
    }
    if (bid < 8) {
        const int which = bid >> 2, n = (bid & 3) * 64 + (tid & 63), ks = tid >> 6;
        const float* w1 = which ? P.cmp_v_w1 : P.cmp_k_w1;
        float s = 0.f;
        for (int k = ks * 256; k < ks * 256 + 256; ++k) s += P.cmp_pos[k] * w1[(size_t)k * CMPH + n];
        float* red = (float*)lds + NWAVES * 64 * 33;
        red[ks * 64 + (tid & 63)] = s;
        __syncthreads();
        if (tid < 64) { float a = 0.f; for (int q = 0; q < 8; ++q) a += red[q * 64 + tid]; ((float*)(ws + WS_B1))[which * 256 + (bid & 3) * 64 + tid] = a; }
        __syncthreads();
    }
    if (bid == 8 % nb) {
        h16* kp = (h16*)(ws + WS_KCT) + (size_t)16 * T * 64; h16* vp = (h16*)(ws + WS_VCT) + (size_t)16 * T * 64;
        for (int e = tid; e < 2048; e += NTHREADS) { kp[e] = (h16)0.f; vp[e] = (h16)0.f; }
    }
}

struct GemmN { const h16* A1; int lda1; const h16* B1; int ldb1; int K1; const h16* A2; int lda2; const h16* B2; int ldb2; int K2; int Mr, Nc; int bmap; };
template <bool DUAL, class Epi>
__device__ __forceinline__ void gemm_naive(const GemmN& g, const Epi& epi, int gw, int ngw, int lane) {
    const int tn = g.Nc / 64, tm = g.Mr / 64, ntile = tm * tn;
    const int fr = lane & 15, fq = lane >> 4;
    for (int tile = gw; tile < ntile; tile += ngw) {
        const int tr = tile / tn, tc = tile % tn;
        f32x4 acc1[4][4], acc2[4][4];
#pragma unroll
        for (int i = 0; i < 4; ++i)
#pragma unroll
            for (int j = 0; j < 4; ++j) { acc1[i][j] = (f32x4){0.f, 0.f, 0.f, 0.f}; acc2[i][j] = (f32x4){0.f, 0.f, 0.f, 0.f}; }
        const int bcol = tc * 64 + fr;
        const int brow0 = g.bmap ? ((bcol >> 7) * 256 + (bcol & 127)) : bcol;
        {
            const h16* ap = g.A1 + (size_t)(tr * 64 + fr) * g.lda1 + fq * 8;
            const h16* bp = g.B1 + (size_t)brow0 * g.ldb1 + fq * 8;
            for (int k0 = 0; k0 < g.K1; k0 += 32) {
                h16x8 a[4], b[4];
#pragma unroll
                for (int i = 0; i < 4; ++i) a[i] = *(const h16x8*)(ap + (size_t)i * 16 * g.lda1 + k0);
#pragma unroll
                for (int j = 0; j < 4; ++j) b[j] = *(const h16x8*)(bp + (size_t)j * 16 * g.ldb1 + k0);
#pragma unroll
                for (int i = 0; i < 4; ++i)
#pragma unroll
                    for (int j = 0; j < 4; ++j) acc1[i][j] = __builtin_amdgcn_mfma_f32_16x16x32_f16(a[i], b[j], acc1[i][j], 0, 0, 0);
            }
        }
        if (DUAL) {
            const h16* ap = g.A2 + (size_t)(tr * 64 + fr) * g.lda2 + fq * 8;
            const h16* bp = g.B2 + (size_t)(brow0 + (g.bmap ? 128 : 0)) * g.ldb2 + fq * 8;
            for (int k0 = 0; k0 < g.K2; k0 += 32) {
                h16x8 a[4], b[4];
#pragma unroll
                for (int i = 0; i < 4; ++i) a[i] = *(const h16x8*)(ap + (size_t)i * 16 * g.lda2 + k0);
#pragma unroll
                for (int j = 0; j < 4; ++j) b[j] = *(const h16x8*)(bp + (size_t)j * 16 * g.ldb2 + k0);
#pragma unroll
                for (int i = 0; i < 4; ++i)
#pragma unroll
                    for (int j = 0; j < 4; ++j) acc2[i][j] = __builtin_amdgcn_mfma_f32_16x16x32_f16(a[i], b[j], acc2[i][j], 0, 0, 0);
            }
        }
#pragma unroll
        for (int i = 0; i < 4; ++i)
#pragma unroll
            for (int j = 0; j < 4; ++j)
#pragma unroll
                for (int r = 0; r < 4; ++r) epi(tr * 64 + 16 * i + 4 * fq + r, tc * 64 + 16 * j + fr, acc1[i][j][r], DUAL ? acc2[i][j][r] : 0.f);
    }
}

struct EpiProj {
    unsigned char* ws;
    __device__ __forceinline__ void operator()(int m, int c, float v, float) const {
        v *= ((const float*)(ws + WS_RSTD1))[m];
        if (c < 512) { ((h16*)(ws + WS_XR))[(size_t)m * 512 + c] = (h16)v; return; }
        if (c < 1024) { ((h16*)(ws + WS_GRG))[(size_t)m * 512 + c - 512] = (h16)gelu_tanh(v); return; }
        if (c < 1536) { ((h16*)(ws + WS_Q))[(size_t)m * 512 + c - 1024] = (h16)v; return; }
        if (c < 2304) {
            const int idx = (c - 1536) >> 7, cc = (c - 1536) & 127, g = cc >> 6, d = cc & 63, b = m >> 12, t = m & 4095;
            const size_t off = ((size_t)(b * 2 + g) * T + t) * 64 + d;
            h16* base = (h16*)(ws + (idx == 0 ? WS_KCT : idx == 1 ? WS_VCT : idx == 2 ? WS_KS : idx == 3 ? WS_VS : idx == 4 ? WS_KW : WS_VW));
            base[off] = (h16)v; return;
        }
        if (c < DIN) ((float*)(ws + WS_GATE))[(size_t)m * 24 + c - 2304] = sigmoidf_(v);
    }
};
struct EpiCmpA {
    h16* H1; const float* b1;
    __device__ __forceinline__ void operator()(int r, int c, float v, float) const { H1[(size_t)r * CMPH + c] = (h16)gelu_tanh(v + b1[c]); }
};
struct EpiCmpB {
    float* O;
    __device__ __forceinline__ void operator()(int r, int c, float v, float) const { O[(size_t)r * HD + c] = v; }
};
struct EpiOut {
    const float* x; float* out; h16* x1h; const float* rsr; const float* ssa2;
    __device__ __forceinline__ void operator()(int m, int c, float v1, float v2) const {
        const float s1 = rsr[m], s2 = 1.0f / sqrtf((ssa2[m * 2] + ssa2[m * 2 + 1]) * (1.0f / 512.0f) + EPS);
        const float x1 = x[(size_t)m * D + c] + s1 * v1 + s2 * v2;
        out[(size_t)m * D + c] = x1; x1h[(size_t)m * D + c] = (h16)x1;
    }
};
struct EpiGU {
    h16* hm; const float* rstd2;
    __device__ __forceinline__ void operator()(int m, int c, float vg, float vu) const {
        const float r = rstd2[m], g = vg * r, u = vu * r;
        hm[(size_t)m * DFF + c] = (h16)(g * sigmoidf_(g) * u);
    }
};
struct EpiDown {
    float* out;
    __device__ __forceinline__ void operator()(int m, int c, float v, float) const { out[(size_t)m * D + c] += v; }
};

namespace pg8 {
#define PG8_LAS __attribute__((address_space(3)))
typedef unsigned short bf16_t;
typedef _Float16 bf16x8 __attribute__((ext_vector_type(8)));
typedef float f32x4 __attribute__((ext_vector_type(4)));
typedef unsigned u32x4 __attribute__((ext_vector_type(4)));
constexpr int BM = 256, BK = 64, HALF = 128, HTB = HALF * BK * 2  , STAGE_BYTES = 8 * HTB, NXCD = 8, WGM = 8;

__host__ __device__ __forceinline__ int lds_byte(int r, int c) { const int st = (r >> 4) * 2 + (c >> 5), rr = r & 15, cc = c & 31, ob = rr * 64 + cc * 2; return st * 1024 + (ob ^ (((ob >> 9) & 1) << 5)); }
__host__ __device__ __forceinline__ void stage_rc(int b, int& R, int& C) { const int st = b / 1024, sb = b % 1024, swz = sb ^ (((sb >> 9) & 1) << 5); R = (st >> 1) * 16 + swz / 64; C = (st & 1) * 32 + (swz % 64) / 2; }
__host__ __device__ __forceinline__ int perm32(int rho) { const int n = rho >> 4, i = rho & 15; return 8 * (i >> 2) + 4 * n + (i & 3); }

struct Unit { int pm, pn; };
struct Gemm { const bf16_t* A; const bf16_t* Bt; int M, N, K; };

struct StaticOrder {
    int nM, nN, nwg, G, c;
    __host__ __device__ void init(int M, int N, int G_, int c_) { nM = M / BM; nN = N / BM; nwg = nM * nN; G = G_; c = c_; }
    __host__ __device__ bool next(int i, Unit& u) const {
        const long L = (long)i * G + c; if (L >= nwg) return false;
        int wgid = (int)L; { const int q = nwg / NXCD, r = nwg % NXCD, xcd = wgid % NXCD, off = wgid / NXCD; wgid = (xcd < r ? xcd * (q + 1) : r * (q + 1) + (xcd - r) * q) + off; }
        const int nig = WGM * nN, gid = wgid / nig, fm = gid * WGM, gsz = (nM - fm) < WGM ? (nM - fm) : WGM;
        u.pm = fm + ((wgid % nig) % gsz); u.pn = (wgid % nig) / gsz; return true;
    }
    __device__ __forceinline__ void a_ready(const Unit&) const {}
    __device__ __forceinline__ void done(const Unit&) const {}
};
template <class Epi, class Sched, bool ALIGN_EPI = false, bool SP2 = false>
__device__ __forceinline__ void gemm_phase(PG8_LAS unsigned char* lds, const Gemm g, const Sched& S, const Epi& E) {
    const int tid = threadIdx.x, wid = __builtin_amdgcn_readfirstlane(tid >> 6), lane = tid & 63, wr = wid >> 2, wc = wid & 3, fr = lane & 15, fq = lane >> 4;
    const int K = g.K, nt = K / BK;
    unsigned voffA[2], voffB[2];
#pragma unroll
    for (int i = 0; i < 2; ++i) { int R, C; stage_rc(tid * 16 + i * 8192, R, C); const int Rb = Epi::PERM ? ((R & ~31) + perm32(R & 31)) : R;
        voffA[i] = (unsigned)(R * K + C) * 2u; voffB[i] = (unsigned)(Rb * K + C) * 2u; }
    const size_t kstep = (size_t)(BK * 2);
    const size_t hstep = (size_t)HALF * K * 2;
    const size_t tstep = 2 * hstep;
    const unsigned ldsw = (unsigned)wid * 1024u;
    const int aoff = lds_byte(wr * 64 + fr, fq * 8), boff = lds_byte(wc * 32 + fr, fq * 8);
#define PG8_SA(b, h) (((b) * 2 + (h)) * HTB)
#define PG8_SB(b, h) ((4 + (b) * 2 + (h)) * HTB)
#define PG8_STAGE(bufoff, gbase, voff) do { _Pragma("unroll") for (int _i = 0; _i < 2; ++_i) \
        __builtin_amdgcn_global_load_lds((const unsigned*)((const char*)(gbase) + (voff)[_i]), (PG8_LAS unsigned*)(lds + (bufoff) + ldsw + _i * 8192), 16, 0, 0); } while (0)
#define PG8_LDA(dst, b, h) do { _Pragma("unroll") for (int m = 0; m < 4; ++m) _Pragma("unroll") for (int k = 0; k < 2; ++k) dst[m][k] = *(const PG8_LAS bf16x8*)(lds + PG8_SA(b, h) + aoff + m * 2048 + k * 1024); } while (0)
#define PG8_LDB(dst, b, h) do { _Pragma("unroll") for (int n = 0; n < 2; ++n) _Pragma("unroll") for (int k = 0; k < 2; ++k) dst[n][k] = *(const PG8_LAS bf16x8*)(lds + PG8_SB(b, h) + boff + n * 2048 + k * 1024); } while (0)
#define PG8_MMA(ai, bj, At, Bt) do { __builtin_amdgcn_s_setprio(1); _Pragma("unroll") for (int m = 0; m < 4; ++m) _Pragma("unroll") for (int n = 0; n < 2; ++n) _Pragma("unroll") for (int k = 0; k < 2; ++k) \
        acc[ai][bj][m][n] = __builtin_amdgcn_mfma_f32_16x16x32_f16(Bt[n][k], At[m][k], acc[ai][bj][m][n], 0, 0, 0); __builtin_amdgcn_s_setprio(0); } while (0)
#define PG8_WAIT_V(n) asm volatile("s_waitcnt vmcnt(" #n ")" ::: "memory")
#define PG8_WAIT_L(n) asm volatile("s_waitcnt lgkmcnt(" #n ")" ::: "memory")
#define PG8_BAR __builtin_amdgcn_s_barrier()
#define PG8_SCHED __builtin_amdgcn_sched_barrier(0)
    Unit cur, nxt; int ui = 0;
    if (!S.next(0, cur)) return;
    f32x4 acc[2][2][4][2];
#pragma unroll
    for (int a = 0; a < 2; ++a)
#pragma unroll
        for (int b = 0; b < 2; ++b)
#pragma unroll
            for (int m = 0; m < 4; ++m)
#pragma unroll
                for (int n = 0; n < 2; ++n) acc[a][b][m][n] = (f32x4){0.f, 0.f, 0.f, 0.f};
    bf16x8 At[4][2], B0[2][2], B1[2][2];
    const char* cA = (const char*)g.A + (size_t)cur.pm * tstep; const char* cB = (const char*)g.Bt + (size_t)cur.pn * tstep;
    S.a_ready(cur);
    if constexpr (SP2) {
        PG8_STAGE(PG8_SB(0, 0), cB, voffB); PG8_STAGE(PG8_SB(0, 1), cB + hstep, voffB); PG8_STAGE(PG8_SA(0, 0), cA, voffA); PG8_STAGE(PG8_SA(0, 1), cA + hstep, voffA);
        if (wr == 1) PG8_BAR;
        PG8_WAIT_V(2); PG8_BAR;
        PG8_STAGE(PG8_SB(1, 0), cB + kstep, voffB); PG8_STAGE(PG8_SA(1, 0), cA + kstep, voffA); PG8_STAGE(PG8_SB(1, 1), cB + hstep + kstep, voffB);
        PG8_WAIT_V(6); PG8_BAR;
    } else {
        PG8_STAGE(PG8_SB(0, 0), cB, voffB); PG8_STAGE(PG8_SA(0, 0), cA, voffA); PG8_STAGE(PG8_SB(0, 1), cB + hstep, voffB); PG8_STAGE(PG8_SA(0, 1), cA + hstep, voffA);
        if (wr == 1) PG8_BAR;
        PG8_WAIT_V(4); PG8_BAR;
        PG8_STAGE(PG8_SB(1, 0), cB + kstep, voffB); PG8_STAGE(PG8_SA(1, 0), cA + kstep, voffA); PG8_STAGE(PG8_SB(1, 1), cB + hstep + kstep, voffB);
        PG8_WAIT_V(6); PG8_BAR;
    }
    for (;;) {
        const bool has_next = S.next(ui + 1, nxt);
        const char* nA = has_next ? (const char*)g.A + (size_t)nxt.pm * tstep : cA; const char* nB = has_next ? (const char*)g.Bt + (size_t)nxt.pn * tstep : cB;
        for (int t = 0; t < nt; t += 2) {
            const bool last = (t == nt - 2);
            const char* a1 = cA + (size_t)(t + 1) * kstep;
            const char* a2 = last ? nA : cA + (size_t)(t + 2) * kstep; const char* b2 = last ? nB : cB + (size_t)(t + 2) * kstep;
            const char* a3 = a2 + kstep; const char* b3 = b2 + kstep;
            if (last && has_next) S.a_ready(nxt);
            if constexpr (Epi::MIDK) { if (t == nt / 2) E.mid(acc, cur, wr, wc, fr, fq); }
            if constexpr (SP2) {
            PG8_LDB(B0, 0, 0); PG8_LDB(B1, 0, 1); PG8_SCHED; PG8_LDA(At, 0, 0); PG8_STAGE(PG8_SA(1, 1), a1 + hstep, voffA);
            PG8_WAIT_V(8); PG8_WAIT_L(0); PG8_BAR; PG8_MMA(0, 0, At, B0); PG8_MMA(0, 1, At, B1); PG8_BAR; PG8_SCHED;
            PG8_LDA(At, 0, 1); PG8_STAGE(PG8_SB(0, 0), b2, voffB); PG8_STAGE(PG8_SB(0, 1), b2 + hstep, voffB); PG8_STAGE(PG8_SA(0, 0), a2, voffA);
            PG8_WAIT_V(8); PG8_WAIT_L(0); PG8_BAR; PG8_MMA(1, 0, At, B0); PG8_MMA(1, 1, At, B1); PG8_BAR; PG8_SCHED;
            PG8_LDB(B0, 1, 0); PG8_LDB(B1, 1, 1); PG8_SCHED; PG8_LDA(At, 1, 0); PG8_STAGE(PG8_SA(0, 1), a2 + hstep, voffA);
            PG8_WAIT_V(8); PG8_WAIT_L(0); PG8_BAR; PG8_MMA(0, 0, At, B0); PG8_MMA(0, 1, At, B1); PG8_BAR; PG8_SCHED;
            PG8_LDA(At, 1, 1); PG8_STAGE(PG8_SB(1, 0), b3, voffB); PG8_STAGE(PG8_SB(1, 1), b3 + hstep, voffB); PG8_STAGE(PG8_SA(1, 0), a3, voffA);
            PG8_WAIT_V(8); PG8_WAIT_L(0); PG8_BAR; PG8_MMA(1, 0, At, B0); PG8_MMA(1, 1, At, B1); PG8_BAR; PG8_SCHED;
            } else {
            PG8_LDB(B0, 0, 0); PG8_SCHED; PG8_LDA(At, 0, 0); PG8_STAGE(PG8_SA(1, 1), a1 + hstep, voffA);
            PG8_WAIT_L(8); PG8_BAR; PG8_WAIT_L(0); PG8_MMA(0, 0, At, B0); PG8_BAR; PG8_SCHED;
            PG8_LDB(B1, 0, 1); PG8_STAGE(PG8_SB(0, 0), b2, voffB);
            PG8_BAR; PG8_WAIT_L(0); PG8_MMA(0, 1, At, B1); PG8_BAR;
            PG8_LDA(At, 0, 1); PG8_STAGE(PG8_SA(0, 0), a2, voffA);
            PG8_BAR; PG8_WAIT_L(0); PG8_MMA(1, 0, At, B0); PG8_BAR; PG8_SCHED;
            PG8_STAGE(PG8_SB(0, 1), b2 + hstep, voffB);
            PG8_WAIT_V(6); PG8_BAR; PG8_MMA(1, 1, At, B1); PG8_BAR;
            PG8_LDB(B0, 1, 0); PG8_SCHED; PG8_LDA(At, 1, 0); PG8_STAGE(PG8_SA(0, 1), a2 + hstep, voffA);
            PG8_WAIT_L(8); PG8_BAR; PG8_WAIT_L(0); PG8_MMA(0, 0, At, B0); PG8_BAR; PG8_SCHED;
            PG8_LDB(B1, 1, 1); PG8_STAGE(PG8_SB(1, 0), b3, voffB);
            PG8_BAR; PG8_WAIT_L(0); PG8_MMA(0, 1, At, B1); PG8_BAR;
            PG8_LDA(At, 1, 1); PG8_STAGE(PG8_SA(1, 0), a3, voffA);
            PG8_BAR; PG8_WAIT_L(0); PG8_MMA(1, 0, At, B0); PG8_BAR; PG8_SCHED;
            PG8_STAGE(PG8_SB(1, 1), b3 + hstep, voffB);
            PG8_WAIT_V(6); PG8_BAR; PG8_MMA(1, 1, At, B1); PG8_BAR;
            }
        }
        if constexpr (ALIGN_EPI) { if (wr == 0) PG8_BAR; }
        if constexpr (!Epi::AFTER_DRAIN) { E(acc, cur, wr, wc, fr, fq); S.done(cur); }
        if (!has_next) break;
#pragma unroll
        for (int a = 0; a < 2; ++a)
#pragma unroll
            for (int b = 0; b < 2; ++b)
#pragma unroll
                for (int m = 0; m < 4; ++m)
#pragma unroll
                    for (int n = 0; n < 2; ++n) acc[a][b][m][n] = (f32x4){0.f, 0.f, 0.f, 0.f};
        cur = nxt; cA = nA; cB = nB; ++ui;
        if constexpr (ALIGN_EPI) { if (wr == 1) PG8_BAR; }
    }
    PG8_WAIT_V(0);
    if constexpr (!ALIGN_EPI) { if (wr == 0) PG8_BAR; }
    PG8_BAR;
    if constexpr (Epi::AFTER_DRAIN) { E.fused(acc, cur, wr, wc, fr, fq, lds, wid, lane); S.done(cur); }
#undef PG8_SA
#undef PG8_SB
#undef PG8_STAGE
#undef PG8_LDA
#undef PG8_LDB
#undef PG8_MMA
#undef PG8_WAIT_V
#undef PG8_WAIT_L
#undef PG8_BAR
#undef PG8_SCHED
}
}

__device__ __forceinline__ float fsigmoid(float x) { return __builtin_amdgcn_rcpf(1.0f + __builtin_amdgcn_exp2f(-1.4426950408889634f * x)); }
__device__ __forceinline__ float fgelu_tanh(float x) { const float u2 = 1.5957691216057308f * (x + 0.044715f * x * x * x); return x * fsigmoid(u2); }
__device__ __forceinline__ h16x8 pack8(const f32x4 a, const f32x4 b) {
    h16x8 o; o[0] = (h16)a[0]; o[1] = (h16)a[1]; o[2] = (h16)a[2]; o[3] = (h16)a[3]; o[4] = (h16)b[0]; o[5] = (h16)b[1]; o[6] = (h16)b[2]; o[7] = (h16)b[3]; return o;
}
struct EpiProjF {
    static constexpr bool PERM = true, AFTER_DRAIN = false, MIDK = false;
    unsigned char* ws;
    __device__ __forceinline__ void operator()(const f32x4 (&acc)[2][2][4][2], const pg8::Unit& u, int wr, int wc, int fr, int fq) const {
        const float* RSTD1 = (const float*)(ws + WS_RSTD1);
        const int row0 = u.pm * 256 + wr * 64 + fr, pn = u.pn, c8 = wc * 32 + 8 * fq;
#pragma unroll
        for (int ai = 0; ai < 2; ++ai)
#pragma unroll
            for (int m = 0; m < 4; ++m) {
                const int row = row0 + ai * 128 + m * 16; const float rs = RSTD1[row];
#pragma unroll
                for (int bj = 0; bj < 2; ++bj) {
                    f32x4 v0 = acc[ai][bj][m][0] * rs, v1 = acc[ai][bj][m][1] * rs;
                    const int cb = bj * 128 + c8;
                    if (pn < 2) { *(h16x8*)((h16*)(ws + WS_XR) + (size_t)row * 512 + pn * 256 + cb) = pack8(v0, v1); }
                    else if (pn < 4) {
#pragma unroll
                        for (int e = 0; e < 4; ++e) { v0[e] = fgelu_tanh(v0[e]); v1[e] = fgelu_tanh(v1[e]); }
                        *(h16x8*)((h16*)(ws + WS_GRG) + (size_t)row * 512 + (pn - 2) * 256 + cb) = pack8(v0, v1); }
                    else if (pn < 6) { *(h16x8*)((h16*)(ws + WS_Q) + (size_t)row * 512 + (pn - 4) * 256 + cb) = pack8(v0, v1); }
                    else if (pn < 9) {
                        const int idx = 2 * (pn - 6) + bj, g = c8 >> 6, d = c8 & 63, b = row >> 12, t = row & 4095;
                        h16* base = (h16*)(ws + (idx == 0 ? WS_KCT : idx == 1 ? WS_VCT : idx == 2 ? WS_KS : idx == 3 ? WS_VS : idx == 4 ? WS_KW : WS_VW));
                        *(h16x8*)(base + ((size_t)(b * 2 + g) * T + t) * 64 + d) = pack8(v0, v1); }
                    else if (bj == 0 && c8 < 24) {
                        float* gp = (float*)(ws + WS_GATE) + (size_t)row * 24 + c8;
#pragma unroll
                        for (int e = 0; e < 4; ++e) { v0[e] = fsigmoid(v0[e]); v1[e] = fsigmoid(v1[e]); }
                        *(f32x4*)gp = v0; *(f32x4*)(gp + 4) = v1; }
                }
            }
    }
};
struct EpiOutF {
    static constexpr bool PERM = false, AFTER_DRAIN = false, MIDK = true;
    const float* x; float* out; h16* x1h; const float* rsr; const float* ssa2; float* ss2p;
    __device__ __forceinline__ float rsa_of(int row) const { const f32x2 a = *(const f32x2*)(ssa2 + (size_t)row * 2); return 1.0f / sqrtf((a[0] + a[1]) * (1.0f / 512.0f) + EPS); }
    __device__ __forceinline__ void mid(f32x4 (&acc)[2][2][4][2], const pg8::Unit& u, int wr, int wc, int fr, int fq) const {
        int row0 = u.pm * 256 + wr * 64 + fr; asm volatile("" : "+v"(row0));
#pragma unroll
        for (int ai = 0; ai < 2; ++ai)
#pragma unroll
            for (int m = 0; m < 4; ++m) { const int row = row0 + ai * 128 + m * 16; const float ratio = rsr[row] / rsa_of(row);
#pragma unroll
                for (int bj = 0; bj < 2; ++bj)
#pragma unroll
                    for (int n = 0; n < 2; ++n) acc[ai][bj][m][n] *= ratio; }
    }
    __device__ __forceinline__ void operator()(const f32x4 (&acc)[2][2][4][2], const pg8::Unit& u, int wr, int wc, int fr, int fq) const {
        const int row0 = u.pm * 256 + wr * 64 + fr, col0 = u.pn * 256 + wc * 32 + 4 * fq;
#pragma unroll
        for (int ai = 0; ai < 2; ++ai)
#pragma unroll
            for (int m = 0; m < 4; ++m) { const int row = row0 + ai * 128 + m * 16; const float s2 = rsa_of(row); float ss = 0.f;
#pragma unroll
                for (int bj = 0; bj < 2; ++bj)
#pragma unroll
                    for (int n = 0; n < 2; ++n) { const size_t off = (size_t)row * D + col0 + bj * 128 + n * 16;
                        const f32x4 v = *(const f32x4*)(x + off) + acc[ai][bj][m][n] * s2;
                        *(f32x4*)(out + off) = v; h16x4 h; h[0] = (h16)v[0]; h[1] = (h16)v[1]; h[2] = (h16)v[2]; h[3] = (h16)v[3]; *(h16x4*)(x1h + off) = h;
                        ss += (v[0] * v[0] + v[1] * v[1]) + (v[2] * v[2] + v[3] * v[3]); }
                ss += __shfl_xor(ss, 16); ss += __shfl_xor(ss, 32);
                if (fq == 0) ss2p[(size_t)row * 16 + u.pn * 4 + wc] = ss;
                if (m & 1) asm volatile("" ::: "memory"); }
    }
};
struct EpiGUF {
    static constexpr bool PERM = true, AFTER_DRAIN = false, MIDK = false;
    h16* hm; const float* ss2p;
    __device__ __forceinline__ void operator()(const f32x4 (&acc)[2][2][4][2], const pg8::Unit& u, int wr, int wc, int fr, int fq) const {
        const int row0 = u.pm * 256 + wr * 64 + fr, col = u.pn * 128 + wc * 32 + 8 * fq;
#pragma unroll
        for (int ai = 0; ai < 2; ++ai)
#pragma unroll
            for (int m = 0; m < 4; ++m) { const int row = row0 + ai * 128 + m * 16; const f32x4* sp = (const f32x4*)(ss2p + (size_t)row * 16);
                const f32x4 s0 = sp[0], s1 = sp[1], s2 = sp[2], s3 = sp[3];
                const float tot = ((s0[0] + s0[1]) + (s0[2] + s0[3])) + ((s1[0] + s1[1]) + (s1[2] + s1[3])) + ((s2[0] + s2[1]) + (s2[2] + s2[3])) + ((s3[0] + s3[1]) + (s3[2] + s3[3]));
                const float rs = 1.0f / sqrtf(tot * (1.0f / D) + EPS);
                f32x4 o[2];
#pragma unroll
                for (int n = 0; n < 2; ++n) { const f32x4 g = acc[ai][0][m][n] * rs, uu = acc[ai][1][m][n] * rs;
#pragma unroll
                    for (int e = 0; e < 4; ++e) o[n][e] = g[e] * fsigmoid(g[e]) * uu[e]; }
                *(h16x8*)(hm + (size_t)row * DFF + col) = pack8(o[0], o[1]); }
    }
};
struct EpiDownF {
    static constexpr bool PERM = false, AFTER_DRAIN = false, MIDK = false;
    float* out;
    __device__ __forceinline__ void operator()(const f32x4 (&acc)[2][2][4][2], const pg8::Unit& u, int wr, int wc, int fr, int fq) const {
        const int row0 = u.pm * 256 + wr * 64 + fr, col0 = u.pn * 256 + wc * 32 + 4 * fq;
#pragma unroll
        for (int ai = 0; ai < 2; ++ai)
#pragma unroll
            for (int m = 0; m < 4; ++m) { const int row = row0 + ai * 128 + m * 16;
#pragma unroll
                for (int bj = 0; bj < 2; ++bj)
#pragma unroll
                    for (int n = 0; n < 2; ++n) { float* p = out + (size_t)row * D + col0 + bj * 128 + n * 16; *(f32x4*)p = *(const f32x4*)p + acc[ai][bj][m][n]; } }
    }
};

__device__ __forceinline__ void normrope_rows(const Params& P, int gw, int ngw, int lane) {
    unsigned char* ws = P.ws;
    const float* ROPE = (const float*)(ws + WS_ROPE);
    const int sub = lane & 7;
    for (int m = gw; m < M; m += ngw) {
        const int b = m >> 12, t = m & 4095;
        float cs[8], sn[8];
#pragma unroll
        for (int i = 0; i < 8; ++i) { cs[i] = ROPE[m * 16 + i]; sn[i] = ROPE[m * 16 + 8 + i]; }
#pragma unroll
        for (int which = 0; which < 3; ++which) {
            h16* p; const float* nw; float scale;
            bool act = true;
            if (which == 0) { p = (h16*)(ws + WS_Q) + (size_t)m * 512 + (lane >> 3) * 64 + sub * 8; nw = P.q_norm_w; scale = C2; }
            else { act = lane < 16; const int g = (lane >> 3) & 1; p = (h16*)(ws + (which == 1 ? WS_KS : WS_KW)) + ((size_t)(b * 2 + g) * T + t) * 64 + sub * 8; nw = P.k_norm_w; scale = 1.0f; }
            float v[8]; float ss = 0.f;
            if (act) { const h16x8 h = *(const h16x8*)p;
#pragma unroll
                for (int e = 0; e < 8; ++e) { v[e] = (float)h[e]; ss += v[e] * v[e]; } }
            else {
#pragma unroll
                for (int e = 0; e < 8; ++e) v[e] = 0.f; }
            ss += __shfl_xor(ss, 1); ss += __shfl_xor(ss, 2); ss += __shfl_xor(ss, 4);
            const float rstd = 1.0f / sqrtf(ss * (1.0f / 64.0f) + EPS);
#pragma unroll
            for (int e = 0; e < 8; ++e) v[e] = v[e] * rstd * nw[sub * 8 + e];
            float o[8];
#pragma unroll
            for (int e = 0; e < 8; ++e) {
                const float other = __shfl_xor(v[e], 1);
                if (sub == 0) o[e] = v[e] * cs[e] - other * sn[e];
                else if (sub == 1) o[e] = v[e] * cs[e] + other * sn[e];
                else o[e] = v[e];
            }
            if (act) { h16x8 h;
#pragma unroll
                for (int e = 0; e < 8; ++e) h[e] = (h16)(o[e] * scale);
                *(h16x8*)p = h; }
        }
    }
}

__device__ __forceinline__ void rglru_local(const Params& P, unsigned char* lds, int tid, int lane, int wave, int bid, int nb) {
    unsigned char* ws = P.ws;
    float* WA = (float*)lds;
    float* WX = WA + 4096;
    float* XC = WX + 4096 + wave * 64;
    const h16* XR = (const h16*)(ws + WS_XR);
    h16* HL = (h16*)(ws + WS_HL); h16* AC = (h16*)(ws + WS_AC); float* AGG = (float*)(ws + WS_AGG);
    for (int item = bid; item < 8 * 8 * 32; item += nb) {
        const int n = item & 7, b = (item >> 3) & 7, ck = item >> 6;
        __syncthreads();
        for (int e = tid; e < 4096; e += NTHREADS) { WA[e] = P.gate_a_w[n * 4096 + e]; WX[e] = P.gate_x_w[n * 4096 + e]; }
        __syncthreads();
        const int ch = n * 64 + lane;
        const float cw0 = P.conv_w[0 * 512 + ch], cw1 = P.conv_w[1 * 512 + ch], cw2 = P.conv_w[2 * 512 + ch], cw3 = P.conv_w[3 * 512 + ch], cb = P.conv_b[ch];
        const float ba = P.gate_a_b[ch], bx = P.gate_x_b[ch];
        const float lam = P.lru_lambda[ch];
        const float sp8 = -8.0f * log1pf(expf(-lam));
        const int seg = ck * 8 + wave, t0 = seg * 16;
        const size_t mrow = (size_t)b * T + t0;
        float x0 = (t0 >= 3) ? (float)XR[(mrow - 3) * 512 + ch] : 0.f;
        float x1 = (t0 >= 2) ? (float)XR[(mrow - 2) * 512 + ch] : 0.f;
        float x2 = (t0 >= 1) ? (float)XR[(mrow - 1) * 512 + ch] : 0.f;
        float h = 0.f, Acum = 1.0f;
        for (int tt = 0; tt < 16; ++tt) {
            const float x3 = (float)XR[(mrow + tt) * 512 + ch];
            const float xc = cb + cw0 * x0 + cw1 * x1 + cw2 * x2 + cw3 * x3;
            x0 = x1; x1 = x2; x2 = x3;
            LDS_WAIT();
            XC[lane] = xc;
            LDS_WAIT();
            float sa = ba, sx = bx;
#pragma unroll 16
            for (int d = 0; d < 64; ++d) { const float xd = XC[d]; sa += xd * WA[d * 64 + lane]; sx += xd * WX[d * 64 + lane]; }
            const float r = sigmoidf_(sa), ig = sigmoidf_(sx);
            const float la = sp8 * r;
            const float a = expf(la);
            const float bq = sqrtf(-expm1f(2.0f * la)) * (ig * xc);
            h = a * h + bq; Acum *= a;
            HL[(mrow + tt) * 512 + ch] = (h16)h; AC[(mrow + tt) * 512 + ch] = (h16)Acum;
        }
        float* ag = AGG + (((size_t)(b * 8 + n) * 256 + seg) * 2) * 64;
        ag[lane] = Acum; ag[64 + lane] = h;
    }
}

__device__ __forceinline__ void rglru_fixup(const Params& P, int gw, int ngw, int lane) {
    unsigned char* ws = P.ws;
    const h16* HL = (const h16*)(ws + WS_HL); const h16* AC = (const h16*)(ws + WS_AC); const h16* GRG = (const h16*)(ws + WS_GRG);
    const float* AGG = (const float*)(ws + WS_AGG);
    h16* Y = (h16*)(ws + WS_Y); float* RSR = (float*)(ws + WS_SSR);
    for (int item = gw; item < 8 * 256; item += ngw) {
        const int seg = item & 255, b = item >> 8;
        const size_t mrow = (size_t)b * T + seg * 16;
        float ssq = 0.f;
        for (int n = 0; n < 8; ++n) {
            const float* ag = AGG + ((size_t)(b * 8 + n) * 256) * 128;
            float carry = 0.f;
            for (int s = 0; s < seg; ++s) carry = ag[s * 128 + lane] * carry + ag[s * 128 + 64 + lane];
            const int ch = n * 64 + lane;
            for (int tt = 0; tt < 16; ++tt) {
                const size_t m = mrow + tt;
                const float hv = (float)HL[m * 512 + ch] + (float)AC[m * 512 + ch] * carry;
                const float y = (float)GRG[m * 512 + ch] * hv;
                Y[m * 1024 + ch] = (h16)y;
                const float ss = wave_sum(y * y);
                if (lane == tt) ssq += ss;
            }
        }
        if (lane < 16) RSR[mrow + lane] = 1.0f / sqrtf(ssq * (1.0f / 512.0f) + EPS);
    }
}

__device__ __forceinline__ void compress_finish(const Params& P, int gw, int ngw, int lane) {
    unsigned char* ws = P.ws;
    const float* CR = (const float*)(ws + WS_CRAW); const float* ROPE = (const float*)(ws + WS_ROPE);
    h16* KCC = (h16*)(ws + WS_KCC); h16* VCC = (h16*)(ws + WS_VCC);
    for (int r = gw; r < 4096; r += ngw) {
        const int bg = r >> 8, c = r & 255, b = bg >> 1;
        float kv = CR[(size_t)r * 64 + lane], vv = CR[(size_t)(4096 + r) * 64 + lane];
        if (c == 255) { KCC[(size_t)r * 64 + lane] = (h16)0.f; VCC[(size_t)r * 64 + lane] = (h16)0.f; continue; }
        const float ss = wave_sum(kv * kv);
        kv = kv * (1.0f / sqrtf(ss * (1.0f / 64.0f) + EPS)) * P.k_norm_w[lane];
        const int mp = b * T + 16 * c + 31;
        const float other = __shfl_xor(kv, 8);
        float o = kv;
        if (lane < 8) o = kv * ROPE[mp * 16 + lane] - other * ROPE[mp * 16 + 8 + lane];
        else if (lane < 16) o = kv * ROPE[mp * 16 + lane - 8] + other * ROPE[mp * 16 + 8 + lane - 8];
        KCC[(size_t)r * 64 + lane] = (h16)o; VCC[(size_t)r * 64 + lane] = (h16)vv;
    }
}

__device__ __forceinline__ void qk4(const h16* krow, const float* qs, float (&s)[4]) {
    s[0] = s[1] = s[2] = s[3] = 0.f;
#pragma unroll
    for (int c = 0; c < 8; ++c) {
        const h16x8 k8 = *(const h16x8*)(krow + c * 8);
#pragma unroll
        for (int e = 0; e < 8; ++e) { const float kf = (float)k8[e];
#pragma unroll
            for (int h = 0; h < 4; ++h) s[h] += qs[h * 64 + c * 8 + e] * kf; }
    }
}
__device__ __forceinline__ void attn_group(const h16* Kb, const h16* Vb, int key, bool valid, int nk, const float* qs, float* ps,
                                           float (&mx)[4], float (&l)[4], float (&o)[4], int lane) {
    float s[4];
    qk4(Kb + (size_t)(valid ? key : 0) * 64, qs, s);
    float p[4];
#pragma unroll
    for (int h = 0; h < 4; ++h) {
        const float sv = valid ? s[h] : -INFINITY;
        const float mn = fmaxf(mx[h], wave_max(sv));
        const float f = exp2f(mx[h] - mn);
        p[h] = exp2f(sv - mn);
        l[h] = l[h] * f + wave_sum(p[h]); o[h] *= f; mx[h] = mn;
    }
    LDS_WAIT();
    *(f32x4*)(ps + lane * 4) = (f32x4){p[0], p[1], p[2], p[3]};
    LDS_WAIT();
    const int k0 = key - lane;
    for (int kk = 0; kk < nk; ++kk) {
        const float v = (float)Vb[(size_t)(k0 + kk) * 64 + lane];
        const f32x4 pv = *(const f32x4*)(ps + kk * 4);
        o[0] += pv.x * v; o[1] += pv.y * v; o[2] += pv.z * v; o[3] += pv.w * v;
    }
}
__device__ __forceinline__ void attn_naive(const Params& P, unsigned char* lds, int lane, int wave, int gw, int ngw) {
    unsigned char* ws = P.ws;
    float* qs = (float*)lds + wave * (256 + 1024);
    float* ps = qs + 256;
    const h16* QN = (const h16*)(ws + WS_Q);
    const h16* KCC = (const h16*)(ws + WS_KCC); const h16* VCC = (const h16*)(ws + WS_VCC);
    const h16* KS = (const h16*)(ws + WS_KS); const h16* VS = (const h16*)(ws + WS_VS);
    const h16* KW = (const h16*)(ws + WS_KW); const h16* VW = (const h16*)(ws + WS_VW);
    const float* GATE = (const float*)(ws + WS_GATE);
    h16* Y = (h16*)(ws + WS_Y); float* SSA = (float*)(ws + WS_SSA);
    for (int item = gw; item < M * 2; item += ngw) {
        const int g = item & 1, m = item >> 1, b = m >> 12, t = m & 4095, bg = b * 2 + g;
        LDS_WAIT();
#pragma unroll
        for (int h = 0; h < 4; ++h) qs[h * 64 + lane] = (float)QN[(size_t)m * 512 + (4 * g + h) * 64 + lane];
        LDS_WAIT();
        const int nvalid = (t >= 31) ? ((t - 31) >> 4) + 1 : 0;
        float sc[4][4];
#pragma unroll
        for (int i = 0; i < 4; ++i) {
            const int c = lane + 64 * i;
            float s[4]; qk4(KCC + ((size_t)bg * 256 + c) * 64, qs, s);
#pragma unroll
            for (int h = 0; h < 4; ++h) sc[i][h] = (c < nvalid) ? s[h] : -INFINITY;
        }
#pragma unroll
        for (int h = 0; h < 4; ++h) {
            float mxv = fmaxf(fmaxf(sc[0][h], sc[1][h]), fmaxf(sc[2][h], sc[3][h]));
            mxv = wave_max(mxv);
            if (!(mxv > -INFINITY)) mxv = 0.f;
            float ls = 0.f;
#pragma unroll
            for (int i = 0; i < 4; ++i) { sc[i][h] = exp2f(sc[i][h] - mxv); ls += sc[i][h]; }
            ls = wave_sum(ls);
            const float inv = 1.0f / fmaxf(ls, 1e-30f);
#pragma unroll
            for (int i = 0; i < 4; ++i) sc[i][h] *= inv;
        }
#pragma unroll
        for (int i = 0; i < 4; ++i) *(f32x4*)(ps + (lane + 64 * i) * 4) = (f32x4){sc[i][0], sc[i][1], sc[i][2], sc[i][3]};
        LDS_WAIT();
        float ocmp[4] = {0.f, 0.f, 0.f, 0.f};
        for (int c = 0; c < nvalid; ++c) {
            const float v = (float)VCC[((size_t)bg * 256 + c) * 64 + lane];
            const f32x4 pv = *(const f32x4*)(ps + c * 4);
            ocmp[0] += pv.x * v; ocmp[1] += pv.y * v; ocmp[2] += pv.z * v; ocmp[3] += pv.w * v;
        }
        float imp = 0.f;
        {
#pragma unroll
            for (int e = 0; e < 4; ++e) { const f32x4 pv = *(const f32x4*)(ps + (4 * lane + e) * 4); const float sh = (pv.x + pv.y) + (pv.z + pv.w); imp += (e == 3) ? 0.5f * sh : sh; }
            if (lane >= 1) { const f32x4 pv = *(const f32x4*)(ps + (4 * lane - 1) * 4); imp += 0.5f * ((pv.x + pv.y) + (pv.z + pv.w)); }
        }
        const int cur = t >> 6;
        const bool forced = (lane == 0) || (lane == cur) || (lane == cur - 1);
        const bool cand = !forced && lane < cur - 1;
        const int quota = 16 - (1 + (cur >= 1 ? 1 : 0) + (cur >= 2 ? 1 : 0));
        int rank = 0;
        for (int j2 = 0; j2 < 64; ++j2) {
            const float io = __shfl(imp, j2); const int co = __shfl((int)cand, j2);
            if (co && (io > imp || (io == imp && j2 < lane))) ++rank;
        }
        const bool sel = forced || (cand && rank < quota);
        unsigned long long mask = __ballot(sel);
        float mx[4] = {-INFINITY, -INFINITY, -INFINITY, -INFINITY}, ls[4] = {0.f, 0.f, 0.f, 0.f}, os[4] = {0.f, 0.f, 0.f, 0.f};
        while (mask) {
            const int j = __builtin_ctzll(mask); mask &= mask - 1;
            const int key = 64 * j + lane; const int nk = min(64, t - 64 * j + 1);
            attn_group(KS + (size_t)bg * T * 64, VS + (size_t)bg * T * 64, key, key <= t, nk, qs, ps, mx, ls, os, lane);
        }
        float mw[4] = {-INFINITY, -INFINITY, -INFINITY, -INFINITY}, lw[4] = {0.f, 0.f, 0.f, 0.f}, ow[4] = {0.f, 0.f, 0.f, 0.f};
        for (int k0 = max(0, t - 511); k0 <= t; k0 += 64) {
            const int key = k0 + lane; const int nk = min(64, t - k0 + 1);
            attn_group(KW + (size_t)bg * T * 64, VW + (size_t)bg * T * 64, key, key <= t, nk, qs, ps, mw, lw, ow, lane);
        }
        float ssq = 0.f;
#pragma unroll
        for (int h = 0; h < 4; ++h) {
            const float* gp = GATE + (size_t)m * 24 + (4 * g + h) * 3;
            const float o = gp[0] * ocmp[h] + gp[1] * os[h] / ls[h] + gp[2] * ow[h] / lw[h];
            Y[(size_t)m * 1024 + 512 + (4 * g + h) * 64 + lane] = (h16)o;
            ssq += o * o;
        }
        ssq = wave_sum(ssq);
        if (lane == 0) SSA[m * 2 + g] = ssq;
    }
}


typedef float f32x16 __attribute__((ext_vector_type(16)));
typedef short s16x4 __attribute__((ext_vector_type(4)));
#define LAS3 __attribute__((address_space(3)))
constexpr int AT_KV = 0;
constexpr int AT_IMPH = 32768;
constexpr int AT_IMPS = AT_IMPH + 65536;
constexpr int AT_MASK = AT_IMPS + 16384;
constexpr int AT_WSF = AT_MASK + 512;
constexpr int AT_SSQ = AT_WSF + 2048;
constexpr int AT_STG = AT_SSQ + 1024;
constexpr int AT_END = AT_STG + 32768;
__device__ __forceinline__ int crow(int r, int hi) { return (r & 3) + 8 * (r >> 2) + 4 * hi; }
__device__ __forceinline__ float fexp2(float x) { return __builtin_amdgcn_exp2f(x); }

__device__ __forceinline__ void at_qkt(f32x16& p0, f32x16& p1, const LAS3 unsigned char* kb, const h16x8 (&qr)[4], int r32, int hi) {
    const LAS3 unsigned char* kp = kb + hi * 1024 + r32 * 16;
    p0 = (f32x16){0.f, 0.f, 0.f, 0.f, 0.f, 0.f, 0.f, 0.f, 0.f, 0.f, 0.f, 0.f, 0.f, 0.f, 0.f, 0.f}; p1 = p0;
#pragma unroll
    for (int d0 = 0; d0 < 4; ++d0) {
        const h16x8 b0 = *(const LAS3 h16x8*)(kp + d0 * 2048), b1 = *(const LAS3 h16x8*)(kp + d0 * 2048 + 512);
        p0 = __builtin_amdgcn_mfma_f32_32x32x16_f16(b0, qr[d0], p0, 0, 0, 0);
        p1 = __builtin_amdgcn_mfma_f32_32x32x16_f16(b1, qr[d0], p1, 0, 0, 0);
    }
}
__device__ __forceinline__ void at_mask(f32x16& p0, f32x16& p1, int lo, int hb, int hi) {
#pragma unroll
    for (int r = 0; r < 16; ++r) { const int kv = crow(r, hi);
        if (kv < lo || kv >= hb) p0[r] = -INFINITY;
        if (kv + 32 < lo || kv + 32 >= hb) p1[r] = -INFINITY; }
}
__device__ __forceinline__ float at_rowmax(const f32x16& p0, const f32x16& p1) {
    float a = fmaxf(p0[0], p1[0]);
#pragma unroll
    for (int r = 1; r < 16; ++r) a = fmaxf(a, fmaxf(p0[r], p1[r]));
    return fmaxf(a, __shfl_xor(a, 32));
}
__device__ __forceinline__ h16x8 at_pack(const f32x16& p, int b) {
    h16x8 o;
#pragma unroll
    for (int j = 0; j < 8; ++j) o[j] = (h16)p[b + j];
    return o;
}
__device__ __forceinline__ void at_pv(f32x16& o0, f32x16& o1, const LAS3 unsigned char* vb, const f32x16& p0, const f32x16& p1, int lane, int hi) {
    const LAS3 unsigned char* vp = vb + ((lane >> 4) & 1) * 32 + (lane & 3) * 8 + (4 * hi + ((lane & 15) >> 2)) * 64;
    const h16x8 pw0 = at_pack(p0, 0), pw1 = at_pack(p0, 8), pw2 = at_pack(p1, 0), pw3 = at_pack(p1, 8);
#pragma unroll
    for (int dh = 0; dh < 2; ++dh) {
        h16x8 vf[4];
#pragma unroll
        for (int kg = 0; kg < 4; ++kg) {
            const s16x4 lo4 = __builtin_amdgcn_ds_read_tr16_b64_v4i16((LAS3 s16x4*)(vp + dh * 4096 + kg * 1024));
            const s16x4 hi4 = __builtin_amdgcn_ds_read_tr16_b64_v4i16((LAS3 s16x4*)(vp + dh * 4096 + kg * 1024 + 512));
            typedef short s16x8 __attribute__((ext_vector_type(8)));
            const s16x8 w = (s16x8){lo4[0], lo4[1], lo4[2], lo4[3], hi4[0], hi4[1], hi4[2], hi4[3]};
            vf[kg] = __builtin_bit_cast(h16x8, w);
        }
        f32x16& o = dh ? o1 : o0;
        o = __builtin_amdgcn_mfma_f32_32x32x16_f16(pw0, vf[0], o, 0, 0, 0);
        o = __builtin_amdgcn_mfma_f32_32x32x16_f16(pw1, vf[1], o, 0, 0, 0);
        o = __builtin_amdgcn_mfma_f32_32x32x16_f16(pw2, vf[2], o, 0, 0, 0);
        o = __builtin_amdgcn_mfma_f32_32x32x16_f16(pw3, vf[3], o, 0, 0, 0);
    }
}
__device__ __forceinline__ void at_scale_rows(f32x16& o0, f32x16& o1, float f, LAS3 float* wsf, int r32, int hi) {
    LDS_WAIT();
    if (hi == 0) wsf[r32] = f;
    LDS_WAIT();
#pragma unroll
    for (int r = 0; r < 16; ++r) { const float fr = wsf[crow(r, hi)]; o0[r] *= fr; o1[r] *= fr; }
}
__device__ __forceinline__ void at_step(f32x16& p0, f32x16& p1, f32x16& o0, f32x16& o1, float& m, float& l, const LAS3 unsigned char* vb, LAS3 float* wsf, int lane, int r32, int hi) {
    const float rm = at_rowmax(p0, p1);
    const float mn = fmaxf(m, rm);
    if (__any(mn > m)) { const float f = fexp2(m - mn); l *= f; m = mn; at_scale_rows(o0, o1, f, wsf, r32, hi); }
    float s = 0.f;
#pragma unroll
    for (int r = 0; r < 16; ++r) { p0[r] = fexp2(p0[r] - m); p1[r] = fexp2(p1[r] - m); s += p0[r] + p1[r]; }
    l += s;
    at_pv(o0, o1, vb, p0, p1, lane, hi);
}

__device__ __forceinline__ void attn_unit(const Params& P, unsigned char* lds_g, int bg, int qb, int tid_in, int lane_in, int wave) {
    int lane = lane_in; asm volatile("" : "+v"(lane));
    const int tid = wave * 64 + lane; (void)tid_in;
    unsigned char* ws = P.ws;
    LAS3 unsigned char* lds = (LAS3 unsigned char*)lds_g;
    const int r32 = lane & 31, hi = lane >> 5, hl = wave >> 1, th = wave & 1;
    const int b = bg >> 1, g = bg & 1;
    const int tok = 32 * th + r32;
    const int t = 64 * qb + tok;
    const size_t m = (size_t)b * T + t;
    const h16* KCC = (const h16*)(ws + WS_KCC) + (size_t)bg * 256 * 64; const h16* VCC = (const h16*)(ws + WS_VCC) + (size_t)bg * 256 * 64;
    const h16* KS = (const h16*)(ws + WS_KS) + (size_t)bg * T * 64; const h16* VS = (const h16*)(ws + WS_VS) + (size_t)bg * T * 64;
    const h16* KW = (const h16*)(ws + WS_KW) + (size_t)bg * T * 64; const h16* VW = (const h16*)(ws + WS_VW) + (size_t)bg * T * 64;
    LAS3 float* wsf = (LAS3 float*)(lds + AT_WSF) + wave * 64;
    LAS3 float* IMPH = (LAS3 float*)(lds + AT_IMPH); LAS3 float* IMPS = (LAS3 float*)(lds + AT_IMPS);
    const int ntc = (4 * qb + 3 + 63) >> 6, nsl = qb + 1, nwn = min(qb + 1, 9), nt = 2 * ntc + nsl + nwn;
#define AT_KOFF (lane * 64 + wave * 8)
#define AT_VOFF ((16 * (wave & 3) + (lane >> 2)) * 64 + (wave >> 2) * 32 + (lane & 3) * 8)
#define AT_ISSUE(i) do { const int i_ = (i); const h16* ks_; const h16* vs_ = nullptr; int key0_; \
        if (i_ < ntc) { ks_ = KCC; key0_ = 64 * i_; } else if (i_ < 2 * ntc) { ks_ = KCC; vs_ = VCC; key0_ = 64 * (i_ - ntc); } \
        else if (i_ < 2 * ntc + nsl) { ks_ = KS; vs_ = VS; key0_ = 64 * (i_ - 2 * ntc); } else { ks_ = KW; vs_ = VW; key0_ = 64 * (qb - (i_ - 2 * ntc - nsl)); } \
        LAS3 unsigned char* dst_ = lds + AT_KV + (i_ & 1) * 16384 + wave * 1024; \
        __builtin_amdgcn_global_load_lds((const unsigned*)(ks_ + (size_t)key0_ * 64 + AT_KOFF), (LAS3 unsigned*)dst_, 16, 0, 0); \
        if (vs_) __builtin_amdgcn_global_load_lds((const unsigned*)(vs_ + (size_t)key0_ * 64 + AT_VOFF), (LAS3 unsigned*)(dst_ + 8192), 16, 0, 0); } while (0)
    AT_ISSUE(0);
    h16x8 qr[4];
    { const h16* qp = (const h16*)(ws + WS_Q) + m * 512 + (4 * g + hl) * 64 + hi * 8;
#pragma unroll
      for (int d0 = 0; d0 < 4; ++d0) qr[d0] = *(const h16x8*)(qp + d0 * 16); }
    float gt[3];
    { const float* gp = (const float*)(ws + WS_GATE) + m * 24 + (4 * g + hl) * 3; gt[0] = gp[0]; gt[1] = gp[1]; gt[2] = gp[2]; }
    const int nvalid = (t >= 31) ? ((t - 31) >> 4) + 1 : 0;
    f32x16 ot0, ot1, o0, o1;
#pragma unroll
    for (int r = 0; r < 16; ++r) { ot0[r] = 0.f; ot1[r] = 0.f; o0[r] = 0.f; o1[r] = 0.f; }
    float mx = -INFINITY, l = 0.f, cinv = 0.f, carry = 0.f;
    unsigned selw0 = 0u, selw1 = 0u;
    asm volatile("s_waitcnt vmcnt(0)" ::: "memory"); __syncthreads();
    const int lane_outer = lane, r32_outer = r32, hi_outer = hi, tok_outer = tok, tid_outer = tid;
    for (int i = 0; i < nt; ++i) {
        int lane = lane_outer; asm volatile("" : "+v"(lane));
        const int r32 = lane & 31, hi = lane >> 5, tok = 32 * th + r32, tid = wave * 64 + lane;
        if (i + 1 < nt) AT_ISSUE(i + 1);
        const LAS3 unsigned char* kb = lds + AT_KV + (i & 1) * 16384; const LAS3 unsigned char* vb = kb + 8192;
        f32x16 p0, p1;
        at_qkt(p0, p1, kb, qr, r32, hi);
        if (i < ntc) {
            at_mask(p0, p1, 0, nvalid - 64 * i, hi);
            const float rm = at_rowmax(p0, p1);
            const float mn = fmaxf(mx, rm), ms = (mn == -INFINITY) ? 0.f : mn;
            float s = 0.f;
#pragma unroll
            for (int r = 0; r < 16; ++r) s += fexp2(p0[r] - ms) + fexp2(p1[r] - ms);
            l = l * fexp2(mx - ms) + s; mx = mn;
            if (i == ntc - 1) { const float lt = l + __shfl_xor(l, 32); cinv = 1.0f / fmaxf(lt, 1e-30f); if (mx == -INFINITY) mx = 0.f; }
        } else if (i < 2 * ntc) {
            const int tl = i - ntc;
            at_mask(p0, p1, 0, nvalid - 64 * tl, hi);
#pragma unroll
            for (int r = 0; r < 16; ++r) { p0[r] = fexp2(p0[r] - mx) * cinv; p1[r] = fexp2(p1[r] - mx) * cinv; }
#pragma unroll
            for (int gq = 0; gq < 2; ++gq) {
                const f32x16& p = gq ? p1 : p0;
                float tot[4], x[4];
#pragma unroll
                for (int R = 0; R < 4; ++R) { const float sp = 0.5f * p[4 * R + 3]; tot[R] = (p[4 * R] + p[4 * R + 1]) + (p[4 * R + 2] + sp); x[R] = __shfl_xor(sp, 32); }
                if (hi) {
#pragma unroll
                    for (int R = 0; R < 4; ++R) tot[R] += x[R];
                } else { tot[0] += carry; tot[1] += x[0]; tot[2] += x[1]; tot[3] += x[2]; carry = x[3]; }
#pragma unroll
                for (int R = 0; R < 4; ++R) IMPH[(hl * 64 + 16 * tl + 8 * gq + 2 * R + hi) * 64 + tok] = tot[R];
            }
            at_pv(o0, o1, vb, p0, p1, lane, hi);
            if (i == 2 * ntc - 1) {
                at_scale_rows(o0, o1, gt[0], wsf, r32, hi);
#pragma unroll
                for (int r = 0; r < 16; ++r) { ot0[r] += o0[r]; ot1[r] += o1[r]; o0[r] = 0.f; o1[r] = 0.f; }
                mx = -INFINITY; l = 0.f;
                LDS_WAIT(); __syncthreads();
                { const int tk = tid & 63, part = tid >> 6;
                  float own[8];
#pragma unroll
                  for (int e = 0; e < 8; ++e) { const int j = 8 * part + e; float v = 0.f;
                      if (j < 16 * ntc) v = (IMPH[(0 * 64 + j) * 64 + tk] + IMPH[(1 * 64 + j) * 64 + tk]) + (IMPH[(2 * 64 + j) * 64 + tk] + IMPH[(3 * 64 + j) * 64 + tk]);
                      own[e] = v; IMPS[j * 64 + tk] = v; }
                  LDS_WAIT(); __syncthreads();
                  int rank[8];
#pragma unroll
                  for (int e = 0; e < 8; ++e) rank[e] = 0;
                  for (int j2 = 1; j2 <= qb - 2; ++j2) { const float v2 = IMPS[j2 * 64 + tk];
#pragma unroll
                      for (int e = 0; e < 8; ++e) { const int j = 8 * part + e; rank[e] += (v2 > own[e] || (v2 == own[e] && j2 < j)) ? 1 : 0; } }
                  const int quota = 16 - (1 + (qb >= 1 ? 1 : 0) + (qb >= 2 ? 1 : 0));
                  unsigned bits = 0u;
#pragma unroll
                  for (int e = 0; e < 8; ++e) { const int j = 8 * part + e; const bool forced = (j == 0) || (j == qb) || (j == qb - 1); const bool cand = !forced && j >= 1 && j <= qb - 2;
                      if (forced || (cand && rank[e] < quota)) bits |= 1u << e; }
                  ((LAS3 unsigned char*)(lds + AT_MASK))[tk * 8 + part] = (unsigned char)bits;
                  LDS_WAIT(); __syncthreads();
                  const LAS3 unsigned* mp = (const LAS3 unsigned*)(lds + AT_MASK) + tok * 2; selw0 = mp[0]; selw1 = mp[1]; }
            }
        } else if (i < 2 * ntc + nsl) {
            const int j = i - 2 * ntc;
            const bool sel = ((j < 32 ? (selw0 >> j) : (selw1 >> (j - 32))) & 1u) != 0u;
            const int hb = sel ? ((j == qb) ? tok + 1 : 64) : 0;
            at_mask(p0, p1, 0, hb, hi);
            at_step(p0, p1, o0, o1, mx, l, vb, wsf, lane, r32, hi);
            if (j == qb) {
                const float lt = l + __shfl_xor(l, 32);
                at_scale_rows(o0, o1, gt[1] / lt, wsf, r32, hi);
#pragma unroll
                for (int r = 0; r < 16; ++r) { ot0[r] += o0[r]; ot1[r] += o1[r]; o0[r] = 0.f; o1[r] = 0.f; }
                mx = -INFINITY; l = 0.f;
            }
        } else {
            const int jj = i - 2 * ntc - nsl;
            const int lo = (jj == 8) ? tok + 1 : 0, hb = (jj == 0) ? tok + 1 : 64;
            if (jj == 0 || jj == 8) at_mask(p0, p1, lo, hb, hi);
            at_step(p0, p1, o0, o1, mx, l, vb, wsf, lane, r32, hi);
            if (i == nt - 1) {
                const float lt = l + __shfl_xor(l, 32);
                at_scale_rows(o0, o1, gt[2] / lt, wsf, r32, hi);
#pragma unroll
                for (int r = 0; r < 16; ++r) { ot0[r] += o0[r]; ot1[r] += o1[r]; }
            }
        }
        asm volatile("s_waitcnt vmcnt(0)" ::: "memory"); __syncthreads();
    }
#undef AT_ISSUE
#undef AT_KOFF
#undef AT_VOFF
    (void)r32_outer; (void)hi_outer; (void)tok_outer; (void)tid_outer;
    LAS3 h16* stg = (LAS3 h16*)(lds + AT_STG) + wave * 2048;
#pragma unroll
    for (int r = 0; r < 16; ++r) { const int orow = crow(r, hi); stg[orow * 64 + r32] = (h16)ot0[r]; stg[orow * 64 + 32 + r32] = (h16)ot1[r]; }
    LDS_WAIT();
    LAS3 float* SSQ = (LAS3 float*)(lds + AT_SSQ);
    h16* Yb = (h16*)(ws + WS_Y) + ((size_t)b * T + 64 * qb + 32 * th) * 1024 + 512 + (4 * g + hl) * 64;
#pragma unroll
    for (int i2 = 0; i2 < 4; ++i2) { const int row = i2 * 8 + (lane >> 3), ch = lane & 7;
        const h16x8 v = *(const LAS3 h16x8*)(stg + row * 64 + ch * 8);
        *(h16x8*)(Yb + (size_t)row * 1024 + ch * 8) = v;
        float ss = 0.f;
#pragma unroll
        for (int e = 0; e < 8; ++e) { const float f = (float)v[e]; ss += f * f; }
        ss += __shfl_xor(ss, 1); ss += __shfl_xor(ss, 2); ss += __shfl_xor(ss, 4);
        if (ch == 0) SSQ[hl * 64 + 32 * th + row] = ss; }
    LDS_WAIT(); __syncthreads();
    if (tid < 64) ((float*)(ws + WS_SSA))[((size_t)b * T + 64 * qb + tid) * 2 + g] = (SSQ[tid] + SSQ[64 + tid]) + (SSQ[128 + tid] + SSQ[192 + tid]);
    __syncthreads();
}
__device__ __forceinline__ void attn_mfma_phase(const Params& P, unsigned char* lds, int tid, int lane, int wave, int bid, int nb) {
    const bool deal = (nb == 256);
    const int v = (bid & 7) * 32 + (bid >> 3);
    const int nu = deal ? 4 : (1024 - bid + nb - 1) / nb;
    for (int k = 0; k < nu; ++k) {
        int bg, qb;
        if (deal) { const int s = v & 15; bg = v >> 4; qb = (k == 0) ? 63 - s : (k == 1) ? 32 + s : (k == 2) ? 31 - s : s; }
        else { const int u = bid + k * nb; bg = u >> 6; qb = 63 - (u & 63); }
        attn_unit(P, lds, bg, qb, tid, lane, wave);
    }
}

#ifndef PHMASK
#define PHMASK 0x3ff
#endif
constexpr int NPHASE = 10;
#ifndef FAST_GEMM
#define FAST_GEMM 7
#endif
#ifndef FAST_ATTN
#define FAST_ATTN 1
#endif
constexpr int LDS_BYTES = 155648;
static_assert(AT_END <= LDS_BYTES && pg8::STAGE_BYTES <= LDS_BYTES, "LDS map");
__global__ void __launch_bounds__(NTHREADS, 2) hymba_fwd(Params P) {
    extern __shared__ __attribute__((aligned(16))) unsigned char lds[];
    cg::grid_group grid = cg::this_grid();
    const int tid = threadIdx.x, lane = tid & 63, wave = __builtin_amdgcn_readfirstlane(tid >> 6);
    const int bid = blockIdx.x, nb = gridDim.x;
    const int gw = bid * NWAVES + wave, ngw = nb * NWAVES;
    unsigned char* ws = P.ws;
    const int lo = P.ph_lo, hi = P.ph_hi;
#define PH_BEGIN(k) if (lo <= (k) && (k) < hi) { if ((k) > lo) grid.sync();
#define PH_END }
#if PHMASK & (1 << 0)
        PH_BEGIN(0) phase0(P, lds, tid, lane, wave, bid, nb); PH_END
#endif
#if PHMASK & (1 << 1)
        PH_BEGIN(1) {
#if FAST_GEMM & 1
            pg8::Gemm g{(const pg8::bf16_t*)(ws + WS_XH), (const pg8::bf16_t*)(ws + WS_WIN), M, NP1, 1024}; pg8::StaticOrder S; S.init(M, NP1, nb, bid);
            pg8::gemm_phase<EpiProjF, pg8::StaticOrder, true, true>((PG8_LAS unsigned char*)lds, g, S, EpiProjF{ws});
#else
            GemmN g{(const h16*)(ws + WS_XH), 1024, (const h16*)(ws + WS_WIN), 1024, 1024, nullptr, 0, nullptr, 0, 0, M, NP1, 0};
            gemm_naive<false>(g, EpiProj{ws}, gw, ngw, lane);
#endif
        } PH_END
#endif
#if PHMASK & (1 << 2)
        PH_BEGIN(2) {
            normrope_rows(P, gw, ngw, lane);
            rglru_local(P, lds, tid, lane, wave, bid, nb);
            for (int w = 0; w < 2; ++w) {
                GemmN g{(const h16*)(ws + (w ? WS_VCT : WS_KCT)), 1024, (const h16*)(ws + (w ? WS_W1V : WS_W1K)), CMPK, CMPK, nullptr, 0, nullptr, 0, 0, 4096, CMPH, 0};
                gemm_naive<false>(g, EpiCmpA{(h16*)(ws + WS_H1) + (size_t)w * 4096 * CMPH, (const float*)(ws + WS_B1) + w * 256}, gw, ngw, lane);
            }
        } PH_END
#endif
#if PHMASK & (1 << 3)
        PH_BEGIN(3) {
            for (int w = 0; w < 2; ++w) {
                GemmN g{(const h16*)(ws + WS_H1) + (size_t)w * 4096 * CMPH, CMPH, (const h16*)(ws + (w ? WS_W2V : WS_W2K)), CMPH, CMPH, nullptr, 0, nullptr, 0, 0, 4096, HD, 0};
                gemm_naive<false>(g, EpiCmpB{(float*)(ws + WS_CRAW) + (size_t)w * 4096 * HD}, gw, ngw, lane);
            }
        } PH_END
#endif
#if PHMASK & (1 << 4)
        PH_BEGIN(4) compress_finish(P, gw, ngw, lane); PH_END
#endif
#if PHMASK & (1 << 5)
        PH_BEGIN(5) {
            rglru_fixup(P, gw, ngw, lane);
#if FAST_ATTN
            attn_mfma_phase(P, lds, tid, lane, wave, bid, nb);
#else
            attn_naive(P, lds, lane, wave, gw, ngw);
#endif
        } PH_END
#endif
#if PHMASK & (1 << 6)
        PH_BEGIN(6) {
#if FAST_GEMM & 2
            pg8::Gemm g{(const pg8::bf16_t*)(ws + WS_Y), (const pg8::bf16_t*)(ws + WS_WOUT), M, D, 1024}; pg8::StaticOrder S; S.init(M, D, nb, bid);
            pg8::gemm_phase<EpiOutF, pg8::StaticOrder, true, true>((PG8_LAS unsigned char*)lds, g, S,
                EpiOutF{P.x, P.out, (h16*)(ws + WS_X1H), (const float*)(ws + WS_SSR), (const float*)(ws + WS_SSA), (float*)(ws + WS_SS2P)});
#else
            const h16* Y = (const h16*)(ws + WS_Y); const h16* W = (const h16*)(ws + WS_WOUT);
            GemmN g{Y, 1024, W, 1024, 512, Y + 512, 1024, W + 512, 1024, 512, M, D, 0};
            gemm_naive<true>(g, EpiOut{P.x, P.out, (h16*)(ws + WS_X1H), (const float*)(ws + WS_SSR), (const float*)(ws + WS_SSA)}, gw, ngw, lane);
#endif
        } PH_END
#endif
#if PHMASK & (1 << 7)
        PH_BEGIN(7) {
            float* RSTD2 = (float*)(ws + WS_RSTD2);
            for (int m = gw; m < ((FAST_GEMM & 2) ? 0 : M); m += ngw) {
                const f32x4* xr = (const f32x4*)(P.out + (size_t)m * D) + lane; float s = 0.f;
#pragma unroll
                for (int j = 0; j < 4; ++j) { const f32x4 v = xr[64 * j]; s += (v.x * v.x + v.y * v.y) + (v.z * v.z + v.w * v.w); }
                s = wave_sum(s);
                if (lane == 0) RSTD2[m] = 1.0f / sqrtf(s * (1.0f / D) + EPS);
            }
        } PH_END
#endif
#if PHMASK & (1 << 8)
        PH_BEGIN(8) {
#if FAST_GEMM & 2
            pg8::Gemm g{(const pg8::bf16_t*)(ws + WS_X1H), (const pg8::bf16_t*)(ws + WS_WGU), M, 2 * DFF, 1024}; pg8::StaticOrder S; S.init(M, 2 * DFF, nb, bid);
            pg8::gemm_phase<EpiGUF, pg8::StaticOrder, true, true>((PG8_LAS unsigned char*)lds, g, S, EpiGUF{(h16*)(ws + WS_HM), (const float*)(ws + WS_SS2P)});
#else
            const h16* A = (const h16*)(ws + WS_X1H); const h16* W = (const h16*)(ws + WS_WGU);
            GemmN g{A, 1024, W, 1024, 1024, A, 1024, W, 1024, 1024, M, DFF, 1};
            gemm_naive<true>(g, EpiGU{(h16*)(ws + WS_HM), (const float*)(ws + WS_RSTD2)}, gw, ngw, lane);
#endif
        } PH_END
#endif
#if PHMASK & (1 << 9)
        PH_BEGIN(9) {
#if FAST_GEMM & 4
            pg8::Gemm g{(const pg8::bf16_t*)(ws + WS_HM), (const pg8::bf16_t*)(ws + WS_WD), M, D, DFF}; pg8::StaticOrder S; S.init(M, D, nb, bid);
            pg8::gemm_phase<EpiDownF, pg8::StaticOrder, true, true>((PG8_LAS unsigned char*)lds, g, S, EpiDownF{P.out});
#else
            GemmN g{(const h16*)(ws + WS_HM), DFF, (const h16*)(ws + WS_WD), DFF, DFF, nullptr, 0, nullptr, 0, 0, M, D, 0};
            gemm_naive<false>(g, EpiDown{P.out}, gw, ngw, lane);
#endif
        } PH_END
#endif
}

#ifndef N_LAUNCH_PER_PHASE
#define N_LAUNCH_PER_PHASE 0
#endif
extern "C" void kernel_launch(void* const* d_in, const int* in_sizes, int n_in, void* d_out, int out_size, void* d_ws, size_t ws_size, hipStream_t stream) {
    static int grid = 0;
    if (grid == 0) {
        if (n_in != 25 || in_sizes[0] != M * D || out_size != M * D || ws_size < WS_END) {
            fprintf(stderr, "kernel_launch: unexpected problem (n_in %d, in0 %d, out %d, ws %zu)\n", n_in, n_in > 0 ? in_sizes[0] : -1, out_size, ws_size); grid = -1; return; }
        int dev = 0, cus = 0, per_cu = 0;
        hipGetDevice(&dev);
        hipDeviceGetAttribute(&cus, hipDeviceAttributeMultiprocessorCount, dev);
        hipFuncSetAttribute((const void*)hymba_fwd, hipFuncAttributeMaxDynamicSharedMemorySize, LDS_BYTES);
        hipOccupancyMaxActiveBlocksPerMultiprocessor(&per_cu, (const void*)hymba_fwd, NTHREADS, LDS_BYTES);
        if (per_cu < 1) { fprintf(stderr, "kernel_launch: occupancy query says %d blocks per CU\n", per_cu); grid = -1; return; }
        grid = cus;
    }
    if (grid < 0) return;
    Params p{};
    const float** pf = (const float**)&p;
    for (int i = 0; i < 25; ++i) pf[i] = (const float*)d_in[i];
    p.out = (float*)d_out; p.ws = (unsigned char*)d_ws;
#if N_LAUNCH_PER_PHASE
    for (int ph = 0; ph < NPHASE; ++ph) {
        p.ph_lo = ph; p.ph_hi = ph + 1;
        void* args[] = {&p};
        hipError_t e = hipLaunchCooperativeKernel((const void*)hymba_fwd, dim3(grid), dim3(NTHREADS), args, LDS_BYTES, stream);
        if (e != hipSuccess) { fprintf(stderr, "launch failed: %s\n", hipGetErrorString(e)); return; }
    }
#else
    p.ph_lo = 0; p.ph_hi = NPHASE;
    void* args[] = {&p};
    hipError_t e = hipLaunchCooperativeKernel((const void*)hymba_fwd, dim3(grid), dim3(NTHREADS), args, LDS_BYTES, stream);
    if (e != hipSuccess) fprintf(stderr, "launch failed: %s\n", hipGetErrorString(e));
#endif
}
```

```cpp
#include <hip/hip_runtime.h>
#include <hip/hip_cooperative_groups.h>
#include <cstdio>
#include <cstdint>
namespace cg = cooperative_groups;

typedef _Float16 h16;
typedef _Float16 h16x8 __attribute__((ext_vector_type(8)));
typedef _Float16 h16x4 __attribute__((ext_vector_type(4)));
typedef _Float16 h16x2 __attribute__((ext_vector_type(2)));
typedef float f32x4 __attribute__((ext_vector_type(4)));
typedef float f32x2 __attribute__((ext_vector_type(2)));
typedef unsigned u32x4 __attribute__((ext_vector_type(4)));
typedef unsigned u32x2 __attribute__((ext_vector_type(2)));

constexpr int BATCH = 8, T = 4096, M = BATCH * T, D = 1024;
constexpr int DRNN = 512, NBLK = 8, DATT = 512, NH = 8, NKV = 2, HPG = 4, HD = 64;
constexpr int DIN = 2328, NP1 = 2560;
constexpr int DFF = 2816;
constexpr int NCMP = 255, NCP = 256;
constexpr int CMPK = 2048, CMPH = 256;
constexpr float EPS = 1e-6f;
constexpr float C2 = 0.125f * 1.4426950408889634f;
constexpr int NTHREADS = 512, NWAVES = 8;

constexpr size_t MiB = 1u << 20;
constexpr size_t WS_WIN = 0;
constexpr size_t WS_WOUT = 6 * MiB;
constexpr size_t WS_WGU = 8 * MiB;
constexpr size_t WS_WD = 20 * MiB;
constexpr size_t WS_W1K = 26 * MiB, WS_W1V = 27 * MiB;
constexpr size_t WS_W2K = 28 * MiB, WS_W2V = 28 * MiB + 65536;
constexpr size_t WS_B1 = 28 * MiB + 131072;
constexpr size_t WS_RSTD1 = 29 * MiB;
constexpr size_t WS_RSTD2 = 29 * MiB + 262144;
constexpr size_t WS_SS2P = 456 * MiB;
constexpr size_t WS_ROPE = 30 * MiB;
constexpr size_t WS_XH = 32 * MiB;
constexpr size_t WS_XR = 96 * MiB;
constexpr size_t WS_GRG = 128 * MiB;
constexpr size_t WS_Q = 160 * MiB;
constexpr size_t WS_HL = 192 * MiB;
constexpr size_t WS_HM = 32 * MiB;
constexpr size_t WS_AC = 224 * MiB;
constexpr size_t WS_KCT = 256 * MiB;
constexpr size_t WS_VCT = 265 * MiB;
constexpr size_t WS_KS = 274 * MiB, WS_VS = 282 * MiB, WS_KW = 290 * MiB, WS_VW = 298 * MiB;
constexpr size_t WS_GATE = 306 * MiB;
constexpr size_t WS_H1 = 310 * MiB;
constexpr size_t WS_CRAW = 314 * MiB;
constexpr size_t WS_KCC = 316 * MiB, WS_VCC = 317 * MiB;
constexpr size_t WS_AGG = 318 * MiB;
constexpr size_t WS_SSR = 326 * MiB, WS_SSA = 327 * MiB;
constexpr size_t WS_Y = 328 * MiB;
constexpr size_t WS_X1H = 392 * MiB;
constexpr size_t WS_CTL = 458 * MiB;
constexpr size_t CTL_BYTES = 16384;
constexpr size_t WS_END = 459 * MiB;

#define LDS_WAIT() asm volatile("s_waitcnt lgkmcnt(0)" ::: "memory")
__device__ __forceinline__ float wave_sum(float v) {
#pragma unroll
    for (int o = 1; o < 64; o <<= 1) v += __shfl_xor(v, o);
    return v;
}
__device__ __forceinline__ float wave_max(float v) {
#pragma unroll
    for (int o = 1; o < 64; o <<= 1) v = fmaxf(v, __shfl_xor(v, o));
    return v;
}
__device__ __forceinline__ float gelu_tanh(float x) {
    const float u = 0.7978845608028654f * (x + 0.044715f * x * x * x);
    return 0.5f * x * (1.0f + tanhf(u));
}
__device__ __forceinline__ float sigmoidf_(float x) { return 1.0f / (1.0f + __expf(-x)); }

struct Params {
    const float* x; const int* pos; const float* attn_norm_w; const float* w_in; const float* conv_w; const float* conv_b;
    const float* gate_a_w; const float* gate_a_b; const float* gate_x_w; const float* gate_x_b; const float* lru_lambda;
    const float* q_norm_w; const float* k_norm_w; const float* cmp_pos; const float* cmp_k_w1; const float* cmp_k_w2;
    const float* cmp_v_w1; const float* cmp_v_w2; const float* rnn_out_norm_w; const float* attn_out_norm_w; const float* w_out;
    const float* ffn_norm_w; const float* w_gate; const float* w_up; const float* w_down;
    float* out; unsigned char* ws; int ph_lo, ph_hi;
};

__device__ __forceinline__ void p0_transpose_item(const float* W, int K, int N, const float* s0, const float* s1, int ksplit,
                                                  h16* WT, int ldt, int mode, int nblk, float* scr, int item, int lane) {
    const int kb = item / nblk, nb = item % nblk, k0 = 64 * kb, n0 = 32 * nb;
#pragma unroll 8
    for (int i = 0; i < 32; ++i) {
        const int kk = 2 * i + (lane >> 5), n = n0 + (lane & 31), k = k0 + kk;
        float v = 0.f;
        if (n < N) { v = W[(size_t)k * N + n]; if (s0) v *= (k < ksplit) ? s0[k] : s1[k - ksplit]; }
        scr[kk * 33 + (lane & 31)] = v;
    }
    LDS_WAIT();
    const int c = lane & 7;
#pragma unroll
    for (int j = 0; j < 4; ++j) {
        const int nl = (lane >> 3) + 8 * j, n = n0 + nl;
        const float* s = scr + (8 * c) * 33 + nl;
        h16x8 o;
#pragma unroll
        for (int e = 0; e < 8; ++e) o[e] = (h16)s[e * 33];
        int orow = n;
        if (mode == 1) orow = (n >> 7) * 256 + (n & 127);
        else if (mode == 2) orow = (n >> 7) * 256 + (n & 127) + 128;
        *(h16x8*)(WT + (size_t)orow * ldt + k0 + 8 * c) = o;
    }
    LDS_WAIT();
}

__device__ __forceinline__ void phase0(const Params& P, unsigned char* lds, int tid, int lane, int wave, int bid, int nb) {
    unsigned char* ws = P.ws;
    float* scr = (float*)lds + wave * (64 * 33);
    const int gw = bid * NWAVES + wave, ngw = nb * NWAVES;
    constexpr int I_IN = 16 * 80, I_OUT = 16 * 32, I_G = 16 * 88, I_U = 16 * 88, I_D = 44 * 32, I_C1 = 32 * 8, I_C2 = 4 * 2;
    constexpr int NIT = I_IN + I_OUT + I_G + I_U + I_D + 2 * I_C1 + 2 * I_C2;
    for (int it = gw; it < NIT; it += ngw) {
        int r = it;
        const float* W; int K, N; const float* s0 = nullptr; const float* s1 = nullptr; int ksplit = 0; size_t wo; int ldt, mode = 0, nblk;
        if (r < I_IN) { W = P.w_in; K = 1024; N = DIN; s0 = P.attn_norm_w; s1 = P.attn_norm_w; ksplit = 1024; wo = WS_WIN; ldt = 1024; nblk = 80; }
        else if ((r -= I_IN) < I_OUT) { W = P.w_out; K = 1024; N = 1024; s0 = P.rnn_out_norm_w; s1 = P.attn_out_norm_w; ksplit = 512; wo = WS_WOUT; ldt = 1024; nblk = 32; }
        else if ((r -= I_OUT) < I_G) { W = P.w_gate; K = 1024; N = DFF; s0 = P.ffn_norm_w; s1 = P.ffn_norm_w; ksplit = 1024; wo = WS_WGU; ldt = 1024; mode = 1; nblk = 88; }
        else if ((r -= I_G) < I_U) { W = P.w_up; K = 1024; N = DFF; s0 = P.ffn_norm_w; s1 = P.ffn_norm_w; ksplit = 1024; wo = WS_WGU; ldt = 1024; mode = 2; nblk = 88; }
        else if ((r -= I_U) < I_D) { W = P.w_down; K = DFF; N = 1024; wo = WS_WD; ldt = DFF; nblk = 32; }
        else if ((r -= I_D) < I_C1) { W = P.cmp_k_w1; K = CMPK; N = CMPH; wo = WS_W1K; ldt = CMPK; nblk = 8; }
        else if ((r -= I_C1) < I_C1) { W = P.cmp_v_w1; K = CMPK; N = CMPH; wo = WS_W1V; ldt = CMPK; nblk = 8; }
        else if ((r -= I_C1) < I_C2) { W = P.cmp_k_w2; K = CMPH; N = HD; wo = WS_W2K; ldt = CMPH; nblk = 2; }
        else { r -= I_C2; W = P.cmp_v_w2; K = CMPH; N = HD; wo = WS_W2V; ldt = CMPH; nblk = 2; }
        p0_transpose_item(W, K, N, s0, s1, ksplit, (h16*)(ws + wo), ldt, mode, nblk, scr, r, lane);
    }
    h16* XH = (h16*)(ws + WS_XH); float* RSTD1 = (float*)(ws + WS_RSTD1);
    for (int m = gw; m < M; m += ngw) {
        const f32x4* xr = (const f32x4*)(P.x + (size_t)m * D) + lane;
        f32x4 v[4]; float s = 0.f;
#pragma unroll
        for (int j = 0; j < 4; ++j) { v[j] = xr[64 * j]; s += (v[j].x * v[j].x + v[j].y * v[j].y) + (v[j].z * v[j].z + v[j].w * v[j].w); }
        s = wave_sum(s);
        if (lane == 0) RSTD1[m] = 1.0f / sqrtf(s * (1.0f / D) + EPS);
        h16x4* o = (h16x4*)(XH + (size_t)m * D) + lane;
#pragma unroll
        for (int j = 0; j < 4; ++j) { h16x4 h; h.x = (h16)v[j].x; h.y = (h16)v[j].y; h.z = (h16)v[j].z; h.w = (h16)v[j].w; o[64 * j] = h; }
    }
    float* ROPE = (float*)(ws + WS_ROPE);
    for (int e = bid * NTHREADS + tid; e < M * 8; e += nb * NTHREADS) {
        const int m = e >> 3, i = e & 7;
        const float inv = (float)pow(500000.0, -(double)i / 8.0);
        const float ang = (float)P.pos[m] * inv;
        ROPE[m * 16 + i] = (float)cos((double)ang);
        ROPE[m * 16 + 8 + i] = (float)sin((double)ang);
    }
    if (bid < 64) {
        const int which = bid >> 5, n = (bid & 31) * 8 + (tid & 7), ks = tid >> 3;
        const float* w1 = (which ? P.cmp_v_w1 : P.cmp_k_w1) + n; const float* cp = P.cmp_pos + ks * 32;
        float s = 0.f;
#pragma unroll
        for (int k = 0; k < 32; ++k) s += cp[k] * w1[(size_t)(ks * 32 + k) * CMPH];
        float* red = (float*)lds + NWAVES * 64 * 33;
        red[tid] = s;
        __syncthreads();
        if (tid < 8) { float a = 0.f; for (int q = 0; q < 64; ++q) a += red[q * 8 + tid]; ((float*)(ws + WS_B1))[which * 256 + (bid & 31) * 8 + tid] = a; }
        __syncthreads();
    }
    if (bid == 64 % nb) {
        h16* kp = (h16*)(ws + WS_KCT) + (size_t)16 * T * 64; h16* vp = (h16*)(ws + WS_VCT) + (size_t)16 * T * 64;
        for (int e = tid; e < 2048; e += NTHREADS) { kp[e] = (h16)0.f; vp[e] = (h16)0.f; }
    }
}

struct GemmN { const h16* A1; int lda1; const h16* B1; int ldb1; int K1; const h16* A2; int lda2; const h16* B2; int ldb2; int K2; int Mr, Nc; int bmap; };
template <bool DUAL, class Epi>
__device__ __forceinline__ void gemm_naive(const GemmN& g, const Epi& epi, int gw, int ngw, int lane) {
    const int tn = g.Nc / 64, tm = g.Mr / 64, ntile = tm * tn;
    const int fr = lane & 15, fq = lane >> 4;
    for (int tile = gw; tile < ntile; tile += ngw) {
        const int tr = tile / tn, tc = tile % tn;
        f32x4 acc1[4][4], acc2[4][4];
#pragma unroll
        for (int i = 0; i < 4; ++i)
#pragma unroll
            for (int j = 0; j < 4; ++j) { acc1[i][j] = (f32x4){0.f, 0.f, 0.f, 0.f}; acc2[i][j] = (f32x4){0.f, 0.f, 0.f, 0.f}; }
        const int bcol = tc * 64 + fr;
        const int brow0 = g.bmap ? ((bcol >> 7) * 256 + (bcol & 127)) : bcol;
        {
            const h16* ap = g.A1 + (size_t)(tr * 64 + fr) * g.lda1 + fq * 8;
            const h16* bp = g.B1 + (size_t)brow0 * g.ldb1 + fq * 8;
            for (int k0 = 0; k0 < g.K1; k0 += 32) {
                h16x8 a[4], b[4];
#pragma unroll
                for (int i = 0; i < 4; ++i) a[i] = *(const h16x8*)(ap + (size_t)i * 16 * g.lda1 + k0);
#pragma unroll
                for (int j = 0; j < 4; ++j) b[j] = *(const h16x8*)(bp + (size_t)j * 16 * g.ldb1 + k0);
#pragma unroll
                for (int i = 0; i < 4; ++i)
#pragma unroll
                    for (int j = 0; j < 4; ++j) acc1[i][j] = __builtin_amdgcn_mfma_f32_16x16x32_f16(a[i], b[j], acc1[i][j], 0, 0, 0);
            }
        }
        if (DUAL) {
            const h16* ap = g.A2 + (size_t)(tr * 64 + fr) * g.lda2 + fq * 8;
            const h16* bp = g.B2 + (size_t)(brow0 + (g.bmap ? 128 : 0)) * g.ldb2 + fq * 8;
            for (int k0 = 0; k0 < g.K2; k0 += 32) {
                h16x8 a[4], b[4];
#pragma unroll
                for (int i = 0; i < 4; ++i) a[i] = *(const h16x8*)(ap + (size_t)i * 16 * g.lda2 + k0);
#pragma unroll
                for (int j = 0; j < 4; ++j) b[j] = *(const h16x8*)(bp + (size_t)j * 16 * g.ldb2 + k0);
#pragma unroll
                for (int i = 0; i < 4; ++i)
#pragma unroll
                    for (int j = 0; j < 4; ++j) acc2[i][j] = __builtin_amdgcn_mfma_f32_16x16x32_f16(a[i], b[j], acc2[i][j], 0, 0, 0);
            }
        }
#pragma unroll
        for (int i = 0; i < 4; ++i)
#pragma unroll
            for (int j = 0; j < 4; ++j)
#pragma unroll
                for (int r = 0; r < 4; ++r) epi(tr * 64 + 16 * i + 4 * fq + r, tc * 64 + 16 * j + fr, acc1[i][j][r], DUAL ? acc2[i][j][r] : 0.f);
    }
}

struct EpiProj {
    unsigned char* ws;
    __device__ __forceinline__ void operator()(int m, int c, float v, float) const {
        v *= ((const float*)(ws + WS_RSTD1))[m];
        if (c < 512) { ((h16*)(ws + WS_XR))[(size_t)m * 512 + c] = (h16)v; return; }
        if (c < 1024) { ((h16*)(ws + WS_GRG))[(size_t)m * 512 + c - 512] = (h16)gelu_tanh(v); return; }
        if (c < 1536) { ((h16*)(ws + WS_Q))[(size_t)m * 512 + c - 1024] = (h16)v; return; }
        if (c < 2304) {
            const int idx = (c - 1536) >> 7, cc = (c - 1536) & 127, g = cc >> 6, d = cc & 63, b = m >> 12, t = m & 4095;
            const size_t off = ((size_t)(b * 2 + g) * T + t) * 64 + d;
            h16* base = (h16*)(ws + (idx == 0 ? WS_KCT : idx == 1 ? WS_VCT : idx == 2 ? WS_KS : idx == 3 ? WS_VS : idx == 4 ? WS_KW : WS_VW));
            base[off] = (h16)v; return;
        }
        if (c < DIN) ((float*)(ws + WS_GATE))[(size_t)m * 24 + c - 2304] = sigmoidf_(v);
    }
};
struct EpiCmpA {
    h16* H1; const float* b1;
    __device__ __forceinline__ void operator()(int r, int c, float v, float) const { H1[(size_t)r * CMPH + c] = (h16)gelu_tanh(v + b1[c]); }
};
struct EpiCmpB {
    float* O;
    __device__ __forceinline__ void operator()(int r, int c, float v, float) const { O[(size_t)r * HD + c] = v; }
};
struct EpiOut {
    const float* x; float* out; h16* x1h; const float* rsr; const float* ssa2;
    __device__ __forceinline__ void operator()(int m, int c, float v1, float v2) const {
        const float s1 = rsr[m], s2 = 1.0f / sqrtf((ssa2[m * 2] + ssa2[m * 2 + 1]) * (1.0f / 512.0f) + EPS);
        const float x1 = x[(size_t)m * D + c] + s1 * v1 + s2 * v2;
        out[(size_t)m * D + c] = x1; x1h[(size_t)m * D + c] = (h16)x1;
    }
};
struct EpiGU {
    h16* hm; const float* rstd2;
    __device__ __forceinline__ void operator()(int m, int c, float vg, float vu) const {
        const float r = rstd2[m], g = vg * r, u = vu * r;
        hm[(size_t)m * DFF + c] = (h16)(g * sigmoidf_(g) * u);
    }
};
struct EpiDown {
    float* out;
    __device__ __forceinline__ void operator()(int m, int c, float v, float) const { out[(size_t)m * D + c] += v; }
};

namespace pg8 {
#define PG8_LAS __attribute__((address_space(3)))
typedef unsigned short bf16_t;
typedef _Float16 bf16x8 __attribute__((ext_vector_type(8)));
typedef float f32x4 __attribute__((ext_vector_type(4)));
typedef unsigned u32x4 __attribute__((ext_vector_type(4)));
constexpr int BM = 256, BK = 64, HALF = 128, HTB = HALF * BK * 2  , STAGE_BYTES = 8 * HTB, NXCD = 8, WGM = 8;

__host__ __device__ __forceinline__ int lds_byte(int r, int c) { const int st = (r >> 4) * 2 + (c >> 5), rr = r & 15, cc = c & 31, ob = rr * 64 + cc * 2; return st * 1024 + (ob ^ (((ob >> 9) & 1) << 5)); }
__host__ __device__ __forceinline__ void stage_rc(int b, int& R, int& C) { const int st = b / 1024, sb = b % 1024, swz = sb ^ (((sb >> 9) & 1) << 5); R = (st >> 1) * 16 + swz / 64; C = (st & 1) * 32 + (swz % 64) / 2; }
__host__ __device__ __forceinline__ int perm32(int rho) { const int n = rho >> 4, i = rho & 15; return 8 * (i >> 2) + 4 * n + (i & 3); }

struct Unit { int pm, pn; };
struct Gemm { const bf16_t* A; const bf16_t* Bt; int M, N, K; };

struct StaticOrder {
    int nM, nN, nwg, G, c;
    __host__ __device__ void init(int M, int N, int G_, int c_) { nM = M / BM; nN = N / BM; nwg = nM * nN; G = G_; c = c_; }
    __host__ __device__ bool next(int i, Unit& u) const {
        const long L = (long)i * G + c; if (L >= nwg) return false;
        int wgid = (int)L; { const int q = nwg / NXCD, r = nwg % NXCD, xcd = wgid % NXCD, off = wgid / NXCD; wgid = (xcd < r ? xcd * (q + 1) : r * (q + 1) + (xcd - r) * q) + off; }
        const int nig = WGM * nN, gid = wgid / nig, fm = gid * WGM, gsz = (nM - fm) < WGM ? (nM - fm) : WGM;
        u.pm = fm + ((wgid % nig) % gsz); u.pn = (wgid % nig) / gsz; return true;
    }
    __device__ __forceinline__ void a_ready(const Unit&) const {}
    __device__ __forceinline__ void done(const Unit&) const {}
};
template <class Epi, class Sched, bool ALIGN_EPI = false, bool SP2 = false>
__device__ __forceinline__ void gemm_phase(PG8_LAS unsigned char* lds, const Gemm g, const Sched& S, const Epi& E) {
    const int tid = threadIdx.x, wid = __builtin_amdgcn_readfirstlane(tid >> 6), lane = tid & 63, wr = wid >> 2, wc = wid & 3, fr = lane & 15, fq = lane >> 4;
    const int K = g.K, nt = K / BK;
    unsigned voffA[2], voffB[2];
#pragma unroll
    for (int i = 0; i < 2; ++i) { int R, C; stage_rc(tid * 16 + i * 8192, R, C); const int Rb = Epi::PERM ? ((R & ~31) + perm32(R & 31)) : R;
        voffA[i] = (unsigned)(R * K + C) * 2u; voffB[i] = (unsigned)(Rb * K + C) * 2u; }
    const size_t kstep = (size_t)(BK * 2);
    const size_t hstep = (size_t)HALF * K * 2;
    const size_t tstep = 2 * hstep;
    const unsigned ldsw = (unsigned)wid * 1024u;
    const int aoff = lds_byte(wr * 64 + fr, fq * 8), boff = lds_byte(wc * 32 + fr, fq * 8);
#define PG8_SA(b, h) (((b) * 2 + (h)) * HTB)
#define PG8_SB(b, h) ((4 + (b) * 2 + (h)) * HTB)
#define PG8_STAGE(bufoff, gbase, voff) do { _Pragma("unroll") for (int _i = 0; _i < 2; ++_i) \
        __builtin_amdgcn_global_load_lds((const unsigned*)((const char*)(gbase) + (voff)[_i]), (PG8_LAS unsigned*)(lds + (bufoff) + ldsw + _i * 8192), 16, 0, 0); } while (0)
#define PG8_LDA(dst, b, h) do { _Pragma("unroll") for (int m = 0; m < 4; ++m) _Pragma("unroll") for (int k = 0; k < 2; ++k) dst[m][k] = *(const PG8_LAS bf16x8*)(lds + PG8_SA(b, h) + aoff + m * 2048 + k * 1024); } while (0)
#define PG8_LDB(dst, b, h) do { _Pragma("unroll") for (int n = 0; n < 2; ++n) _Pragma("unroll") for (int k = 0; k < 2; ++k) dst[n][k] = *(const PG8_LAS bf16x8*)(lds + PG8_SB(b, h) + boff + n * 2048 + k * 1024); } while (0)
#define PG8_MMA(ai, bj, At, Bt) do { __builtin_amdgcn_s_setprio(1); _Pragma("unroll") for (int m = 0; m < 4; ++m) _Pragma("unroll") for (int n = 0; n < 2; ++n) _Pragma("unroll") for (int k = 0; k < 2; ++k) \
        acc[ai][bj][m][n] = __builtin_amdgcn_mfma_f32_16x16x32_f16(Bt[n][k], At[m][k], acc[ai][bj][m][n], 0, 0, 0); __builtin_amdgcn_s_setprio(0); } while (0)
#define PG8_WAIT_V(n) asm volatile("s_waitcnt vmcnt(" #n ")" ::: "memory")
#define PG8_WAIT_L(n) asm volatile("s_waitcnt lgkmcnt(" #n ")" ::: "memory")
#define PG8_BAR __builtin_amdgcn_s_barrier()
#define PG8_SCHED __builtin_amdgcn_sched_barrier(0)
    Unit cur, nxt; int ui = 0;
    if (!S.next(0, cur)) return;
    f32x4 acc[2][2][4][2];
#pragma unroll
    for (int a = 0; a < 2; ++a)
#pragma unroll
        for (int b = 0; b < 2; ++b)
#pragma unroll
            for (int m = 0; m < 4; ++m)
#pragma unroll
                for (int n = 0; n < 2; ++n) acc[a][b][m][n] = (f32x4){0.f, 0.f, 0.f, 0.f};
    bf16x8 At[4][2], B0[2][2], B1[2][2];
    const char* cA = (const char*)g.A + (size_t)cur.pm * tstep; const char* cB = (const char*)g.Bt + (size_t)cur.pn * tstep;
    S.a_ready(cur);
    if constexpr (SP2) {
        PG8_STAGE(PG8_SB(0, 0), cB, voffB); PG8_STAGE(PG8_SB(0, 1), cB + hstep, voffB); PG8_STAGE(PG8_SA(0, 0), cA, voffA); PG8_STAGE(PG8_SA(0, 1), cA + hstep, voffA);
        if (wr == 1) PG8_BAR;
        PG8_WAIT_V(2); PG8_BAR;
        PG8_STAGE(PG8_SB(1, 0), cB + kstep, voffB); PG8_STAGE(PG8_SA(1, 0), cA + kstep, voffA); PG8_STAGE(PG8_SB(1, 1), cB + hstep + kstep, voffB);
        PG8_WAIT_V(6); PG8_BAR;
    } else {
        PG8_STAGE(PG8_SB(0, 0), cB, voffB); PG8_STAGE(PG8_SA(0, 0), cA, voffA); PG8_STAGE(PG8_SB(0, 1), cB + hstep, voffB); PG8_STAGE(PG8_SA(0, 1), cA + hstep, voffA);
        if (wr == 1) PG8_BAR;
        PG8_WAIT_V(4); PG8_BAR;
        PG8_STAGE(PG8_SB(1, 0), cB + kstep, voffB); PG8_STAGE(PG8_SA(1, 0), cA + kstep, voffA); PG8_STAGE(PG8_SB(1, 1), cB + hstep + kstep, voffB);
        PG8_WAIT_V(6); PG8_BAR;
    }
    for (;;) {
        const bool has_next = S.next(ui + 1, nxt);
        const char* nA = has_next ? (const char*)g.A + (size_t)nxt.pm * tstep : cA; const char* nB = has_next ? (const char*)g.Bt + (size_t)nxt.pn * tstep : cB;
        for (int t = 0; t < nt; t += 2) {
            const bool last = (t == nt - 2);
            const char* a1 = cA + (size_t)(t + 1) * kstep;
            const char* a2 = last ? nA : cA + (size_t)(t + 2) * kstep; const char* b2 = last ? nB : cB + (size_t)(t + 2) * kstep;
            const char* a3 = a2 + kstep; const char* b3 = b2 + kstep;
            if (last && has_next) S.a_ready(nxt);
            if constexpr (Epi::MIDK) { if (t == nt / 2) E.mid(acc, cur, wr, wc, fr, fq); }
            if constexpr (SP2) {
            PG8_LDB(B0, 0, 0); PG8_LDB(B1, 0, 1); PG8_SCHED; PG8_LDA(At, 0, 0); PG8_STAGE(PG8_SA(1, 1), a1 + hstep, voffA);
            PG8_WAIT_V(8); PG8_WAIT_L(0); PG8_BAR; PG8_MMA(0, 0, At, B0); PG8_MMA(0, 1, At, B1); PG8_BAR; PG8_SCHED;
            PG8_LDA(At, 0, 1); PG8_STAGE(PG8_SB(0, 0), b2, voffB); PG8_STAGE(PG8_SB(0, 1), b2 + hstep, voffB); PG8_STAGE(PG8_SA(0, 0), a2, voffA);
            PG8_WAIT_V(8); PG8_WAIT_L(0); PG8_BAR; PG8_MMA(1, 0, At, B0); PG8_MMA(1, 1, At, B1); PG8_BAR; PG8_SCHED;
            PG8_LDB(B0, 1, 0); PG8_LDB(B1, 1, 1); PG8_SCHED; PG8_LDA(At, 1, 0); PG8_STAGE(PG8_SA(0, 1), a2 + hstep, voffA);
            PG8_WAIT_V(8); PG8_WAIT_L(0); PG8_BAR; PG8_MMA(0, 0, At, B0); PG8_MMA(0, 1, At, B1); PG8_BAR; PG8_SCHED;
            PG8_LDA(At, 1, 1); PG8_STAGE(PG8_SB(1, 0), b3, voffB); PG8_STAGE(PG8_SB(1, 1), b3 + hstep, voffB); PG8_STAGE(PG8_SA(1, 0), a3, voffA);
            PG8_WAIT_V(8); PG8_WAIT_L(0); PG8_BAR; PG8_MMA(1, 0, At, B0); PG8_MMA(1, 1, At, B1); PG8_BAR; PG8_SCHED;
            } else {
            PG8_LDB(B0, 0, 0); PG8_SCHED; PG8_LDA(At, 0, 0); PG8_STAGE(PG8_SA(1, 1), a1 + hstep, voffA);
            PG8_WAIT_L(8); PG8_BAR; PG8_WAIT_L(0); PG8_MMA(0, 0, At, B0); PG8_BAR; PG8_SCHED;
            PG8_LDB(B1, 0, 1); PG8_STAGE(PG8_SB(0, 0), b2, voffB);
            PG8_BAR; PG8_WAIT_L(0); PG8_MMA(0, 1, At, B1); PG8_BAR;
            PG8_LDA(At, 0, 1); PG8_STAGE(PG8_SA(0, 0), a2, voffA);
            PG8_BAR; PG8_WAIT_L(0); PG8_MMA(1, 0, At, B0); PG8_BAR; PG8_SCHED;
            PG8_STAGE(PG8_SB(0, 1), b2 + hstep, voffB);
            PG8_WAIT_V(6); PG8_BAR; PG8_MMA(1, 1, At, B1); PG8_BAR;
            PG8_LDB(B0, 1, 0); PG8_SCHED; PG8_LDA(At, 1, 0); PG8_STAGE(PG8_SA(0, 1), a2 + hstep, voffA);
            PG8_WAIT_L(8); PG8_BAR; PG8_WAIT_L(0); PG8_MMA(0, 0, At, B0); PG8_BAR; PG8_SCHED;
            PG8_LDB(B1, 1, 1); PG8_STAGE(PG8_SB(1, 0), b3, voffB);
            PG8_BAR; PG8_WAIT_L(0); PG8_MMA(0, 1, At, B1); PG8_BAR;
            PG8_LDA(At, 1, 1); PG8_STAGE(PG8_SA(1, 0), a3, voffA);
            PG8_BAR; PG8_WAIT_L(0); PG8_MMA(1, 0, At, B0); PG8_BAR; PG8_SCHED;
            PG8_STAGE(PG8_SB(1, 1), b3 + hstep, voffB);
            PG8_WAIT_V(6); PG8_BAR; PG8_MMA(1, 1, At, B1); PG8_BAR;
            }
        }
        if constexpr (ALIGN_EPI) { if (wr == 0) PG8_BAR; }
        if constexpr (!Epi::AFTER_DRAIN) { E(acc, cur, wr, wc, fr, fq); S.done(cur); }
        if (!has_next) break;
#pragma unroll
        for (int a = 0; a < 2; ++a)
#pragma unroll
            for (int b = 0; b < 2; ++b)
#pragma unroll
                for (int m = 0; m < 4; ++m)
#pragma unroll
                    for (int n = 0; n < 2; ++n) acc[a][b][m][n] = (f32x4){0.f, 0.f, 0.f, 0.f};
        cur = nxt; cA = nA; cB = nB; ++ui;
        if constexpr (ALIGN_EPI) { if (wr == 1) PG8_BAR; }
    }
    PG8_WAIT_V(0);
    if constexpr (!ALIGN_EPI) { if (wr == 0) PG8_BAR; }
    PG8_BAR;
    if constexpr (Epi::AFTER_DRAIN) { E.fused(acc, cur, wr, wc, fr, fq, lds, wid, lane); S.done(cur); }
#undef PG8_SA
#undef PG8_SB
#undef PG8_STAGE
#undef PG8_LDA
#undef PG8_LDB
#undef PG8_MMA
#undef PG8_WAIT_V
#undef PG8_WAIT_L
#undef PG8_BAR
#undef PG8_SCHED
}
}

__device__ __forceinline__ float fsigmoid(float x) { return __builtin_amdgcn_rcpf(1.0f + __builtin_amdgcn_exp2f(-1.4426950408889634f * x)); }
__device__ __forceinline__ float fgelu_tanh(float x) { const float u2 = 1.5957691216057308f * (x + 0.044715f * x * x * x); return x * fsigmoid(u2); }
__device__ __forceinline__ h16x8 pack8(const f32x4 a, const f32x4 b) {
    h16x8 o; o[0] = (h16)a[0]; o[1] = (h16)a[1]; o[2] = (h16)a[2]; o[3] = (h16)a[3]; o[4] = (h16)b[0]; o[5] = (h16)b[1]; o[6] = (h16)b[2]; o[7] = (h16)b[3]; return o;
}
struct EpiProjF {
    static constexpr bool PERM = true, AFTER_DRAIN = false, MIDK = false;
    unsigned char* ws;
    __device__ __forceinline__ void operator()(const f32x4 (&acc)[2][2][4][2], const pg8::Unit& u, int wr, int wc, int fr, int fq) const {
        const float* RSTD1 = (const float*)(ws + WS_RSTD1);
        const int row0 = u.pm * 256 + wr * 64 + fr, pn = u.pn, c8 = wc * 32 + 8 * fq;
#pragma unroll
        for (int ai = 0; ai < 2; ++ai)
#pragma unroll
            for (int m = 0; m < 4; ++m) {
                const int row = row0 + ai * 128 + m * 16; const float rs = RSTD1[row];
#pragma unroll
                for (int bj = 0; bj < 2; ++bj) {
                    f32x4 v0 = acc[ai][bj][m][0] * rs, v1 = acc[ai][bj][m][1] * rs;
                    const int cb = bj * 128 + c8;
                    if (pn < 2) { *(h16x8*)((h16*)(ws + WS_XR) + (size_t)row * 512 + pn * 256 + cb) = pack8(v0, v1); }
                    else if (pn < 4) {
#pragma unroll
                        for (int e = 0; e < 4; ++e) { v0[e] = fgelu_tanh(v0[e]); v1[e] = fgelu_tanh(v1[e]); }
                        *(h16x8*)((h16*)(ws + WS_GRG) + (size_t)row * 512 + (pn - 2) * 256 + cb) = pack8(v0, v1); }
                    else if (pn < 6) { *(h16x8*)((h16*)(ws + WS_Q) + (size_t)row * 512 + (pn - 4) * 256 + cb) = pack8(v0, v1); }
                    else if (pn < 9) {
                        const int idx = 2 * (pn - 6) + bj, g = c8 >> 6, d = c8 & 63, b = row >> 12, t = row & 4095;
                        h16* base = (h16*)(ws + (idx == 0 ? WS_KCT : idx == 1 ? WS_VCT : idx == 2 ? WS_KS : idx == 3 ? WS_VS : idx == 4 ? WS_KW : WS_VW));
                        *(h16x8*)(base + ((size_t)(b * 2 + g) * T + t) * 64 + d) = pack8(v0, v1); }
                    else if (bj == 0 && c8 < 24) {
                        float* gp = (float*)(ws + WS_GATE) + (size_t)row * 24 + c8;
#pragma unroll
                        for (int e = 0; e < 4; ++e) { v0[e] = fsigmoid(v0[e]); v1[e] = fsigmoid(v1[e]); }
                        *(f32x4*)gp = v0; *(f32x4*)(gp + 4) = v1; }
                }
            }
    }
};
struct EpiOutF {
    static constexpr bool PERM = false, AFTER_DRAIN = false, MIDK = true;
    const float* x; float* out; h16* x1h; const float* rsr; const float* ssa2; float* ss2p;
    __device__ __forceinline__ float rsa_of(int row) const { const f32x2 a = *(const f32x2*)(ssa2 + (size_t)row * 2); return 1.0f / sqrtf((a[0] + a[1]) * (1.0f / 512.0f) + EPS); }
    __device__ __forceinline__ void mid(f32x4 (&acc)[2][2][4][2], const pg8::Unit& u, int wr, int wc, int fr, int fq) const {
        int row0 = u.pm * 256 + wr * 64 + fr; asm volatile("" : "+v"(row0));
#pragma unroll
        for (int ai = 0; ai < 2; ++ai)
#pragma unroll
            for (int m = 0; m < 4; ++m) { const int row = row0 + ai * 128 + m * 16; const float ratio = rsr[row] / rsa_of(row);
#pragma unroll
                for (int bj = 0; bj < 2; ++bj)
#pragma unroll
                    for (int n = 0; n < 2; ++n) acc[ai][bj][m][n] *= ratio; }
    }
    __device__ __forceinline__ void operator()(const f32x4 (&acc)[2][2][4][2], const pg8::Unit& u, int wr, int wc, int fr, int fq) const {
        const int row0 = u.pm * 256 + wr * 64 + fr, col0 = u.pn * 256 + wc * 32 + 4 * fq;
#pragma unroll
        for (int ai = 0; ai < 2; ++ai)
#pragma unroll
            for (int m = 0; m < 4; ++m) { const int row = row0 + ai * 128 + m * 16; const float s2 = rsa_of(row); float ss = 0.f;
#pragma unroll
                for (int bj = 0; bj < 2; ++bj)
#pragma unroll
                    for (int n = 0; n < 2; ++n) { const size_t off = (size_t)row * D + col0 + bj * 128 + n * 16;
                        const f32x4 v = *(const f32x4*)(x + off) + acc[ai][bj][m][n] * s2;
                        *(f32x4*)(out + off) = v; h16x4 h; h[0] = (h16)v[0]; h[1] = (h16)v[1]; h[2] = (h16)v[2]; h[3] = (h16)v[3]; *(h16x4*)(x1h + off) = h;
                        ss += (v[0] * v[0] + v[1] * v[1]) + (v[2] * v[2] + v[3] * v[3]); }
                ss += __shfl_xor(ss, 16); ss += __shfl_xor(ss, 32);
                if (fq == 0) ss2p[(size_t)row * 16 + u.pn * 4 + wc] = ss;
                if (m & 1) asm volatile("" ::: "memory"); }
    }
};
struct EpiGUF {
    static constexpr bool PERM = true, AFTER_DRAIN = false, MIDK = false;
    h16* hm; const float* ss2p;
    __device__ __forceinline__ void operator()(const f32x4 (&acc)[2][2][4][2], const pg8::Unit& u, int wr, int wc, int fr, int fq) const {
        const int row0 = u.pm * 256 + wr * 64 + fr, col = u.pn * 128 + wc * 32 + 8 * fq;
#pragma unroll
        for (int ai = 0; ai < 2; ++ai)
#pragma unroll
            for (int m = 0; m < 4; ++m) { const int row = row0 + ai * 128 + m * 16; const f32x4* sp = (const f32x4*)(ss2p + (size_t)row * 16);
                const f32x4 s0 = sp[0], s1 = sp[1], s2 = sp[2], s3 = sp[3];
                const float tot = ((s0[0] + s0[1]) + (s0[2] + s0[3])) + ((s1[0] + s1[1]) + (s1[2] + s1[3])) + ((s2[0] + s2[1]) + (s2[2] + s2[3])) + ((s3[0] + s3[1]) + (s3[2] + s3[3]));
                const float rs = 1.0f / sqrtf(tot * (1.0f / D) + EPS);
                f32x4 o[2];
#pragma unroll
                for (int n = 0; n < 2; ++n) { const f32x4 g = acc[ai][0][m][n] * rs, uu = acc[ai][1][m][n] * rs;
#pragma unroll
                    for (int e = 0; e < 4; ++e) o[n][e] = g[e] * fsigmoid(g[e]) * uu[e]; }
                *(h16x8*)(hm + (size_t)row * DFF + col) = pack8(o[0], o[1]); }
    }
};
struct EpiDownF {
    static constexpr bool PERM = false, AFTER_DRAIN = false, MIDK = false;
    float* out;
    __device__ __forceinline__ void operator()(const f32x4 (&acc)[2][2][4][2], const pg8::Unit& u, int wr, int wc, int fr, int fq) const {
        const int row0 = u.pm * 256 + wr * 64 + fr, col0 = u.pn * 256 + wc * 32 + 4 * fq;
#pragma unroll
        for (int ai = 0; ai < 2; ++ai)
#pragma unroll
            for (int m = 0; m < 4; ++m) { const int row = row0 + ai * 128 + m * 16;
#pragma unroll
                for (int bj = 0; bj < 2; ++bj)
#pragma unroll
                    for (int n = 0; n < 2; ++n) { float* p = out + (size_t)row * D + col0 + bj * 128 + n * 16; *(f32x4*)p = *(const f32x4*)p + acc[ai][bj][m][n]; } }
    }
};

__device__ __forceinline__ void normrope_rows(const Params& P, int gw, int ngw, int lane) {
    unsigned char* ws = P.ws;
    const float* ROPE = (const float*)(ws + WS_ROPE);
    const int sub = lane & 7;
    for (int m = gw; m < M; m += ngw) {
        const int b = m >> 12, t = m & 4095;
        float cs[8], sn[8];
#pragma unroll
        for (int i = 0; i < 8; ++i) { cs[i] = ROPE[m * 16 + i]; sn[i] = ROPE[m * 16 + 8 + i]; }
#pragma unroll
        for (int which = 0; which < 3; ++which) {
            h16* p; const float* nw; float scale;
            bool act = true;
            if (which == 0) { p = (h16*)(ws + WS_Q) + (size_t)m * 512 + (lane >> 3) * 64 + sub * 8; nw = P.q_norm_w; scale = C2; }
            else { act = lane < 16; const int g = (lane >> 3) & 1; p = (h16*)(ws + (which == 1 ? WS_KS : WS_KW)) + ((size_t)(b * 2 + g) * T + t) * 64 + sub * 8; nw = P.k_norm_w; scale = 1.0f; }
            float v[8]; float ss = 0.f;
            if (act) { const h16x8 h = *(const h16x8*)p;
#pragma unroll
                for (int e = 0; e < 8; ++e) { v[e] = (float)h[e]; ss += v[e] * v[e]; } }
            else {
#pragma unroll
                for (int e = 0; e < 8; ++e) v[e] = 0.f; }
            ss += __shfl_xor(ss, 1); ss += __shfl_xor(ss, 2); ss += __shfl_xor(ss, 4);
            const float rstd = 1.0f / sqrtf(ss * (1.0f / 64.0f) + EPS);
#pragma unroll
            for (int e = 0; e < 8; ++e) v[e] = v[e] * rstd * nw[sub * 8 + e];
            float o[8];
#pragma unroll
            for (int e = 0; e < 8; ++e) {
                const float other = __shfl_xor(v[e], 1);
                if (sub == 0) o[e] = v[e] * cs[e] - other * sn[e];
                else if (sub == 1) o[e] = v[e] * cs[e] + other * sn[e];
                else o[e] = v[e];
            }
            if (act) { h16x8 h;
#pragma unroll
                for (int e = 0; e < 8; ++e) h[e] = (h16)(o[e] * scale);
                *(h16x8*)p = h; }
        }
    }
}

__device__ __forceinline__ void rglru_local(const Params& P, unsigned char* lds, int tid, int lane, int wave, int bid, int nb) {
    unsigned char* ws = P.ws;
    float* WA = (float*)lds;
    float* WX = WA + 4096;
    float* XC = WX + 4096 + wave * 64;
    const h16* XR = (const h16*)(ws + WS_XR);
    h16* HL = (h16*)(ws + WS_HL); h16* AC = (h16*)(ws + WS_AC); float* AGG = (float*)(ws + WS_AGG);
    for (int item = bid; item < 8 * 8 * 32; item += nb) {
        const int n = item & 7, b = (item >> 3) & 7, ck = item >> 6;
        __syncthreads();
        for (int e = tid; e < 4096; e += NTHREADS) { WA[e] = P.gate_a_w[n * 4096 + e]; WX[e] = P.gate_x_w[n * 4096 + e]; }
        __syncthreads();
        const int ch = n * 64 + lane;
        const float cw0 = P.conv_w[0 * 512 + ch], cw1 = P.conv_w[1 * 512 + ch], cw2 = P.conv_w[2 * 512 + ch], cw3 = P.conv_w[3 * 512 + ch], cb = P.conv_b[ch];
        const float ba = P.gate_a_b[ch], bx = P.gate_x_b[ch];
        const float lam = P.lru_lambda[ch];
        const float sp8 = -8.0f * log1pf(expf(-lam));
        const int seg = ck * 8 + wave, t0 = seg * 16;
        const size_t mrow = (size_t)b * T + t0;
        float x0 = (t0 >= 3) ? (float)XR[(mrow - 3) * 512 + ch] : 0.f;
        float x1 = (t0 >= 2) ? (float)XR[(mrow - 2) * 512 + ch] : 0.f;
        float x2 = (t0 >= 1) ? (float)XR[(mrow - 1) * 512 + ch] : 0.f;
        float h = 0.f, Acum = 1.0f;
        for (int tt = 0; tt < 16; ++tt) {
            const float x3 = (float)XR[(mrow + tt) * 512 + ch];
            const float xc = cb + cw0 * x0 + cw1 * x1 + cw2 * x2 + cw3 * x3;
            x0 = x1; x1 = x2; x2 = x3;
            LDS_WAIT();
            XC[lane] = xc;
            LDS_WAIT();
            float sa = ba, sx = bx;
#pragma unroll 16
            for (int d = 0; d < 64; ++d) { const float xd = XC[d]; sa += xd * WA[d * 64 + lane]; sx += xd * WX[d * 64 + lane]; }
            const float r = sigmoidf_(sa), ig = sigmoidf_(sx);
            const float la = sp8 * r;
            const float a = expf(la);
            const float bq = sqrtf(-expm1f(2.0f * la)) * (ig * xc);
            h = a * h + bq; Acum *= a;
            HL[(mrow + tt) * 512 + ch] = (h16)h; AC[(mrow + tt) * 512 + ch] = (h16)Acum;
        }
        float* ag = AGG + (((size_t)(b * 8 + n) * 256 + seg) * 2) * 64;
        ag[lane] = Acum; ag[64 + lane] = h;
    }
}

__device__ __forceinline__ void rglru_fixup(const Params& P, int gw, int ngw, int lane) {
    unsigned char* ws = P.ws;
    const h16* HL = (const h16*)(ws + WS_HL); const h16* AC = (const h16*)(ws + WS_AC); const h16* GRG = (const h16*)(ws + WS_GRG);
    const float* AGG = (const float*)(ws + WS_AGG);
    h16* Y = (h16*)(ws + WS_Y); float* RSR = (float*)(ws + WS_SSR);
    for (int item = gw; item < 8 * 256; item += ngw) {
        const int seg = item & 255, b = item >> 8;
        const size_t mrow = (size_t)b * T + seg * 16;
        float ssq = 0.f;
        for (int n = 0; n < 8; ++n) {
            const float* ag = AGG + ((size_t)(b * 8 + n) * 256) * 128;
            float carry = 0.f;
            for (int s = 0; s < seg; ++s) carry = ag[s * 128 + lane] * carry + ag[s * 128 + 64 + lane];
            const int ch = n * 64 + lane;
            for (int tt = 0; tt < 16; ++tt) {
                const size_t m = mrow + tt;
                const float hv = (float)HL[m * 512 + ch] + (float)AC[m * 512 + ch] * carry;
                const float y = (float)GRG[m * 512 + ch] * hv;
                Y[m * 1024 + ch] = (h16)y;
                const float ss = wave_sum(y * y);
                if (lane == tt) ssq += ss;
            }
        }
        if (lane < 16) RSR[mrow + lane] = 1.0f / sqrtf(ssq * (1.0f / 512.0f) + EPS);
    }
}

__device__ __forceinline__ void compress_finish(const Params& P, int gw, int ngw, int lane) {
    unsigned char* ws = P.ws;
    const float* CR = (const float*)(ws + WS_CRAW); const float* ROPE = (const float*)(ws + WS_ROPE);
    h16* KCC = (h16*)(ws + WS_KCC); h16* VCC = (h16*)(ws + WS_VCC);
    for (int r = gw; r < 4096; r += ngw) {
        const int bg = r >> 8, c = r & 255, b = bg >> 1;
        float kv = CR[(size_t)r * 64 + lane], vv = CR[(size_t)(4096 + r) * 64 + lane];
        if (c == 255) { KCC[(size_t)r * 64 + lane] = (h16)0.f; VCC[(size_t)r * 64 + lane] = (h16)0.f; continue; }
        const float ss = wave_sum(kv * kv);
        kv = kv * (1.0f / sqrtf(ss * (1.0f / 64.0f) + EPS)) * P.k_norm_w[lane];
        const int mp = b * T + 16 * c + 31;
        const float other = __shfl_xor(kv, 8);
        float o = kv;
        if (lane < 8) o = kv * ROPE[mp * 16 + lane] - other * ROPE[mp * 16 + 8 + lane];
        else if (lane < 16) o = kv * ROPE[mp * 16 + lane - 8] + other * ROPE[mp * 16 + 8 + lane - 8];
        KCC[(size_t)r * 64 + lane] = (h16)o; VCC[(size_t)r * 64 + lane] = (h16)vv;
    }
}

__device__ __forceinline__ void qk4(const h16* krow, const float* qs, float (&s)[4]) {
    s[0] = s[1] = s[2] = s[3] = 0.f;
#pragma unroll
    for (int c = 0; c < 8; ++c) {
        const h16x8 k8 = *(const h16x8*)(krow + c * 8);
#pragma unroll
        for (int e = 0; e < 8; ++e) { const float kf = (float)k8[e];
#pragma unroll
            for (int h = 0; h < 4; ++h) s[h] += qs[h * 64 + c * 8 + e] * kf; }
    }
}
__device__ __forceinline__ void attn_group(const h16* Kb, const h16* Vb, int key, bool valid, int nk, const float* qs, float* ps,
                                           float (&mx)[4], float (&l)[4], float (&o)[4], int lane) {
    float s[4];
    qk4(Kb + (size_t)(valid ? key : 0) * 64, qs, s);
    float p[4];
#pragma unroll
    for (int h = 0; h < 4; ++h) {
        const float sv = valid ? s[h] : -INFINITY;
        const float mn = fmaxf(mx[h], wave_max(sv));
        const float f = exp2f(mx[h] - mn);
        p[h] = exp2f(sv - mn);
        l[h] = l[h] * f + wave_sum(p[h]); o[h] *= f; mx[h] = mn;
    }
    LDS_WAIT();
    *(f32x4*)(ps + lane * 4) = (f32x4){p[0], p[1], p[2], p[3]};
    LDS_WAIT();
    const int k0 = key - lane;
    for (int kk = 0; kk < nk; ++kk) {
        const float v = (float)Vb[(size_t)(k0 + kk) * 64 + lane];
        const f32x4 pv = *(const f32x4*)(ps + kk * 4);
        o[0] += pv.x * v; o[1] += pv.y * v; o[2] += pv.z * v; o[3] += pv.w * v;
    }
}
__device__ __forceinline__ void attn_naive(const Params& P, unsigned char* lds, int lane, int wave, int gw, int ngw) {
    unsigned char* ws = P.ws;
    float* qs = (float*)lds + wave * (256 + 1024);
    float* ps = qs + 256;
    const h16* QN = (const h16*)(ws + WS_Q);
    const h16* KCC = (const h16*)(ws + WS_KCC); const h16* VCC = (const h16*)(ws + WS_VCC);
    const h16* KS = (const h16*)(ws + WS_KS); const h16* VS = (const h16*)(ws + WS_VS);
    const h16* KW = (const h16*)(ws + WS_KW); const h16* VW = (const h16*)(ws + WS_VW);
    const float* GATE = (const float*)(ws + WS_GATE);
    h16* Y = (h16*)(ws + WS_Y); float* SSA = (float*)(ws + WS_SSA);
    for (int item = gw; item < M * 2; item += ngw) {
        const int g = item & 1, m = item >> 1, b = m >> 12, t = m & 4095, bg = b * 2 + g;
        LDS_WAIT();
#pragma unroll
        for (int h = 0; h < 4; ++h) qs[h * 64 + lane] = (float)QN[(size_t)m * 512 + (4 * g + h) * 64 + lane];
        LDS_WAIT();
        const int nvalid = (t >= 31) ? ((t - 31) >> 4) + 1 : 0;
        float sc[4][4];
#pragma unroll
        for (int i = 0; i < 4; ++i) {
            const int c = lane + 64 * i;
            float s[4]; qk4(KCC + ((size_t)bg * 256 + c) * 64, qs, s);
#pragma unroll
            for (int h = 0; h < 4; ++h) sc[i][h] = (c < nvalid) ? s[h] : -INFINITY;
        }
#pragma unroll
        for (int h = 0; h < 4; ++h) {
            float mxv = fmaxf(fmaxf(sc[0][h], sc[1][h]), fmaxf(sc[2][h], sc[3][h]));
            mxv = wave_max(mxv);
            if (!(mxv > -INFINITY)) mxv = 0.f;
            float ls = 0.f;
#pragma unroll
            for (int i = 0; i < 4; ++i) { sc[i][h] = exp2f(sc[i][h] - mxv); ls += sc[i][h]; }
            ls = wave_sum(ls);
            const float inv = 1.0f / fmaxf(ls, 1e-30f);
#pragma unroll
            for (int i = 0; i < 4; ++i) sc[i][h] *= inv;
        }
#pragma unroll
        for (int i = 0; i < 4; ++i) *(f32x4*)(ps + (lane + 64 * i) * 4) = (f32x4){sc[i][0], sc[i][1], sc[i][2], sc[i][3]};
        LDS_WAIT();
        float ocmp[4] = {0.f, 0.f, 0.f, 0.f};
        for (int c = 0; c < nvalid; ++c) {
            const float v = (float)VCC[((size_t)bg * 256 + c) * 64 + lane];
            const f32x4 pv = *(const f32x4*)(ps + c * 4);
            ocmp[0] += pv.x * v; ocmp[1] += pv.y * v; ocmp[2] += pv.z * v; ocmp[3] += pv.w * v;
        }
        float imp = 0.f;
        {
#pragma unroll
            for (int e = 0; e < 4; ++e) { const f32x4 pv = *(const f32x4*)(ps + (4 * lane + e) * 4); const float sh = (pv.x + pv.y) + (pv.z + pv.w); imp += (e == 3) ? 0.5f * sh : sh; }
            if (lane >= 1) { const f32x4 pv = *(const f32x4*)(ps + (4 * lane - 1) * 4); imp += 0.5f * ((pv.x + pv.y) + (pv.z + pv.w)); }
        }
        const int cur = t >> 6;
        const bool forced = (lane == 0) || (lane == cur) || (lane == cur - 1);
        const bool cand = !forced && lane < cur - 1;
        const int quota = 16 - (1 + (cur >= 1 ? 1 : 0) + (cur >= 2 ? 1 : 0));
        int rank = 0;
        for (int j2 = 0; j2 < 64; ++j2) {
            const float io = __shfl(imp, j2); const int co = __shfl((int)cand, j2);
            if (co && (io > imp || (io == imp && j2 < lane))) ++rank;
        }
        const bool sel = forced || (cand && rank < quota);
        unsigned long long mask = __ballot(sel);
        float mx[4] = {-INFINITY, -INFINITY, -INFINITY, -INFINITY}, ls[4] = {0.f, 0.f, 0.f, 0.f}, os[4] = {0.f, 0.f, 0.f, 0.f};
        while (mask) {
            const int j = __builtin_ctzll(mask); mask &= mask - 1;
            const int key = 64 * j + lane; const int nk = min(64, t - 64 * j + 1);
            attn_group(KS + (size_t)bg * T * 64, VS + (size_t)bg * T * 64, key, key <= t, nk, qs, ps, mx, ls, os, lane);
        }
        float mw[4] = {-INFINITY, -INFINITY, -INFINITY, -INFINITY}, lw[4] = {0.f, 0.f, 0.f, 0.f}, ow[4] = {0.f, 0.f, 0.f, 0.f};
        for (int k0 = max(0, t - 511); k0 <= t; k0 += 64) {
            const int key = k0 + lane; const int nk = min(64, t - k0 + 1);
            attn_group(KW + (size_t)bg * T * 64, VW + (size_t)bg * T * 64, key, key <= t, nk, qs, ps, mw, lw, ow, lane);
        }
        float ssq = 0.f;
#pragma unroll
        for (int h = 0; h < 4; ++h) {
            const float* gp = GATE + (size_t)m * 24 + (4 * g + h) * 3;
            const float o = gp[0] * ocmp[h] + gp[1] * os[h] / ls[h] + gp[2] * ow[h] / lw[h];
            Y[(size_t)m * 1024 + 512 + (4 * g + h) * 64 + lane] = (h16)o;
            ssq += o * o;
        }
        ssq = wave_sum(ssq);
        if (lane == 0) SSA[m * 2 + g] = ssq;
    }
}


typedef float f32x16 __attribute__((ext_vector_type(16)));
typedef short s16x4 __attribute__((ext_vector_type(4)));
#define LAS3 __attribute__((address_space(3)))
constexpr int AT_KV = 0;
constexpr int AT_IMPH = 32768;
constexpr int AT_IMPS = AT_IMPH + 65536;
constexpr int AT_MASK = AT_IMPS + 16384;
constexpr int AT_WSF = AT_MASK + 512;
constexpr int AT_SSQ = AT_WSF + 2048;
constexpr int AT_STG = AT_SSQ + 1024;
constexpr int AT_END = AT_STG + 32768;
__device__ __forceinline__ int crow(int r, int hi) { return (r & 3) + 8 * (r >> 2) + 4 * hi; }
__device__ __forceinline__ float fexp2(float x) { return __builtin_amdgcn_exp2f(x); }

__device__ __forceinline__ void at_qkt(f32x16& p0, f32x16& p1, const LAS3 unsigned char* kb, const h16x8 (&qr)[4], int r32, int hi) {
    const LAS3 unsigned char* kp = kb + hi * 1024 + r32 * 16;
    p0 = (f32x16){0.f, 0.f, 0.f, 0.f, 0.f, 0.f, 0.f, 0.f, 0.f, 0.f, 0.f, 0.f, 0.f, 0.f, 0.f, 0.f}; p1 = p0;
#pragma unroll
    for (int d0 = 0; d0 < 4; ++d0) {
        const h16x8 b0 = *(const LAS3 h16x8*)(kp + d0 * 2048), b1 = *(const LAS3 h16x8*)(kp + d0 * 2048 + 512);
        p0 = __builtin_amdgcn_mfma_f32_32x32x16_f16(b0, qr[d0], p0, 0, 0, 0);
        p1 = __builtin_amdgcn_mfma_f32_32x32x16_f16(b1, qr[d0], p1, 0, 0, 0);
    }
}
__device__ __forceinline__ void at_mask(f32x16& p0, f32x16& p1, int lo, int hb, int hi) {
#pragma unroll
    for (int r = 0; r < 16; ++r) { const int kv = crow(r, hi);
        if (kv < lo || kv >= hb) p0[r] = -INFINITY;
        if (kv + 32 < lo || kv + 32 >= hb) p1[r] = -INFINITY; }
}
__device__ __forceinline__ float at_rowmax(const f32x16& p0, const f32x16& p1) {
    float a = fmaxf(p0[0], p1[0]);
#pragma unroll
    for (int r = 1; r < 16; ++r) a = fmaxf(a, fmaxf(p0[r], p1[r]));
    return fmaxf(a, __shfl_xor(a, 32));
}
__device__ __forceinline__ h16x8 at_pack(const f32x16& p, int b) {
    h16x8 o;
#pragma unroll
    for (int j = 0; j < 8; ++j) o[j] = (h16)p[b + j];
    return o;
}
__device__ __forceinline__ void at_pv(f32x16& o0, f32x16& o1, const LAS3 unsigned char* vb, const f32x16& p0, const f32x16& p1, int lane, int hi) {
    const LAS3 unsigned char* vp = vb + ((lane >> 4) & 1) * 32 + (lane & 3) * 8 + (4 * hi + ((lane & 15) >> 2)) * 64;
    const h16x8 pw0 = at_pack(p0, 0), pw1 = at_pack(p0, 8), pw2 = at_pack(p1, 0), pw3 = at_pack(p1, 8);
#pragma unroll
    for (int dh = 0; dh < 2; ++dh) {
        h16x8 vf[4];
#pragma unroll
        for (int kg = 0; kg < 4; ++kg) {
            const s16x4 lo4 = __builtin_amdgcn_ds_read_tr16_b64_v4i16((LAS3 s16x4*)(vp + dh * 4096 + kg * 1024));
            const s16x4 hi4 = __builtin_amdgcn_ds_read_tr16_b64_v4i16((LAS3 s16x4*)(vp + dh * 4096 + kg * 1024 + 512));
            typedef short s16x8 __attribute__((ext_vector_type(8)));
            const s16x8 w = (s16x8){lo4[0], lo4[1], lo4[2], lo4[3], hi4[0], hi4[1], hi4[2], hi4[3]};
            vf[kg] = __builtin_bit_cast(h16x8, w);
        }
        f32x16& o = dh ? o1 : o0;
        o = __builtin_amdgcn_mfma_f32_32x32x16_f16(pw0, vf[0], o, 0, 0, 0);
        o = __builtin_amdgcn_mfma_f32_32x32x16_f16(pw1, vf[1], o, 0, 0, 0);
        o = __builtin_amdgcn_mfma_f32_32x32x16_f16(pw2, vf[2], o, 0, 0, 0);
        o = __builtin_amdgcn_mfma_f32_32x32x16_f16(pw3, vf[3], o, 0, 0, 0);
    }
}
__device__ __forceinline__ void at_scale_rows(f32x16& o0, f32x16& o1, float f, LAS3 float* wsf, int r32, int hi) {
    LDS_WAIT();
    if (hi == 0) wsf[r32] = f;
    LDS_WAIT();
#pragma unroll
    for (int r = 0; r < 16; ++r) { const float fr = wsf[crow(r, hi)]; o0[r] *= fr; o1[r] *= fr; }
}
__device__ __forceinline__ void at_step(f32x16& p0, f32x16& p1, f32x16& o0, f32x16& o1, float& m, float& l, const LAS3 unsigned char* vb, LAS3 float* wsf, int lane, int r32, int hi) {
    const float rm = at_rowmax(p0, p1);
    const float mn = fmaxf(m, rm);
    if (__any(mn > m)) { const float f = fexp2(m - mn); l *= f; m = mn; at_scale_rows(o0, o1, f, wsf, r32, hi); }
    float s = 0.f;
#pragma unroll
    for (int r = 0; r < 16; ++r) { p0[r] = fexp2(p0[r] - m); p1[r] = fexp2(p1[r] - m); s += p0[r] + p1[r]; }
    l += s;
    at_pv(o0, o1, vb, p0, p1, lane, hi);
}

__device__ __forceinline__ void attn_unit(const Params& P, unsigned char* lds_g, int bg, int qb, int tid_in, int lane_in, int wave) {
    int lane = lane_in; asm volatile("" : "+v"(lane));
    const int tid = wave * 64 + lane; (void)tid_in;
    unsigned char* ws = P.ws;
    LAS3 unsigned char* lds = (LAS3 unsigned char*)lds_g;
    const int r32 = lane & 31, hi = lane >> 5, hl = wave >> 1, th = wave & 1;
    const int b = bg >> 1, g = bg & 1;
    const int tok = 32 * th + r32;
    const int t = 64 * qb + tok;
    const size_t m = (size_t)b * T + t;
    const h16* KCC = (const h16*)(ws + WS_KCC) + (size_t)bg * 256 * 64; const h16* VCC = (const h16*)(ws + WS_VCC) + (size_t)bg * 256 * 64;
    const h16* KS = (const h16*)(ws + WS_KS) + (size_t)bg * T * 64; const h16* VS = (const h16*)(ws + WS_VS) + (size_t)bg * T * 64;
    const h16* KW = (const h16*)(ws + WS_KW) + (size_t)bg * T * 64; const h16* VW = (const h16*)(ws + WS_VW) + (size_t)bg * T * 64;
    LAS3 float* wsf = (LAS3 float*)(lds + AT_WSF) + wave * 64;
    LAS3 float* IMPH = (LAS3 float*)(lds + AT_IMPH); LAS3 float* IMPS = (LAS3 float*)(lds + AT_IMPS);
    const int ntc = (4 * qb + 3 + 63) >> 6, nsl = qb + 1, nwn = min(qb + 1, 9), nt = 2 * ntc + nsl + nwn;
#define AT_KOFF (lane * 64 + wave * 8)
#define AT_VOFF ((16 * (wave & 3) + (lane >> 2)) * 64 + (wave >> 2) * 32 + (lane & 3) * 8)
#define AT_ISSUE(i) do { const int i_ = (i); const h16* ks_; const h16* vs_ = nullptr; int key0_; \
        if (i_ < ntc) { ks_ = KCC; key0_ = 64 * i_; } else if (i_ < 2 * ntc) { ks_ = KCC; vs_ = VCC; key0_ = 64 * (i_ - ntc); } \
        else if (i_ < 2 * ntc + nsl) { ks_ = KS; vs_ = VS; key0_ = 64 * (i_ - 2 * ntc); } else { ks_ = KW; vs_ = VW; key0_ = 64 * (qb - (i_ - 2 * ntc - nsl)); } \
        LAS3 unsigned char* dst_ = lds + AT_KV + (i_ & 1) * 16384 + wave * 1024; \
        __builtin_amdgcn_global_load_lds((const unsigned*)(ks_ + (size_t)key0_ * 64 + AT_KOFF), (LAS3 unsigned*)dst_, 16, 0, 0); \
        if (vs_) __builtin_amdgcn_global_load_lds((const unsigned*)(vs_ + (size_t)key0_ * 64 + AT_VOFF), (LAS3 unsigned*)(dst_ + 8192), 16, 0, 0); } while (0)
    AT_ISSUE(0);
    h16x8 qr[4];
    { const h16* qp = (const h16*)(ws + WS_Q) + m * 512 + (4 * g + hl) * 64 + hi * 8;
#pragma unroll
      for (int d0 = 0; d0 < 4; ++d0) qr[d0] = *(const h16x8*)(qp + d0 * 16); }
    float gt[3];
    { const float* gp = (const float*)(ws + WS_GATE) + m * 24 + (4 * g + hl) * 3; gt[0] = gp[0]; gt[1] = gp[1]; gt[2] = gp[2]; }
    const int nvalid = (t >= 31) ? ((t - 31) >> 4) + 1 : 0;
    f32x16 ot0, ot1, o0, o1;
#pragma unroll
    for (int r = 0; r < 16; ++r) { ot0[r] = 0.f; ot1[r] = 0.f; o0[r] = 0.f; o1[r] = 0.f; }
    float mx = -INFINITY, l = 0.f, cinv = 0.f, carry = 0.f;
    unsigned selw0 = 0u, selw1 = 0u;
    asm volatile("s_waitcnt vmcnt(0)" ::: "memory"); __syncthreads();
    const int lane_outer = lane, r32_outer = r32, hi_outer = hi, tok_outer = tok, tid_outer = tid;
    for (int i = 0; i < nt; ++i) {
        int lane = lane_outer; asm volatile("" : "+v"(lane));
        const int r32 = lane & 31, hi = lane >> 5, tok = 32 * th + r32, tid = wave * 64 + lane;
        if (i + 1 < nt) AT_ISSUE(i + 1);
        const LAS3 unsigned char* kb = lds + AT_KV + (i & 1) * 16384; const LAS3 unsigned char* vb = kb + 8192;
        f32x16 p0, p1;
        at_qkt(p0, p1, kb, qr, r32, hi);
        if (i < ntc) {
            at_mask(p0, p1, 0, nvalid - 64 * i, hi);
            const float rm = at_rowmax(p0, p1);
            const float mn = fmaxf(mx, rm), ms = (mn == -INFINITY) ? 0.f : mn;
            float s = 0.f;
#pragma unroll
            for (int r = 0; r < 16; ++r) s += fexp2(p0[r] - ms) + fexp2(p1[r] - ms);
            l = l * fexp2(mx - ms) + s; mx = mn;
            if (i == ntc - 1) { const float lt = l + __shfl_xor(l, 32); cinv = 1.0f / fmaxf(lt, 1e-30f); if (mx == -INFINITY) mx = 0.f; }
        } else if (i < 2 * ntc) {
            const int tl = i - ntc;
            at_mask(p0, p1, 0, nvalid - 64 * tl, hi);
#pragma unroll
            for (int r = 0; r < 16; ++r) { p0[r] = fexp2(p0[r] - mx) * cinv; p1[r] = fexp2(p1[r] - mx) * cinv; }
#pragma unroll
            for (int gq = 0; gq < 2; ++gq) {
                const f32x16& p = gq ? p1 : p0;
                float tot[4], x[4];
#pragma unroll
                for (int R = 0; R < 4; ++R) { const float sp = 0.5f * p[4 * R + 3]; tot[R] = (p[4 * R] + p[4 * R + 1]) + (p[4 * R + 2] + sp); x[R] = __shfl_xor(sp, 32); }
                if (hi) {
#pragma unroll
                    for (int R = 0; R < 4; ++R) tot[R] += x[R];
                } else { tot[0] += carry; tot[1] += x[0]; tot[2] += x[1]; tot[3] += x[2]; carry = x[3]; }
#pragma unroll
                for (int R = 0; R < 4; ++R) IMPH[(hl * 64 + 16 * tl + 8 * gq + 2 * R + hi) * 64 + tok] = tot[R];
            }
            at_pv(o0, o1, vb, p0, p1, lane, hi);
            if (i == 2 * ntc - 1) {
                at_scale_rows(o0, o1, gt[0], wsf, r32, hi);
#pragma unroll
                for (int r = 0; r < 16; ++r) { ot0[r] += o0[r]; ot1[r] += o1[r]; o0[r] = 0.f; o1[r] = 0.f; }
                mx = -INFINITY; l = 0.f;
                LDS_WAIT(); __syncthreads();
                { const int tk = tid & 63, part = tid >> 6;
                  float own[8];
#pragma unroll
                  for (int e = 0; e < 8; ++e) { const int j = 8 * part + e; float v = 0.f;
                      if (j < 16 * ntc) v = (IMPH[(0 * 64 + j) * 64 + tk] + IMPH[(1 * 64 + j) * 64 + tk]) + (IMPH[(2 * 64 + j) * 64 + tk] + IMPH[(3 * 64 + j) * 64 + tk]);
                      own[e] = v; IMPS[j * 64 + tk] = v; }
                  LDS_WAIT(); __syncthreads();
                  int rank[8];
#pragma unroll
                  for (int e = 0; e < 8; ++e) rank[e] = 0;
                  for (int j2 = 1; j2 <= qb - 2; ++j2) { const float v2 = IMPS[j2 * 64 + tk];
#pragma unroll
                      for (int e = 0; e < 8; ++e) { const int j = 8 * part + e; rank[e] += (v2 > own[e] || (v2 == own[e] && j2 < j)) ? 1 : 0; } }
                  const int quota = 16 - (1 + (qb >= 1 ? 1 : 0) + (qb >= 2 ? 1 : 0));
                  unsigned bits = 0u;
#pragma unroll
                  for (int e = 0; e < 8; ++e) { const int j = 8 * part + e; const bool forced = (j == 0) || (j == qb) || (j == qb - 1); const bool cand = !forced && j >= 1 && j <= qb - 2;
                      if (forced || (cand && rank[e] < quota)) bits |= 1u << e; }
                  ((LAS3 unsigned char*)(lds + AT_MASK))[tk * 8 + part] = (unsigned char)bits;
                  LDS_WAIT(); __syncthreads();
                  const LAS3 unsigned* mp = (const LAS3 unsigned*)(lds + AT_MASK) + tok * 2; selw0 = mp[0]; selw1 = mp[1]; }
            }
        } else if (i < 2 * ntc + nsl) {
            const int j = i - 2 * ntc;
            const bool sel = ((j < 32 ? (selw0 >> j) : (selw1 >> (j - 32))) & 1u) != 0u;
            const int hb = sel ? ((j == qb) ? tok + 1 : 64) : 0;
            at_mask(p0, p1, 0, hb, hi);
            at_step(p0, p1, o0, o1, mx, l, vb, wsf, lane, r32, hi);
            if (j == qb) {
                const float lt = l + __shfl_xor(l, 32);
                at_scale_rows(o0, o1, gt[1] / lt, wsf, r32, hi);
#pragma unroll
                for (int r = 0; r < 16; ++r) { ot0[r] += o0[r]; ot1[r] += o1[r]; o0[r] = 0.f; o1[r] = 0.f; }
                mx = -INFINITY; l = 0.f;
            }
        } else {
            const int jj = i - 2 * ntc - nsl;
            const int lo = (jj == 8) ? tok + 1 : 0, hb = (jj == 0) ? tok + 1 : 64;
            if (jj == 0 || jj == 8) at_mask(p0, p1, lo, hb, hi);
            at_step(p0, p1, o0, o1, mx, l, vb, wsf, lane, r32, hi);
            if (i == nt - 1) {
                const float lt = l + __shfl_xor(l, 32);
                at_scale_rows(o0, o1, gt[2] / lt, wsf, r32, hi);
#pragma unroll
                for (int r = 0; r < 16; ++r) { ot0[r] += o0[r]; ot1[r] += o1[r]; }
            }
        }
        asm volatile("s_waitcnt vmcnt(0)" ::: "memory"); __syncthreads();
    }
#undef AT_ISSUE
#undef AT_KOFF
#undef AT_VOFF
    (void)r32_outer; (void)hi_outer; (void)tok_outer; (void)tid_outer;
    LAS3 h16* stg = (LAS3 h16*)(lds + AT_STG) + wave * 2048;
#pragma unroll
    for (int r = 0; r < 16; ++r) { const int orow = crow(r, hi); stg[orow * 64 + r32] = (h16)ot0[r]; stg[orow * 64 + 32 + r32] = (h16)ot1[r]; }
    LDS_WAIT();
    LAS3 float* SSQ = (LAS3 float*)(lds + AT_SSQ);
    h16* Yb = (h16*)(ws + WS_Y) + ((size_t)b * T + 64 * qb + 32 * th) * 1024 + 512 + (4 * g + hl) * 64;
#pragma unroll
    for (int i2 = 0; i2 < 4; ++i2) { const int row = i2 * 8 + (lane >> 3), ch = lane & 7;
        const h16x8 v = *(const LAS3 h16x8*)(stg + row * 64 + ch * 8);
        *(h16x8*)(Yb + (size_t)row * 1024 + ch * 8) = v;
        float ss = 0.f;
#pragma unroll
        for (int e = 0; e < 8; ++e) { const float f = (float)v[e]; ss += f * f; }
        ss += __shfl_xor(ss, 1); ss += __shfl_xor(ss, 2); ss += __shfl_xor(ss, 4);
        if (ch == 0) SSQ[hl * 64 + 32 * th + row] = ss; }
    LDS_WAIT(); __syncthreads();
    if (tid < 64) ((float*)(ws + WS_SSA))[((size_t)b * T + 64 * qb + tid) * 2 + g] = (SSQ[tid] + SSQ[64 + tid]) + (SSQ[128 + tid] + SSQ[192 + tid]);
    __syncthreads();
}
__device__ __forceinline__ void attn_mfma_phase(const Params& P, unsigned char* lds, int tid, int lane, int wave, int bid, int nb) {
    const bool deal = (nb == 256);
    const int v = (bid & 7) * 32 + (bid >> 3);
    const int nu = deal ? 4 : (1024 - bid + nb - 1) / nb;
    for (int k = 0; k < nu; ++k) {
        int bg, qb;
        if (deal) { const int s = v & 15; bg = v >> 4; qb = (k == 0) ? 63 - s : (k == 1) ? 32 + s : (k == 2) ? 31 - s : s; }
        else { const int u = bid + k * nb; bg = u >> 6; qb = 63 - (u & 63); }
        attn_unit(P, lds, bg, qb, tid, lane, wave);
    }
}


#define XLAS __attribute__((address_space(3)))
#define XB_TMO      128
#define XB_XCNT(j)  (256  + 64 * (j))
#define XB_XSUB(j)  (1280 + 64 * (j))
#define XB_XGEN(j)  (2304 + 64 * (j))
#define XB_TOP      3328
#define XB_TOPGEN   3392
#define XCD_BAR_WORDS 3456
#define XB_SPIN_CAP (1u << 18)

__device__ __forceinline__ unsigned xb_ld(unsigned* p)              { return __hip_atomic_load(p, __ATOMIC_RELAXED, __HIP_MEMORY_SCOPE_AGENT); }
__device__ __forceinline__ unsigned xb_add(unsigned* p, unsigned v) { return __hip_atomic_fetch_add(p, v, __ATOMIC_RELAXED, __HIP_MEMORY_SCOPE_AGENT); }
__device__ __forceinline__ unsigned xb_xcc_id() { return (unsigned)__builtin_amdgcn_s_getreg((3 << 11) | 20) & 0xFu; }
#define XB_SPIN(cond, bar) do { unsigned _sp = 0; while (cond) { __builtin_amdgcn_s_sleep(1); \
    if ((++_sp & 255u) == 0u) { if (xb_ld(&(bar)[XB_TMO])) break; if (_sp > XB_SPIN_CAP) { atomicAdd(&(bar)[XB_TMO], 1u); break; } } } } while (0)

struct XcdBarrier {
    unsigned* bar; unsigned x;
    volatile XLAS unsigned* st;
};

__device__ __forceinline__ XcdBarrier xcd_barrier_post(unsigned* bar, volatile XLAS unsigned* st) {
    XcdBarrier b; b.bar = bar; b.x = xb_xcc_id(); b.st = st;
    if (threadIdx.x == 0) (void)xb_add(&bar[XB_XCNT(b.x)], 1u);
    return b;
}
__device__ __forceinline__ void xcd_barrier_complete(unsigned* bar, unsigned x, unsigned& nloc, unsigned& nx) {
    const unsigned G = gridDim.x * gridDim.y * gridDim.z;
    unsigned sum, cnt, mine, sp = 0u;
    for (;;) {
        sum = 0u; cnt = 0u; mine = 0u;
#pragma unroll
        for (unsigned j = 0; j < 16; ++j) { const unsigned c = xb_ld(&bar[XB_XCNT(j)]); sum += c; cnt += (c > 0u) ? 1u : 0u; mine = (j == x) ? c : mine; }
        if (sum == G) break;
        __builtin_amdgcn_s_sleep(1);
        if ((++sp & 255u) == 0u) { if (xb_ld(&bar[XB_TMO])) break; if (sp > XB_SPIN_CAP) { atomicAdd(&bar[XB_TMO], 1u); break; } }
    }
    nloc = mine > 0u ? mine : 1u; nx = cnt > 0u ? cnt : 1u;
}

__device__ __forceinline__ void xcd_barrier(const XcdBarrier& b) {
    asm volatile("s_waitcnt vmcnt(0)" ::: "memory");
    __syncthreads();
    if (threadIdx.x == 0) {
        unsigned* bar = b.bar;
        __builtin_amdgcn_s_waitcnt(0);
        unsigned nloc = b.st[0], nx = b.st[1];
        if (nloc == 0u) { xcd_barrier_complete(bar, b.x, nloc, nx); b.st[0] = nloc; b.st[1] = nx; }
        const unsigned old = xb_add(&bar[XB_XSUB(b.x)], 1u);
        const unsigned gen = old / nloc;
        if (old + 1u == (gen + 1u) * nloc) {
            __builtin_amdgcn_fence(__ATOMIC_RELEASE, "agent");
            asm volatile("s_waitcnt vmcnt(0)" ::: "memory");
            const unsigned og = xb_add(&bar[XB_TOP], 1u);
            const unsigned tg = og / nx;
            if (og + 1u == (tg + 1u) * nx) xb_add(&bar[XB_TOPGEN], 1u);
            else XB_SPIN(xb_ld(&bar[XB_TOPGEN]) == tg, bar);
            __builtin_amdgcn_fence(__ATOMIC_ACQUIRE, "agent");
            xb_add(&bar[XB_XGEN(b.x)], 1u);
            asm volatile("s_waitcnt vmcnt(0)" ::: "memory");
        } else {
            XB_SPIN(xb_ld(&bar[XB_XGEN(b.x)]) == gen, bar);
            __builtin_amdgcn_fence(__ATOMIC_ACQUIRE, "agent");
            asm volatile("s_waitcnt vmcnt(0)" ::: "memory");
        }
    }
    __syncthreads();
}

#ifndef PHMASK
#define PHMASK 0x1ff
#endif
constexpr int NPHASE = 9;
#ifndef FAST_GEMM
#define FAST_GEMM 7
#endif
#ifndef FAST_ATTN
#define FAST_ATTN 1
#endif
#ifndef DUPMASK
#define DUPMASK 0
#endif
#define REP(bit) for (int rep_ = 0; rep_ < ((DUPMASK >> (bit)) & 1) + 1; ++rep_)
constexpr int LDS_BYTES = 155648, LDS_MISC = LDS_BYTES - 64;
static_assert(AT_END <= LDS_MISC && pg8::STAGE_BYTES <= LDS_BYTES, "LDS map");
__global__ void __launch_bounds__(NTHREADS, 2) hymba_fwd(Params P) {
    extern __shared__ __attribute__((aligned(16))) unsigned char lds[];
    cg::grid_group grid = cg::this_grid();
    const int tid = threadIdx.x, lane = tid & 63, wave = __builtin_amdgcn_readfirstlane(tid >> 6);
    const int bid = blockIdx.x, nb = gridDim.x;
    const int gw = bid * NWAVES + wave, ngw = nb * NWAVES;
    unsigned char* ws = P.ws;
    const int lo = P.ph_lo, hi = P.ph_hi;
    volatile XLAS unsigned* misc = (volatile XLAS unsigned*)((XLAS unsigned char*)lds + LDS_MISC);
    if (tid < 16) misc[tid] = 0u;
    __syncthreads();
    XcdBarrier bar = xcd_barrier_post((unsigned*)(ws + WS_CTL), misc);
    if (hi < 0) grid.sync();
#define PH_BEGIN(k) if (lo <= (k) && (k) < hi) { if ((k) > lo) xcd_barrier(bar);
#define PH_END }
#if PHMASK & (1 << 0)
        PH_BEGIN(0) REP(0) phase0(P, lds, tid, lane, wave, bid, nb); PH_END
#endif
#if PHMASK & (1 << 1)
        PH_BEGIN(1) {
#if FAST_GEMM & 1
            REP(1) {
            pg8::Gemm g{(const pg8::bf16_t*)(ws + WS_XH), (const pg8::bf16_t*)(ws + WS_WIN), M, NP1, 1024}; pg8::StaticOrder S; S.init(M, NP1, nb, bid);
            pg8::gemm_phase<EpiProjF, pg8::StaticOrder, true, true>((PG8_LAS unsigned char*)lds, g, S, EpiProjF{ws});
            }
#else
            GemmN g{(const h16*)(ws + WS_XH), 1024, (const h16*)(ws + WS_WIN), 1024, 1024, nullptr, 0, nullptr, 0, 0, M, NP1, 0};
            gemm_naive<false>(g, EpiProj{ws}, gw, ngw, lane);
#endif
        } PH_END
#endif
#if PHMASK & (1 << 2)
        PH_BEGIN(2) {
            normrope_rows(P, gw, ngw, lane);
            REP(2) rglru_local(P, lds, tid, lane, wave, bid, nb);
            REP(3) for (int w = 0; w < 2; ++w) {
                GemmN g{(const h16*)(ws + (w ? WS_VCT : WS_KCT)), 1024, (const h16*)(ws + (w ? WS_W1V : WS_W1K)), CMPK, CMPK, nullptr, 0, nullptr, 0, 0, 4096, CMPH, 0};
                gemm_naive<false>(g, EpiCmpA{(h16*)(ws + WS_H1) + (size_t)w * 4096 * CMPH, (const float*)(ws + WS_B1) + w * 256}, gw, ngw, lane);
            }
        } PH_END
#endif
#if PHMASK & (1 << 3)
        PH_BEGIN(3) {
            for (int w = 0; w < 2; ++w) {
                GemmN g{(const h16*)(ws + WS_H1) + (size_t)w * 4096 * CMPH, CMPH, (const h16*)(ws + (w ? WS_W2V : WS_W2K)), CMPH, CMPH, nullptr, 0, nullptr, 0, 0, 4096, HD, 0};
                gemm_naive<false>(g, EpiCmpB{(float*)(ws + WS_CRAW) + (size_t)w * 4096 * HD}, gw, ngw, lane);
            }
        } PH_END
#endif
#if PHMASK & (1 << 4)
        PH_BEGIN(4) compress_finish(P, gw, ngw, lane); PH_END
#endif
#if PHMASK & (1 << 5)
        PH_BEGIN(5) {
            REP(5) rglru_fixup(P, gw, ngw, lane);
#if FAST_ATTN
            REP(6) attn_mfma_phase(P, lds, tid, lane, wave, bid, nb);
#else
            attn_naive(P, lds, lane, wave, gw, ngw);
#endif
        } PH_END
#endif
#if PHMASK & (1 << 6)
        PH_BEGIN(6) {
#if FAST_GEMM & 2
            REP(7) {
            pg8::Gemm g{(const pg8::bf16_t*)(ws + WS_Y), (const pg8::bf16_t*)(ws + WS_WOUT), M, D, 1024}; pg8::StaticOrder S; S.init(M, D, nb, bid);
            pg8::gemm_phase<EpiOutF, pg8::StaticOrder, true, true>((PG8_LAS unsigned char*)lds, g, S,
                EpiOutF{P.x, P.out, (h16*)(ws + WS_X1H), (const float*)(ws + WS_SSR), (const float*)(ws + WS_SSA), (float*)(ws + WS_SS2P)});
            }
#else
            const h16* Y = (const h16*)(ws + WS_Y); const h16* W = (const h16*)(ws + WS_WOUT);
            GemmN g{Y, 1024, W, 1024, 512, Y + 512, 1024, W + 512, 1024, 512, M, D, 0};
            gemm_naive<true>(g, EpiOut{P.x, P.out, (h16*)(ws + WS_X1H), (const float*)(ws + WS_SSR), (const float*)(ws + WS_SSA)}, gw, ngw, lane);
#endif
        } PH_END
#endif
#if PHMASK & (1 << 7)
        PH_BEGIN(7) {
#if FAST_GEMM & 2
            REP(8) {
            pg8::Gemm g{(const pg8::bf16_t*)(ws + WS_X1H), (const pg8::bf16_t*)(ws + WS_WGU), M, 2 * DFF, 1024}; pg8::StaticOrder S; S.init(M, 2 * DFF, nb, bid);
            pg8::gemm_phase<EpiGUF, pg8::StaticOrder, true, true>((PG8_LAS unsigned char*)lds, g, S, EpiGUF{(h16*)(ws + WS_HM), (const float*)(ws + WS_SS2P)});
            }
#else
            const h16* A = (const h16*)(ws + WS_X1H); const h16* W = (const h16*)(ws + WS_WGU);
            GemmN g{A, 1024, W, 1024, 1024, A, 1024, W, 1024, 1024, M, DFF, 1};
            gemm_naive<true>(g, EpiGU{(h16*)(ws + WS_HM), (const float*)(ws + WS_RSTD2)}, gw, ngw, lane);
#endif
        } PH_END
#endif
#if PHMASK & (1 << 8)
        PH_BEGIN(8) {
#if FAST_GEMM & 4
            pg8::Gemm g{(const pg8::bf16_t*)(ws + WS_HM), (const pg8::bf16_t*)(ws + WS_WD), M, D, DFF}; pg8::StaticOrder S; S.init(M, D, nb, bid);
            pg8::gemm_phase<EpiDownF, pg8::StaticOrder, true, true>((PG8_LAS unsigned char*)lds, g, S, EpiDownF{P.out});
#else
            GemmN g{(const h16*)(ws + WS_HM), DFF, (const h16*)(ws + WS_WD), DFF, DFF, nullptr, 0, nullptr, 0, 0, M, D, 0};
            gemm_naive<false>(g, EpiDown{P.out}, gw, ngw, lane);
#endif
        } PH_END
#endif
}

#ifndef N_LAUNCH_PER_PHASE
#define N_LAUNCH_PER_PHASE 0
#endif
extern "C" void kernel_launch(void* const* d_in, const int* in_sizes, int n_in, void* d_out, int out_size, void* d_ws, size_t ws_size, hipStream_t stream) {
    static int grid = 0;
    if (grid == 0) {
        if (n_in != 25 || in_sizes[0] != M * D || out_size != M * D || ws_size < WS_END) {
            fprintf(stderr, "kernel_launch: unexpected problem (n_in %d, in0 %d, out %d, ws %zu)\n", n_in, n_in > 0 ? in_sizes[0] : -1, out_size, ws_size); grid = -1; return; }
        int dev = 0, cus = 0, per_cu = 0;
        hipGetDevice(&dev);
        hipDeviceGetAttribute(&cus, hipDeviceAttributeMultiprocessorCount, dev);
        hipFuncSetAttribute((const void*)hymba_fwd, hipFuncAttributeMaxDynamicSharedMemorySize, LDS_BYTES);
        hipOccupancyMaxActiveBlocksPerMultiprocessor(&per_cu, (const void*)hymba_fwd, NTHREADS, LDS_BYTES);
        if (per_cu < 1) { fprintf(stderr, "kernel_launch: occupancy query says %d blocks per CU\n", per_cu); grid = -1; return; }
        grid = cus;
    }
    if (grid < 0) return;
    if (hipMemsetAsync((char*)d_ws + WS_CTL, 0, CTL_BYTES, stream) != hipSuccess) { fprintf(stderr, "kernel_launch: memset failed\n"); return; }
    Params p{};
    const float** pf = (const float**)&p;
    for (int i = 0; i < 25; ++i) pf[i] = (const float*)d_in[i];
    p.out = (float*)d_out; p.ws = (unsigned char*)d_ws;
#if N_LAUNCH_PER_PHASE
    for (int ph = 0; ph < NPHASE; ++ph) {
        p.ph_lo = ph; p.ph_hi = ph + 1;
        void* args[] = {&p};
        hipError_t e = hipLaunchCooperativeKernel((const void*)hymba_fwd, dim3(grid), dim3(NTHREADS), args, LDS_BYTES, stream);
        if (e != hipSuccess) { fprintf(stderr, "launch failed: %s\n", hipGetErrorString(e)); return; }
    }
#else
    p.ph_lo = 0; p.ph_hi = NPHASE;
    void* args[] = {&p};
    hipError_t e = hipLaunchCooperativeKernel((const void*)hymba_fwd, dim3(grid), dim3(NTHREADS), args, LDS_BYTES, stream);
    if (e != hipSuccess) fprintf(stderr, "launch failed: %s\n", hipGetErrorString(e));
#endif
}
```

```cpp
#include <hip/hip_runtime.h>
#include <hip/hip_cooperative_groups.h>
#include <cstdio>
#include <cstdint>
namespace cg = cooperative_groups;

typedef _Float16 h16;
typedef _Float16 h16x8 __attribute__((ext_vector_type(8)));
typedef _Float16 h16x4 __attribute__((ext_vector_type(4)));
typedef _Float16 h16x2 __attribute__((ext_vector_type(2)));
typedef float f32x4 __attribute__((ext_vector_type(4)));
typedef float f32x2 __attribute__((ext_vector_type(2)));
typedef unsigned u32x4 __attribute__((ext_vector_type(4)));
typedef unsigned u32x2 __attribute__((ext_vector_type(2)));

constexpr int BATCH = 8, T = 4096, M = BATCH * T, D = 1024;
constexpr int DRNN = 512, NBLK = 8, DATT = 512, NH = 8, NKV = 2, HPG = 4, HD = 64;
constexpr int DIN = 2328, NP1 = 2560;
constexpr int DFF = 2816;
constexpr int NCMP = 255, NCP = 256;
constexpr int CMPK = 2048, CMPH = 256;
constexpr float EPS = 1e-6f;
constexpr float C2 = 0.125f * 1.4426950408889634f;
constexpr int NTHREADS = 512, NWAVES = 8;

constexpr size_t MiB = 1u << 20;
constexpr size_t WS_WIN = 0;
constexpr size_t WS_WOUT = 6 * MiB;
constexpr size_t WS_WGU = 8 * MiB;
constexpr size_t WS_WD = 20 * MiB;
constexpr size_t WS_W1K = 26 * MiB, WS_W1V = 27 * MiB;
constexpr size_t WS_W2K = 28 * MiB, WS_W2V = 28 * MiB + 65536;
constexpr size_t WS_B1 = 28 * MiB + 131072;
constexpr size_t WS_RSTD1 = 29 * MiB;
constexpr size_t WS_RSTD2 = 29 * MiB + 262144;
constexpr size_t WS_SS2P = 456 * MiB;
constexpr size_t WS_ROPE = 30 * MiB;
constexpr size_t WS_XH = 32 * MiB;
constexpr size_t WS_XR = 96 * MiB;
constexpr size_t WS_GRG = 128 * MiB;
constexpr size_t WS_Q = 160 * MiB;
constexpr size_t WS_HL = 192 * MiB;
constexpr size_t WS_HM = 32 * MiB;
constexpr size_t WS_AC = 224 * MiB;
constexpr size_t WS_KCT = 256 * MiB;
constexpr size_t WS_VCT = 265 * MiB;
constexpr size_t WS_KS = 274 * MiB, WS_VS = 282 * MiB, WS_KW = 290 * MiB, WS_VW = 298 * MiB;
constexpr size_t WS_GATE = 306 * MiB;
constexpr size_t WS_H1 = 310 * MiB;
constexpr size_t WS_CRAW = 314 * MiB;
constexpr size_t WS_KCC = 316 * MiB, WS_VCC = 317 * MiB;
constexpr size_t WS_AGG = 318 * MiB;
constexpr size_t WS_SSR = 326 * MiB, WS_SSA = 327 * MiB;
constexpr size_t WS_Y = 328 * MiB;
constexpr size_t WS_X1H = 392 * MiB;
constexpr size_t WS_CTL = 458 * MiB;
constexpr size_t CTL_BYTES = 16384;
constexpr size_t WS_END = 459 * MiB;

#define LDS_WAIT() asm volatile("s_waitcnt lgkmcnt(0)" ::: "memory")
#define LAS3 __attribute__((address_space(3)))
__device__ __forceinline__ float wave_sum(float v) {
#pragma unroll
    for (int o = 1; o < 64; o <<= 1) v += __shfl_xor(v, o);
    return v;
}
__device__ __forceinline__ float wave_max(float v) {
#pragma unroll
    for (int o = 1; o < 64; o <<= 1) v = fmaxf(v, __shfl_xor(v, o));
    return v;
}
__device__ __forceinline__ float gelu_tanh(float x) {
    const float u = 0.7978845608028654f * (x + 0.044715f * x * x * x);
    return 0.5f * x * (1.0f + tanhf(u));
}
__device__ __forceinline__ float sigmoidf_(float x) { return 1.0f / (1.0f + __expf(-x)); }

struct Params {
    const float* x; const int* pos; const float* attn_norm_w; const float* w_in; const float* conv_w; const float* conv_b;
    const float* gate_a_w; const float* gate_a_b; const float* gate_x_w; const float* gate_x_b; const float* lru_lambda;
    const float* q_norm_w; const float* k_norm_w; const float* cmp_pos; const float* cmp_k_w1; const float* cmp_k_w2;
    const float* cmp_v_w1; const float* cmp_v_w2; const float* rnn_out_norm_w; const float* attn_out_norm_w; const float* w_out;
    const float* ffn_norm_w; const float* w_gate; const float* w_up; const float* w_down;
    float* out; unsigned char* ws; int ph_lo, ph_hi;
};

__device__ __forceinline__ void p0_transpose_item(const float* W, int K, int N, const float* s0, const float* s1, int ksplit,
                                                  h16* WT, int ldt, int mode, int nblk, float* scr, int item, int lane) {
    const int kb = item / nblk, nb = item % nblk, k0 = 64 * kb, n0 = 32 * nb;
#pragma unroll 8
    for (int i = 0; i < 32; ++i) {
        const int kk = 2 * i + (lane >> 5), n = n0 + (lane & 31), k = k0 + kk;
        float v = 0.f;
        if (n < N) { v = W[(size_t)k * N + n]; if (s0) v *= (k < ksplit) ? s0[k] : s1[k - ksplit]; }
        scr[kk * 33 + (lane & 31)] = v;
    }
    LDS_WAIT();
    const int c = lane & 7;
#pragma unroll
    for (int j = 0; j < 4; ++j) {
        const int nl = (lane >> 3) + 8 * j, n = n0 + nl;
        const float* s = scr + (8 * c) * 33 + nl;
        h16x8 o;
#pragma unroll
        for (int e = 0; e < 8; ++e) o[e] = (h16)s[e * 33];
        int orow = n;
        if (mode == 1) orow = (n >> 7) * 256 + (n & 127);
        else if (mode == 2) orow = (n >> 7) * 256 + (n & 127) + 128;
        *(h16x8*)(WT + (size_t)orow * ldt + k0 + 8 * c) = o;
    }
    LDS_WAIT();
}

__device__ __forceinline__ void phase0(const Params& P, unsigned char* lds, int tid, int lane, int wave, int bid, int nb) {
    unsigned char* ws = P.ws;
    float* scr = (float*)lds + wave * (64 * 33);
    const int gw = bid * NWAVES + wave, ngw = nb * NWAVES;
    constexpr int I_IN = 16 * 80, I_OUT = 16 * 32, I_G = 16 * 88, I_U = 16 * 88, I_D = 44 * 32, I_C1 = 32 * 8, I_C2 = 4 * 2;
    constexpr int NIT = I_IN + I_OUT + I_G + I_U + I_D + 2 * I_C1 + 2 * I_C2;
    for (int it = gw; it < NIT; it += ngw) {
        int r = it;
        const float* W; int K, N; const float* s0 = nullptr; const float* s1 = nullptr; int ksplit = 0; size_t wo; int ldt, mode = 0, nblk;
        if (r < I_IN) { W = P.w_in; K = 1024; N = DIN; s0 = P.attn_norm_w; s1 = P.attn_norm_w; ksplit = 1024; wo = WS_WIN; ldt = 1024; nblk = 80; }
        else if ((r -= I_IN) < I_OUT) { W = P.w_out; K = 1024; N = 1024; s0 = P.rnn_out_norm_w; s1 = P.attn_out_norm_w; ksplit = 512; wo = WS_WOUT; ldt = 1024; nblk = 32; }
        else if ((r -= I_OUT) < I_G) { W = P.w_gate; K = 1024; N = DFF; s0 = P.ffn_norm_w; s1 = P.ffn_norm_w; ksplit = 1024; wo = WS_WGU; ldt = 1024; mode = 1; nblk = 88; }
        else if ((r -= I_G) < I_U) { W = P.w_up; K = 1024; N = DFF; s0 = P.ffn_norm_w; s1 = P.ffn_norm_w; ksplit = 1024; wo = WS_WGU; ldt = 1024; mode = 2; nblk = 88; }
        else if ((r -= I_U) < I_D) { W = P.w_down; K = DFF; N = 1024; wo = WS_WD; ldt = DFF; nblk = 32; }
        else if ((r -= I_D) < I_C1) { W = P.cmp_k_w1; K = CMPK; N = CMPH; wo = WS_W1K; ldt = CMPK; nblk = 8; }
        else if ((r -= I_C1) < I_C1) { W = P.cmp_v_w1; K = CMPK; N = CMPH; wo = WS_W1V; ldt = CMPK; nblk = 8; }
        else if ((r -= I_C1) < I_C2) { W = P.cmp_k_w2; K = CMPH; N = HD; wo = WS_W2K; ldt = CMPH; nblk = 2; }
        else { r -= I_C2; W = P.cmp_v_w2; K = CMPH; N = HD; wo = WS_W2V; ldt = CMPH; nblk = 2; }
        p0_transpose_item(W, K, N, s0, s1, ksplit, (h16*)(ws + wo), ldt, mode, nblk, scr, r, lane);
    }
    h16* XH = (h16*)(ws + WS_XH); float* RSTD1 = (float*)(ws + WS_RSTD1);
    for (int m = gw; m < M; m += ngw) {
        const f32x4* xr = (const f32x4*)(P.x + (size_t)m * D) + lane;
        f32x4 v[4]; float s = 0.f;
#pragma unroll
        for (int j = 0; j < 4; ++j) { v[j] = xr[64 * j]; s += (v[j].x * v[j].x + v[j].y * v[j].y) + (v[j].z * v[j].z + v[j].w * v[j].w); }
        s = wave_sum(s);
        if (lane == 0) RSTD1[m] = 1.0f / sqrtf(s * (1.0f / D) + EPS);
        h16x4* o = (h16x4*)(XH + (size_t)m * D) + lane;
#pragma unroll
        for (int j = 0; j < 4; ++j) { h16x4 h; h.x = (h16)v[j].x; h.y = (h16)v[j].y; h.z = (h16)v[j].z; h.w = (h16)v[j].w; o[64 * j] = h; }
    }
    float* ROPE = (float*)(ws + WS_ROPE);
    for (int e = bid * NTHREADS + tid; e < M * 8; e += nb * NTHREADS) {
        const int m = e >> 3, i = e & 7;
        const float inv = (float)pow(500000.0, -(double)i / 8.0);
        const float ang = (float)P.pos[m] * inv;
        ROPE[m * 16 + i] = (float)cos((double)ang);
        ROPE[m * 16 + 8 + i] = (float)sin((double)ang);
    }
    if (bid < 64) {
        const int which = bid >> 5, n = (bid & 31) * 8 + (tid & 7), ks = tid >> 3;
        const float* w1 = (which ? P.cmp_v_w1 : P.cmp_k_w1) + n; const float* cp = P.cmp_pos + ks * 32;
        float s = 0.f;
#pragma unroll
        for (int k = 0; k < 32; ++k) s += cp[k] * w1[(size_t)(ks * 32 + k) * CMPH];
        float* red = (float*)lds + NWAVES * 64 * 33;
        red[tid] = s;
        __syncthreads();
        if (tid < 8) { float a = 0.f; for (int q = 0; q < 64; ++q) a += red[q * 8 + tid]; ((float*)(ws + WS_B1))[which * 256 + (bid & 31) * 8 + tid] = a; }
        __syncthreads();
    }
    if (bid == 64 % nb) {
        h16* kp = (h16*)(ws + WS_KCT) + (size_t)16 * T * 64; h16* vp = (h16*)(ws + WS_VCT) + (size_t)16 * T * 64;
        for (int e = tid; e < 2048; e += NTHREADS) { kp[e] = (h16)0.f; vp[e] = (h16)0.f; }
    }
}

struct GemmN { const h16* A1; int lda1; const h16* B1; int ldb1; int K1; const h16* A2; int lda2; const h16* B2; int ldb2; int K2; int Mr, Nc; int bmap; };
template <bool DUAL, class Epi>
__device__ __forceinline__ void gemm_naive(const GemmN& g, const Epi& epi, int gw, int ngw, int lane) {
    const int tn = g.Nc / 64, tm = g.Mr / 64, ntile = tm * tn;
    const int fr = lane & 15, fq = lane >> 4;
    for (int tile = gw; tile < ntile; tile += ngw) {
        const int tr = tile / tn, tc = tile % tn;
        f32x4 acc1[4][4], acc2[4][4];
#pragma unroll
        for (int i = 0; i < 4; ++i)
#pragma unroll
            for (int j = 0; j < 4; ++j) { acc1[i][j] = (f32x4){0.f, 0.f, 0.f, 0.f}; acc2[i][j] = (f32x4){0.f, 0.f, 0.f, 0.f}; }
        const int bcol = tc * 64 + fr;
        const int brow0 = g.bmap ? ((bcol >> 7) * 256 + (bcol & 127)) : bcol;
        {
            const h16* ap = g.A1 + (size_t)(tr * 64 + fr) * g.lda1 + fq * 8;
            const h16* bp = g.B1 + (size_t)brow0 * g.ldb1 + fq * 8;
            for (int k0 = 0; k0 < g.K1; k0 += 32) {
                h16x8 a[4], b[4];
#pragma unroll
                for (int i = 0; i < 4; ++i) a[i] = *(const h16x8*)(ap + (size_t)i * 16 * g.lda1 + k0);
#pragma unroll
                for (int j = 0; j < 4; ++j) b[j] = *(const h16x8*)(bp + (size_t)j * 16 * g.ldb1 + k0);
#pragma unroll
                for (int i = 0; i < 4; ++i)
#pragma unroll
                    for (int j = 0; j < 4; ++j) acc1[i][j] = __builtin_amdgcn_mfma_f32_16x16x32_f16(a[i], b[j], acc1[i][j], 0, 0, 0);
            }
        }
        if (DUAL) {
            const h16* ap = g.A2 + (size_t)(tr * 64 + fr) * g.lda2 + fq * 8;
            const h16* bp = g.B2 + (size_t)(brow0 + (g.bmap ? 128 : 0)) * g.ldb2 + fq * 8;
            for (int k0 = 0; k0 < g.K2; k0 += 32) {
                h16x8 a[4], b[4];
#pragma unroll
                for (int i = 0; i < 4; ++i) a[i] = *(const h16x8*)(ap + (size_t)i * 16 * g.lda2 + k0);
#pragma unroll
                for (int j = 0; j < 4; ++j) b[j] = *(const h16x8*)(bp + (size_t)j * 16 * g.ldb2 + k0);
#pragma unroll
                for (int i = 0; i < 4; ++i)
#pragma unroll
                    for (int j = 0; j < 4; ++j) acc2[i][j] = __builtin_amdgcn_mfma_f32_16x16x32_f16(a[i], b[j], acc2[i][j], 0, 0, 0);
            }
        }
#pragma unroll
        for (int i = 0; i < 4; ++i)
#pragma unroll
            for (int j = 0; j < 4; ++j)
#pragma unroll
                for (int r = 0; r < 4; ++r) epi(tr * 64 + 16 * i + 4 * fq + r, tc * 64 + 16 * j + fr, acc1[i][j][r], DUAL ? acc2[i][j][r] : 0.f);
    }
}

struct EpiProj {
    unsigned char* ws;
    __device__ __forceinline__ void operator()(int m, int c, float v, float) const {
        v *= ((const float*)(ws + WS_RSTD1))[m];
        if (c < 512) { ((h16*)(ws + WS_XR))[(size_t)m * 512 + c] = (h16)v; return; }
        if (c < 1024) { ((h16*)(ws + WS_GRG))[(size_t)m * 512 + c - 512] = (h16)gelu_tanh(v); return; }
        if (c < 1536) { ((h16*)(ws + WS_Q))[(size_t)m * 512 + c - 1024] = (h16)v; return; }
        if (c < 2304) {
            const int idx = (c - 1536) >> 7, cc = (c - 1536) & 127, g = cc >> 6, d = cc & 63, b = m >> 12, t = m & 4095;
            const size_t off = ((size_t)(b * 2 + g) * T + t) * 64 + d;
            h16* base = (h16*)(ws + (idx == 0 ? WS_KCT : idx == 1 ? WS_VCT : idx == 2 ? WS_KS : idx == 3 ? WS_VS : idx == 4 ? WS_KW : WS_VW));
            base[off] = (h16)v; return;
        }
        if (c < DIN) ((float*)(ws + WS_GATE))[(size_t)m * 24 + c - 2304] = sigmoidf_(v);
    }
};
struct EpiCmpA {
    h16* H1; const float* b1;
    __device__ __forceinline__ void operator()(int r, int c, float v, float) const { H1[(size_t)r * CMPH + c] = (h16)gelu_tanh(v + b1[c]); }
};
struct EpiCmpB {
    float* O;
    __device__ __forceinline__ void operator()(int r, int c, float v, float) const { O[(size_t)r * HD + c] = v; }
};
struct EpiOut {
    const float* x; float* out; h16* x1h; const float* rsr; const float* ssa2;
    __device__ __forceinline__ void operator()(int m, int c, float v1, float v2) const {
        const float s1 = rsr[m], s2 = 1.0f / sqrtf((ssa2[m * 2] + ssa2[m * 2 + 1]) * (1.0f / 512.0f) + EPS);
        const float x1 = x[(size_t)m * D + c] + s1 * v1 + s2 * v2;
        out[(size_t)m * D + c] = x1; x1h[(size_t)m * D + c] = (h16)x1;
    }
};
struct EpiGU {
    h16* hm; const float* rstd2;
    __device__ __forceinline__ void operator()(int m, int c, float vg, float vu) const {
        const float r = rstd2[m], g = vg * r, u = vu * r;
        hm[(size_t)m * DFF + c] = (h16)(g * sigmoidf_(g) * u);
    }
};
struct EpiDown {
    float* out;
    __device__ __forceinline__ void operator()(int m, int c, float v, float) const { out[(size_t)m * D + c] += v; }
};

namespace pg8 {
#define PG8_LAS __attribute__((address_space(3)))
typedef unsigned short bf16_t;
typedef _Float16 bf16x8 __attribute__((ext_vector_type(8)));
typedef float f32x4 __attribute__((ext_vector_type(4)));
typedef unsigned u32x4 __attribute__((ext_vector_type(4)));
constexpr int BM = 256, BK = 64, HALF = 128, HTB = HALF * BK * 2  , STAGE_BYTES = 8 * HTB, NXCD = 8, WGM = 8;

__host__ __device__ __forceinline__ int lds_byte(int r, int c) { const int st = (r >> 4) * 2 + (c >> 5), rr = r & 15, cc = c & 31, ob = rr * 64 + cc * 2; return st * 1024 + (ob ^ (((ob >> 9) & 1) << 5)); }
__host__ __device__ __forceinline__ void stage_rc(int b, int& R, int& C) { const int st = b / 1024, sb = b % 1024, swz = sb ^ (((sb >> 9) & 1) << 5); R = (st >> 1) * 16 + swz / 64; C = (st & 1) * 32 + (swz % 64) / 2; }
__host__ __device__ __forceinline__ int perm32(int rho) { const int n = rho >> 4, i = rho & 15; return 8 * (i >> 2) + 4 * n + (i & 3); }

struct Unit { int pm, pn; };
struct Gemm { const bf16_t* A; const bf16_t* Bt; int M, N, K; };

struct StaticOrder {
    int nM, nN, nwg, G, c;
    __host__ __device__ void init(int M, int N, int G_, int c_) { nM = M / BM; nN = N / BM; nwg = nM * nN; G = G_; c = c_; }
    __host__ __device__ bool next(int i, Unit& u) const {
        const long L = (long)i * G + c; if (L >= nwg) return false;
        int wgid = (int)L; { const int q = nwg / NXCD, r = nwg % NXCD, xcd = wgid % NXCD, off = wgid / NXCD; wgid = (xcd < r ? xcd * (q + 1) : r * (q + 1) + (xcd - r) * q) + off; }
        const int nig = WGM * nN, gid = wgid / nig, fm = gid * WGM, gsz = (nM - fm) < WGM ? (nM - fm) : WGM;
        u.pm = fm + ((wgid % nig) % gsz); u.pn = (wgid % nig) / gsz; return true;
    }
    __device__ __forceinline__ void a_ready(const Unit&) const {}
    __device__ __forceinline__ void done(const Unit&) const {}
};
template <class Epi, class Sched, bool ALIGN_EPI = false, bool SP2 = false>
__device__ __forceinline__ void gemm_phase(PG8_LAS unsigned char* lds, const Gemm g, const Sched& S, const Epi& E) {
    const int tid = threadIdx.x, wid = __builtin_amdgcn_readfirstlane(tid >> 6), lane = tid & 63, wr = wid >> 2, wc = wid & 3, fr = lane & 15, fq = lane >> 4;
    const int K = g.K, nt = K / BK;
    unsigned voffA[2], voffB[2];
#pragma unroll
    for (int i = 0; i < 2; ++i) { int R, C; stage_rc(tid * 16 + i * 8192, R, C); const int Rb = Epi::PERM ? ((R & ~31) + perm32(R & 31)) : R;
        voffA[i] = (unsigned)(R * K + C) * 2u; voffB[i] = (unsigned)(Rb * K + C) * 2u; }
    const size_t kstep = (size_t)(BK * 2);
    const size_t hstep = (size_t)HALF * K * 2;
    const size_t tstep = 2 * hstep;
    const unsigned ldsw = (unsigned)wid * 1024u;
    const int aoff = lds_byte(wr * 64 + fr, fq * 8), boff = lds_byte(wc * 32 + fr, fq * 8);
#define PG8_SA(b, h) (((b) * 2 + (h)) * HTB)
#define PG8_SB(b, h) ((4 + (b) * 2 + (h)) * HTB)
#define PG8_STAGE(bufoff, gbase, voff) do { _Pragma("unroll") for (int _i = 0; _i < 2; ++_i) \
        __builtin_amdgcn_global_load_lds((const unsigned*)((const char*)(gbase) + (voff)[_i]), (PG8_LAS unsigned*)(lds + (bufoff) + ldsw + _i * 8192), 16, 0, 0); } while (0)
#define PG8_LDA(dst, b, h) do { _Pragma("unroll") for (int m = 0; m < 4; ++m) _Pragma("unroll") for (int k = 0; k < 2; ++k) dst[m][k] = *(const PG8_LAS bf16x8*)(lds + PG8_SA(b, h) + aoff + m * 2048 + k * 1024); } while (0)
#define PG8_LDB(dst, b, h) do { _Pragma("unroll") for (int n = 0; n < 2; ++n) _Pragma("unroll") for (int k = 0; k < 2; ++k) dst[n][k] = *(const PG8_LAS bf16x8*)(lds + PG8_SB(b, h) + boff + n * 2048 + k * 1024); } while (0)
#define PG8_MMA(ai, bj, At, Bt) do { __builtin_amdgcn_s_setprio(1); _Pragma("unroll") for (int m = 0; m < 4; ++m) _Pragma("unroll") for (int n = 0; n < 2; ++n) _Pragma("unroll") for (int k = 0; k < 2; ++k) \
        acc[ai][bj][m][n] = __builtin_amdgcn_mfma_f32_16x16x32_f16(Bt[n][k], At[m][k], acc[ai][bj][m][n], 0, 0, 0); __builtin_amdgcn_s_setprio(0); } while (0)
#define PG8_WAIT_V(n) asm volatile("s_waitcnt vmcnt(" #n ")" ::: "memory")
#define PG8_WAIT_L(n) asm volatile("s_waitcnt lgkmcnt(" #n ")" ::: "memory")
#define PG8_BAR __builtin_amdgcn_s_barrier()
#define PG8_SCHED __builtin_amdgcn_sched_barrier(0)
    Unit cur, nxt; int ui = 0;
    if (!S.next(0, cur)) return;
    f32x4 acc[2][2][4][2];
#pragma unroll
    for (int a = 0; a < 2; ++a)
#pragma unroll
        for (int b = 0; b < 2; ++b)
#pragma unroll
            for (int m = 0; m < 4; ++m)
#pragma unroll
                for (int n = 0; n < 2; ++n) acc[a][b][m][n] = (f32x4){0.f, 0.f, 0.f, 0.f};
    bf16x8 At[4][2], B0[2][2], B1[2][2];
    const char* cA = (const char*)g.A + (size_t)cur.pm * tstep; const char* cB = (const char*)g.Bt + (size_t)cur.pn * tstep;
    S.a_ready(cur);
    if constexpr (SP2) {
        PG8_STAGE(PG8_SB(0, 0), cB, voffB); PG8_STAGE(PG8_SB(0, 1), cB + hstep, voffB); PG8_STAGE(PG8_SA(0, 0), cA, voffA); PG8_STAGE(PG8_SA(0, 1), cA + hstep, voffA);
        if (wr == 1) PG8_BAR;
        PG8_WAIT_V(2); PG8_BAR;
        PG8_STAGE(PG8_SB(1, 0), cB + kstep, voffB); PG8_STAGE(PG8_SA(1, 0), cA + kstep, voffA); PG8_STAGE(PG8_SB(1, 1), cB + hstep + kstep, voffB);
        PG8_WAIT_V(6); PG8_BAR;
    } else {
        PG8_STAGE(PG8_SB(0, 0), cB, voffB); PG8_STAGE(PG8_SA(0, 0), cA, voffA); PG8_STAGE(PG8_SB(0, 1), cB + hstep, voffB); PG8_STAGE(PG8_SA(0, 1), cA + hstep, voffA);
        if (wr == 1) PG8_BAR;
        PG8_WAIT_V(4); PG8_BAR;
        PG8_STAGE(PG8_SB(1, 0), cB + kstep, voffB); PG8_STAGE(PG8_SA(1, 0), cA + kstep, voffA); PG8_STAGE(PG8_SB(1, 1), cB + hstep + kstep, voffB);
        PG8_WAIT_V(6); PG8_BAR;
    }
    for (;;) {
        const bool has_next = S.next(ui + 1, nxt);
        const char* nA = has_next ? (const char*)g.A + (size_t)nxt.pm * tstep : cA; const char* nB = has_next ? (const char*)g.Bt + (size_t)nxt.pn * tstep : cB;
        for (int t = 0; t < nt; t += 2) {
            const bool last = (t == nt - 2);
            const char* a1 = cA + (size_t)(t + 1) * kstep;
            const char* a2 = last ? nA : cA + (size_t)(t + 2) * kstep; const char* b2 = last ? nB : cB + (size_t)(t + 2) * kstep;
            const char* a3 = a2 + kstep; const char* b3 = b2 + kstep;
            if (last && has_next) S.a_ready(nxt);
            if constexpr (Epi::MIDK) { if (t == nt / 2) E.mid(acc, cur, wr, wc, fr, fq); }
            if constexpr (SP2) {
            PG8_LDB(B0, 0, 0); PG8_LDB(B1, 0, 1); PG8_SCHED; PG8_LDA(At, 0, 0); PG8_STAGE(PG8_SA(1, 1), a1 + hstep, voffA);
            PG8_WAIT_V(8); PG8_WAIT_L(0); PG8_BAR; PG8_MMA(0, 0, At, B0); PG8_MMA(0, 1, At, B1); PG8_BAR; PG8_SCHED;
            PG8_LDA(At, 0, 1); PG8_STAGE(PG8_SB(0, 0), b2, voffB); PG8_STAGE(PG8_SB(0, 1), b2 + hstep, voffB); PG8_STAGE(PG8_SA(0, 0), a2, voffA);
            PG8_WAIT_V(8); PG8_WAIT_L(0); PG8_BAR; PG8_MMA(1, 0, At, B0); PG8_MMA(1, 1, At, B1); PG8_BAR; PG8_SCHED;
            PG8_LDB(B0, 1, 0); PG8_LDB(B1, 1, 1); PG8_SCHED; PG8_LDA(At, 1, 0); PG8_STAGE(PG8_SA(0, 1), a2 + hstep, voffA);
            PG8_WAIT_V(8); PG8_WAIT_L(0); PG8_BAR; PG8_MMA(0, 0, At, B0); PG8_MMA(0, 1, At, B1); PG8_BAR; PG8_SCHED;
            PG8_LDA(At, 1, 1); PG8_STAGE(PG8_SB(1, 0), b3, voffB); PG8_STAGE(PG8_SB(1, 1), b3 + hstep, voffB); PG8_STAGE(PG8_SA(1, 0), a3, voffA);
            PG8_WAIT_V(8); PG8_WAIT_L(0); PG8_BAR; PG8_MMA(1, 0, At, B0); PG8_MMA(1, 1, At, B1); PG8_BAR; PG8_SCHED;
            } else {
            PG8_LDB(B0, 0, 0); PG8_SCHED; PG8_LDA(At, 0, 0); PG8_STAGE(PG8_SA(1, 1), a1 + hstep, voffA);
            PG8_WAIT_L(8); PG8_BAR; PG8_WAIT_L(0); PG8_MMA(0, 0, At, B0); PG8_BAR; PG8_SCHED;
            PG8_LDB(B1, 0, 1); PG8_STAGE(PG8_SB(0, 0), b2, voffB);
            PG8_BAR; PG8_WAIT_L(0); PG8_MMA(0, 1, At, B1); PG8_BAR;
            PG8_LDA(At, 0, 1); PG8_STAGE(PG8_SA(0, 0), a2, voffA);
            PG8_BAR; PG8_WAIT_L(0); PG8_MMA(1, 0, At, B0); PG8_BAR; PG8_SCHED;
            PG8_STAGE(PG8_SB(0, 1), b2 + hstep, voffB);
            PG8_WAIT_V(6); PG8_BAR; PG8_MMA(1, 1, At, B1); PG8_BAR;
            PG8_LDB(B0, 1, 0); PG8_SCHED; PG8_LDA(At, 1, 0); PG8_STAGE(PG8_SA(0, 1), a2 + hstep, voffA);
            PG8_WAIT_L(8); PG8_BAR; PG8_WAIT_L(0); PG8_MMA(0, 0, At, B0); PG8_BAR; PG8_SCHED;
            PG8_LDB(B1, 1, 1); PG8_STAGE(PG8_SB(1, 0), b3, voffB);
            PG8_BAR; PG8_WAIT_L(0); PG8_MMA(0, 1, At, B1); PG8_BAR;
            PG8_LDA(At, 1, 1); PG8_STAGE(PG8_SA(1, 0), a3, voffA);
            PG8_BAR; PG8_WAIT_L(0); PG8_MMA(1, 0, At, B0); PG8_BAR; PG8_SCHED;
            PG8_STAGE(PG8_SB(1, 1), b3 + hstep, voffB);
            PG8_WAIT_V(6); PG8_BAR; PG8_MMA(1, 1, At, B1); PG8_BAR;
            }
        }
        if constexpr (ALIGN_EPI) { if (wr == 0) PG8_BAR; }
        if constexpr (!Epi::AFTER_DRAIN) { E(acc, cur, wr, wc, fr, fq); S.done(cur); }
        if (!has_next) break;
#pragma unroll
        for (int a = 0; a < 2; ++a)
#pragma unroll
            for (int b = 0; b < 2; ++b)
#pragma unroll
                for (int m = 0; m < 4; ++m)
#pragma unroll
                    for (int n = 0; n < 2; ++n) acc[a][b][m][n] = (f32x4){0.f, 0.f, 0.f, 0.f};
        cur = nxt; cA = nA; cB = nB; ++ui;
        if constexpr (ALIGN_EPI) { if (wr == 1) PG8_BAR; }
    }
    PG8_WAIT_V(0);
    if constexpr (!ALIGN_EPI) { if (wr == 0) PG8_BAR; }
    PG8_BAR;
    if constexpr (Epi::AFTER_DRAIN) { E.fused(acc, cur, wr, wc, fr, fq, lds, wid, lane); S.done(cur); }
#undef PG8_SA
#undef PG8_SB
#undef PG8_STAGE
#undef PG8_LDA
#undef PG8_LDB
#undef PG8_MMA
#undef PG8_WAIT_V
#undef PG8_WAIT_L
#undef PG8_BAR
#undef PG8_SCHED
}
}

__device__ __forceinline__ float fsigmoid(float x) { return __builtin_amdgcn_rcpf(1.0f + __builtin_amdgcn_exp2f(-1.4426950408889634f * x)); }
__device__ __forceinline__ float fgelu_tanh(float x) { const float u2 = 1.5957691216057308f * (x + 0.044715f * x * x * x); return x * fsigmoid(u2); }
__device__ __forceinline__ h16x8 pack8(const f32x4 a, const f32x4 b) {
    h16x8 o; o[0] = (h16)a[0]; o[1] = (h16)a[1]; o[2] = (h16)a[2]; o[3] = (h16)a[3]; o[4] = (h16)b[0]; o[5] = (h16)b[1]; o[6] = (h16)b[2]; o[7] = (h16)b[3]; return o;
}
struct EpiProjF {
    static constexpr bool PERM = true, AFTER_DRAIN = false, MIDK = false;
    unsigned char* ws;
    __device__ __forceinline__ void operator()(const f32x4 (&acc)[2][2][4][2], const pg8::Unit& u, int wr, int wc, int fr, int fq) const {
        const float* RSTD1 = (const float*)(ws + WS_RSTD1);
        const int row0 = u.pm * 256 + wr * 64 + fr, pn = u.pn, c8 = wc * 32 + 8 * fq;
#pragma unroll
        for (int ai = 0; ai < 2; ++ai)
#pragma unroll
            for (int m = 0; m < 4; ++m) {
                const int row = row0 + ai * 128 + m * 16; const float rs = RSTD1[row];
#pragma unroll
                for (int bj = 0; bj < 2; ++bj) {
                    f32x4 v0 = acc[ai][bj][m][0] * rs, v1 = acc[ai][bj][m][1] * rs;
                    const int cb = bj * 128 + c8;
                    if (pn < 2) { *(h16x8*)((h16*)(ws + WS_XR) + (size_t)row * 512 + pn * 256 + cb) = pack8(v0, v1); }
                    else if (pn < 4) {
#pragma unroll
                        for (int e = 0; e < 4; ++e) { v0[e] = fgelu_tanh(v0[e]); v1[e] = fgelu_tanh(v1[e]); }
                        *(h16x8*)((h16*)(ws + WS_GRG) + (size_t)row * 512 + (pn - 2) * 256 + cb) = pack8(v0, v1); }
                    else if (pn < 6) { *(h16x8*)((h16*)(ws + WS_Q) + (size_t)row * 512 + (pn - 4) * 256 + cb) = pack8(v0, v1); }
                    else if (pn < 9) {
                        const int idx = 2 * (pn - 6) + bj, g = c8 >> 6, d = c8 & 63, b = row >> 12, t = row & 4095;
                        h16* base = (h16*)(ws + (idx == 0 ? WS_KCT : idx == 1 ? WS_VCT : idx == 2 ? WS_KS : idx == 3 ? WS_VS : idx == 4 ? WS_KW : WS_VW));
                        *(h16x8*)(base + ((size_t)(b * 2 + g) * T + t) * 64 + d) = pack8(v0, v1); }
                    else if (bj == 0 && c8 < 24) {
                        float* gp = (float*)(ws + WS_GATE) + (size_t)row * 24 + c8;
#pragma unroll
                        for (int e = 0; e < 4; ++e) { v0[e] = fsigmoid(v0[e]); v1[e] = fsigmoid(v1[e]); }
                        *(f32x4*)gp = v0; *(f32x4*)(gp + 4) = v1; }
                }
            }
    }
};
struct EpiOutF {
    static constexpr bool PERM = false, AFTER_DRAIN = false, MIDK = true;
    const float* x; float* out; h16* x1h; const float* rsr; const float* ssa2; float* ss2p;
    __device__ __forceinline__ float rsa_of(int row) const { const f32x2 a = *(const f32x2*)(ssa2 + (size_t)row * 2); return 1.0f / sqrtf((a[0] + a[1]) * (1.0f / 512.0f) + EPS); }
    __device__ __forceinline__ void mid(f32x4 (&acc)[2][2][4][2], const pg8::Unit& u, int wr, int wc, int fr, int fq) const {
        int row0 = u.pm * 256 + wr * 64 + fr; asm volatile("" : "+v"(row0));
#pragma unroll
        for (int ai = 0; ai < 2; ++ai)
#pragma unroll
            for (int m = 0; m < 4; ++m) { const int row = row0 + ai * 128 + m * 16; const float ratio = rsr[row] / rsa_of(row);
#pragma unroll
                for (int bj = 0; bj < 2; ++bj)
#pragma unroll
                    for (int n = 0; n < 2; ++n) acc[ai][bj][m][n] *= ratio; }
    }
    __device__ __forceinline__ void operator()(const f32x4 (&acc)[2][2][4][2], const pg8::Unit& u, int wr, int wc, int fr, int fq) const {
        const int row0 = u.pm * 256 + wr * 64 + fr, col0 = u.pn * 256 + wc * 32 + 4 * fq;
#pragma unroll
        for (int ai = 0; ai < 2; ++ai)
#pragma unroll
            for (int m = 0; m < 4; ++m) { const int row = row0 + ai * 128 + m * 16; const float s2 = rsa_of(row); float ss = 0.f;
#pragma unroll
                for (int bj = 0; bj < 2; ++bj)
#pragma unroll
                    for (int n = 0; n < 2; ++n) { const size_t off = (size_t)row * D + col0 + bj * 128 + n * 16;
                        const f32x4 v = *(const f32x4*)(x + off) + acc[ai][bj][m][n] * s2;
                        *(f32x4*)(out + off) = v; h16x4 h; h[0] = (h16)v[0]; h[1] = (h16)v[1]; h[2] = (h16)v[2]; h[3] = (h16)v[3]; *(h16x4*)(x1h + off) = h;
                        ss += (v[0] * v[0] + v[1] * v[1]) + (v[2] * v[2] + v[3] * v[3]); }
                ss += __shfl_xor(ss, 16); ss += __shfl_xor(ss, 32);
                if (fq == 0) ss2p[(size_t)row * 16 + u.pn * 4 + wc] = ss;
                if (m & 1) asm volatile("" ::: "memory"); }
    }
};
struct EpiGUF {
    static constexpr bool PERM = true, AFTER_DRAIN = false, MIDK = false;
    h16* hm; const float* ss2p;
    __device__ __forceinline__ void operator()(const f32x4 (&acc)[2][2][4][2], const pg8::Unit& u, int wr, int wc, int fr, int fq) const {
        const int row0 = u.pm * 256 + wr * 64 + fr, col = u.pn * 128 + wc * 32 + 8 * fq;
#pragma unroll
        for (int ai = 0; ai < 2; ++ai)
#pragma unroll
            for (int m = 0; m < 4; ++m) { const int row = row0 + ai * 128 + m * 16; const f32x4* sp = (const f32x4*)(ss2p + (size_t)row * 16);
                const f32x4 s0 = sp[0], s1 = sp[1], s2 = sp[2], s3 = sp[3];
                const float tot = ((s0[0] + s0[1]) + (s0[2] + s0[3])) + ((s1[0] + s1[1]) + (s1[2] + s1[3])) + ((s2[0] + s2[1]) + (s2[2] + s2[3])) + ((s3[0] + s3[1]) + (s3[2] + s3[3]));
                const float rs = 1.0f / sqrtf(tot * (1.0f / D) + EPS);
                f32x4 o[2];
#pragma unroll
                for (int n = 0; n < 2; ++n) { const f32x4 g = acc[ai][0][m][n] * rs, uu = acc[ai][1][m][n] * rs;
#pragma unroll
                    for (int e = 0; e < 4; ++e) o[n][e] = g[e] * fsigmoid(g[e]) * uu[e]; }
                *(h16x8*)(hm + (size_t)row * DFF + col) = pack8(o[0], o[1]); }
    }
};
struct EpiDownF {
    static constexpr bool PERM = false, AFTER_DRAIN = false, MIDK = false;
    float* out;
    __device__ __forceinline__ void operator()(const f32x4 (&acc)[2][2][4][2], const pg8::Unit& u, int wr, int wc, int fr, int fq) const {
        const int row0 = u.pm * 256 + wr * 64 + fr, col0 = u.pn * 256 + wc * 32 + 4 * fq;
#pragma unroll
        for (int ai = 0; ai < 2; ++ai)
#pragma unroll
            for (int m = 0; m < 4; ++m) { const int row = row0 + ai * 128 + m * 16;
#pragma unroll
                for (int bj = 0; bj < 2; ++bj)
#pragma unroll
                    for (int n = 0; n < 2; ++n) { float* p = out + (size_t)row * D + col0 + bj * 128 + n * 16; *(f32x4*)p = *(const f32x4*)p + acc[ai][bj][m][n]; } }
    }
};

__device__ __forceinline__ void normrope_rows(const Params& P, int gw, int ngw, int lane) {
    unsigned char* ws = P.ws;
    const float* ROPE = (const float*)(ws + WS_ROPE);
    const int sub = lane & 7;
    for (int m = gw; m < M; m += ngw) {
        const int b = m >> 12, t = m & 4095;
        float cs[8], sn[8];
#pragma unroll
        for (int i = 0; i < 8; ++i) { cs[i] = ROPE[m * 16 + i]; sn[i] = ROPE[m * 16 + 8 + i]; }
#pragma unroll
        for (int which = 0; which < 3; ++which) {
            h16* p; const float* nw; float scale;
            bool act = true;
            if (which == 0) { p = (h16*)(ws + WS_Q) + (size_t)m * 512 + (lane >> 3) * 64 + sub * 8; nw = P.q_norm_w; scale = C2; }
            else { act = lane < 16; const int g = (lane >> 3) & 1; p = (h16*)(ws + (which == 1 ? WS_KS : WS_KW)) + ((size_t)(b * 2 + g) * T + t) * 64 + sub * 8; nw = P.k_norm_w; scale = 1.0f; }
            float v[8]; float ss = 0.f;
            if (act) { const h16x8 h = *(const h16x8*)p;
#pragma unroll
                for (int e = 0; e < 8; ++e) { v[e] = (float)h[e]; ss += v[e] * v[e]; } }
            else {
#pragma unroll
                for (int e = 0; e < 8; ++e) v[e] = 0.f; }
            ss += __shfl_xor(ss, 1); ss += __shfl_xor(ss, 2); ss += __shfl_xor(ss, 4);
            const float rstd = 1.0f / sqrtf(ss * (1.0f / 64.0f) + EPS);
#pragma unroll
            for (int e = 0; e < 8; ++e) v[e] = v[e] * rstd * nw[sub * 8 + e];
            float o[8];
#pragma unroll
            for (int e = 0; e < 8; ++e) {
                const float other = __shfl_xor(v[e], 1);
                if (sub == 0) o[e] = v[e] * cs[e] - other * sn[e];
                else if (sub == 1) o[e] = v[e] * cs[e] + other * sn[e];
                else o[e] = v[e];
            }
            if (act) { h16x8 h;
#pragma unroll
                for (int e = 0; e < 8; ++e) h[e] = (h16)(o[e] * scale);
                *(h16x8*)p = h; }
        }
    }
}

constexpr int RL_WT = 0;
constexpr int RL_XCF = 16384;
constexpr int RL_AGW = RL_XCF + 8 * 16 * 68 * 4;
constexpr int RL_TRS = RL_AGW + 2 * 8 * 2 * 64 * 4;
constexpr int RL_END = RL_TRS + 8 * 2048;
__device__ __forceinline__ void rglru_local(const Params& P, unsigned char* lds_g, int tid_in, int lane_in, int wave, int bid, int nb) {
    unsigned char* ws = P.ws;
    LAS3 unsigned char* lds = (LAS3 unsigned char*)lds_g;
    const h16* XR = (const h16*)(ws + WS_XR);
    h16* HL = (h16*)(ws + WS_HL); h16* AC = (h16*)(ws + WS_AC); float* AGG = (float*)(ws + WS_AGG);
    int n_loaded = -1, it = 0;
    for (int item = bid; item < 8 * 8 * 32; item += nb, ++it) {
        int lane = lane_in; asm volatile("" : "+v"(lane));
        const int tid = wave * 64 + lane, fr = lane & 15, fq = lane >> 4;
        const int n = item & 7, b = (item >> 3) & 7, ck = item >> 6;
        if (n != n_loaded) {
            __syncthreads();
            LAS3 h16* WT = (LAS3 h16*)(lds + RL_WT);
            for (int e = tid; e < 8192; e += NTHREADS) { const int gte = e >> 12, d = (e >> 6) & 63, eo = e & 63;
                WT[gte * 4096 + eo * 64 + d] = (h16)(gte ? P.gate_x_w : P.gate_a_w)[n * 4096 + d * 64 + eo]; }
            LDS_WAIT(); __syncthreads(); n_loaded = n;
        }
        const size_t m0 = (size_t)b * T + ck * 128 + wave * 16;
        const int tloc = ck * 128 + wave * 16 + fr;
        h16x8 af[2];
        LAS3 float* XCF = (LAS3 float*)(lds + RL_XCF) + wave * (16 * 68);
#pragma unroll
        for (int s = 0; s < 2; ++s) {
            const int cb = n * 64 + 32 * s + 8 * fq;
            float xc[8];
            { const f32x4 b0 = *(const f32x4*)(P.conv_b + cb), b1 = *(const f32x4*)(P.conv_b + cb + 4);
              xc[0] = b0[0]; xc[1] = b0[1]; xc[2] = b0[2]; xc[3] = b0[3]; xc[4] = b1[0]; xc[5] = b1[1]; xc[6] = b1[2]; xc[7] = b1[3]; }
#pragma unroll
            for (int k = 0; k < 4; ++k) {
                h16x8 xv;
#pragma unroll
                for (int e = 0; e < 8; ++e) xv[e] = (h16)0.f;
                if (tloc - 3 + k >= 0) xv = *(const h16x8*)(XR + (m0 + fr - 3 + k) * 512 + cb);
                const f32x4 w0 = *(const f32x4*)(P.conv_w + k * 512 + cb), w1 = *(const f32x4*)(P.conv_w + k * 512 + cb + 4);
#pragma unroll
                for (int e = 0; e < 4; ++e) { xc[e] += w0[e] * (float)xv[e]; xc[4 + e] += w1[e] * (float)xv[4 + e]; }
            }
#pragma unroll
            for (int e = 0; e < 8; ++e) af[s][e] = (h16)xc[e];
            *(LAS3 f32x4*)(XCF + fr * 68 + 32 * s + 8 * fq) = (f32x4){xc[0], xc[1], xc[2], xc[3]};
            *(LAS3 f32x4*)(XCF + fr * 68 + 32 * s + 8 * fq + 4) = (f32x4){xc[4], xc[5], xc[6], xc[7]};
        }
        f32x4 ga[4], gx[4];
        { const LAS3 h16* WT = (const LAS3 h16*)(lds + RL_WT);
#pragma unroll
          for (int nt = 0; nt < 4; ++nt) {
              ga[nt] = (f32x4){0.f, 0.f, 0.f, 0.f}; gx[nt] = ga[nt];
#pragma unroll
              for (int s = 0; s < 2; ++s) {
                  const h16x8 ba_ = *(const LAS3 h16x8*)(WT + (16 * nt + fr) * 64 + 32 * s + 8 * fq);
                  const h16x8 bx_ = *(const LAS3 h16x8*)(WT + 4096 + (16 * nt + fr) * 64 + 32 * s + 8 * fq);
                  ga[nt] = __builtin_amdgcn_mfma_f32_16x16x32_f16(af[s], ba_, ga[nt], 0, 0, 0);
                  gx[nt] = __builtin_amdgcn_mfma_f32_16x16x32_f16(af[s], bx_, gx[nt], 0, 0, 0);
              }
          } }
        LDS_WAIT();
        float hl_[4][4], ac_[4][4], A4[4], H4[4];
#pragma unroll
        for (int nt = 0; nt < 4; ++nt) {
            const int ch = n * 64 + 16 * nt + fr;
            const float bav = P.gate_a_b[ch], bxv = P.gate_x_b[ch], sp8 = -8.0f * log1pf(__expf(-P.lru_lambda[ch]));
            float h = 0.f, A = 1.0f;
#pragma unroll
            for (int r = 0; r < 4; ++r) {
                const float xcv = XCF[(4 * fq + r) * 68 + 16 * nt + fr];
                const float rg = fsigmoid(ga[nt][r] + bav), ig = fsigmoid(gx[nt][r] + bxv);
                const float la = sp8 * rg, a = __builtin_amdgcn_exp2f(la * 1.4426950408889634f);
                const float x2 = 2.0f * la;
                const float poly = -x2 * (1.0f + x2 * (0.5f + x2 * (0.16666667f + x2 * (0.041666668f + x2 * (0.0083333338f + x2 * 0.0013888889f)))));
                const float em = (x2 > -0.25f) ? poly : (1.0f - a * a);
                const float bq = sqrtf(em) * (ig * xcv);
                h = a * h + bq; A *= a;
                hl_[nt][r] = h; ac_[nt][r] = A;
            }
            A4[nt] = A; H4[nt] = h;
        }
        float Ap[4], Hp[4], A16[4], H16[4];
#pragma unroll
        for (int nt = 0; nt < 4; ++nt) {
            float Aq = 1.0f, Hq = 0.f; Ap[nt] = 1.0f; Hp[nt] = 0.f;
#pragma unroll
            for (int q = 0; q < 4; ++q) {
                const float aq = __shfl(A4[nt], fr + 16 * q), hq = __shfl(H4[nt], fr + 16 * q);
                if (q == fq) { Ap[nt] = Aq; Hp[nt] = Hq; }
                Hq = aq * Hq + hq; Aq = aq * Aq;
            }
            A16[nt] = Aq; H16[nt] = Hq;
        }
        LAS3 float* AGW = (LAS3 float*)(lds + RL_AGW) + (it & 1) * (8 * 128);
        if (fq == 0) {
#pragma unroll
            for (int nt = 0; nt < 4; ++nt) { AGW[wave * 128 + 16 * nt + fr] = A16[nt]; AGW[wave * 128 + 64 + 16 * nt + fr] = H16[nt]; }
        }
        LDS_WAIT(); __syncthreads();
        LAS3 h16* TRS = (LAS3 h16*)(lds + RL_TRS) + wave * 1024;
        float S0[4], Apre[4];
#pragma unroll
        for (int nt = 0; nt < 4; ++nt) {
            float Aw = 1.0f, Hw = 0.f, At = 1.0f, Ht = 0.f;
#pragma unroll
            for (int w2 = 0; w2 < 8; ++w2) {
                const float aw = AGW[w2 * 128 + 16 * nt + fr], hw = AGW[w2 * 128 + 64 + 16 * nt + fr];
                if (w2 == wave) { Aw = At; Hw = Ht; }
                Ht = aw * Ht + hw; At = aw * At;
            }
            S0[nt] = Ap[nt] * Hw + Hp[nt]; Apre[nt] = Ap[nt] * Aw;
            if (wave == 0 && fq == 0) { float* ag = AGG + ((size_t)(b * 8 + n) * 32 + ck) * 128; ag[16 * nt + fr] = At; ag[64 + 16 * nt + fr] = Ht; }
        }
#pragma unroll
        for (int arr = 0; arr < 2; ++arr) {
            LDS_WAIT();
#pragma unroll
            for (int nt = 0; nt < 4; ++nt)
#pragma unroll
                for (int r = 0; r < 4; ++r) {
                    const float v = arr ? ac_[nt][r] * Apre[nt] : hl_[nt][r] + ac_[nt][r] * S0[nt];
                    TRS[(4 * fq + r) * 64 + 16 * nt + fr] = (h16)v; }
            LDS_WAIT();
            h16* dst = (arr ? AC : HL) + (m0 + (lane >> 2)) * 512 + n * 64 + (lane & 3) * 16;
            const h16x8 v0 = *(const LAS3 h16x8*)(TRS + (lane >> 2) * 64 + (lane & 3) * 16), v1 = *(const LAS3 h16x8*)(TRS + (lane >> 2) * 64 + (lane & 3) * 16 + 8);
            *(h16x8*)dst = v0; *(h16x8*)(dst + 8) = v1;
        }
    }
    __syncthreads();
}

__device__ __forceinline__ void rglru_fixup(const Params& P, int gw, int ngw, int lane) {
    unsigned char* ws = P.ws;
    const h16* HL = (const h16*)(ws + WS_HL); const h16* AC = (const h16*)(ws + WS_AC); const h16* GRG = (const h16*)(ws + WS_GRG);
    const float* AGG = (const float*)(ws + WS_AGG);
    h16* Y = (h16*)(ws + WS_Y); float* RSR = (float*)(ws + WS_SSR);
    for (int item = gw; item < 8 * 256; item += ngw) {
        const int seg = item & 255, b = item >> 8, ck = seg >> 3, n = lane >> 3, c8 = (lane & 7) * 8;
        const float* ag = AGG + ((size_t)(b * 8 + n) * 32) * 128 + c8;
        float carry[8];
#pragma unroll
        for (int e = 0; e < 8; ++e) carry[e] = 0.f;
        for (int c0 = 0; c0 < ck; c0 += 4) {
            f32x4 a_[4][2], h_[4][2];
#pragma unroll
            for (int u = 0; u < 4; ++u) { const int cc = min(c0 + u, ck - 1); const float* p = ag + (size_t)cc * 128;
                a_[u][0] = *(const f32x4*)p; a_[u][1] = *(const f32x4*)(p + 4); h_[u][0] = *(const f32x4*)(p + 64); h_[u][1] = *(const f32x4*)(p + 68); }
#pragma unroll
            for (int u = 0; u < 4; ++u) if (c0 + u < ck) {
#pragma unroll
                for (int e = 0; e < 8; ++e) carry[e] = a_[u][e >> 2][e & 3] * carry[e] + h_[u][e >> 2][e & 3]; }
        }
        const size_t mrow = (size_t)b * T + seg * 16;
        const int ch = n * 64 + c8;
#pragma unroll 4
        for (int tt = 0; tt < 16; ++tt) {
            const size_t m = mrow + tt;
            const h16x8 hv = *(const h16x8*)(HL + m * 512 + ch), av = *(const h16x8*)(AC + m * 512 + ch), gv = *(const h16x8*)(GRG + m * 512 + ch);
            h16x8 yo; float ss = 0.f;
#pragma unroll
            for (int e = 0; e < 8; ++e) { const float y = (float)gv[e] * ((float)hv[e] + (float)av[e] * carry[e]); yo[e] = (h16)y; ss += y * y; }
            *(h16x8*)(Y + m * 1024 + ch) = yo;
            ss = wave_sum(ss);
            if (lane == 0) RSR[m] = 1.0f / sqrtf(ss * (1.0f / 512.0f) + EPS);
        }
    }
}

__device__ __forceinline__ void compress_finish(const Params& P, int gw, int ngw, int lane) {
    unsigned char* ws = P.ws;
    const float* CR = (const float*)(ws + WS_CRAW); const float* ROPE = (const float*)(ws + WS_ROPE);
    h16* KCC = (h16*)(ws + WS_KCC); h16* VCC = (h16*)(ws + WS_VCC);
    for (int r = gw; r < 4096; r += ngw) {
        const int bg = r >> 8, c = r & 255, b = bg >> 1;
        float kv = CR[(size_t)r * 64 + lane], vv = CR[(size_t)(4096 + r) * 64 + lane];
        if (c == 255) { KCC[(size_t)r * 64 + lane] = (h16)0.f; VCC[(size_t)r * 64 + lane] = (h16)0.f; continue; }
        const float ss = wave_sum(kv * kv);
        kv = kv * (1.0f / sqrtf(ss * (1.0f / 64.0f) + EPS)) * P.k_norm_w[lane];
        const int mp = b * T + 16 * c + 31;
        const float other = __shfl_xor(kv, 8);
        float o = kv;
        if (lane < 8) o = kv * ROPE[mp * 16 + lane] - other * ROPE[mp * 16 + 8 + lane];
        else if (lane < 16) o = kv * ROPE[mp * 16 + lane - 8] + other * ROPE[mp * 16 + 8 + lane - 8];
        KCC[(size_t)r * 64 + lane] = (h16)o; VCC[(size_t)r * 64 + lane] = (h16)vv;
    }
}

__device__ __forceinline__ void qk4(const h16* krow, const float* qs, float (&s)[4]) {
    s[0] = s[1] = s[2] = s[3] = 0.f;
#pragma unroll
    for (int c = 0; c < 8; ++c) {
        const h16x8 k8 = *(const h16x8*)(krow + c * 8);
#pragma unroll
        for (int e = 0; e < 8; ++e) { const float kf = (float)k8[e];
#pragma unroll
            for (int h = 0; h < 4; ++h) s[h] += qs[h * 64 + c * 8 + e] * kf; }
    }
}
__device__ __forceinline__ void attn_group(const h16* Kb, const h16* Vb, int key, bool valid, int nk, const float* qs, float* ps,
                                           float (&mx)[4], float (&l)[4], float (&o)[4], int lane) {
    float s[4];
    qk4(Kb + (size_t)(valid ? key : 0) * 64, qs, s);
    float p[4];
#pragma unroll
    for (int h = 0; h < 4; ++h) {
        const float sv = valid ? s[h] : -INFINITY;
        const float mn = fmaxf(mx[h], wave_max(sv));
        const float f = exp2f(mx[h] - mn);
        p[h] = exp2f(sv - mn);
        l[h] = l[h] * f + wave_sum(p[h]); o[h] *= f; mx[h] = mn;
    }
    LDS_WAIT();
    *(f32x4*)(ps + lane * 4) = (f32x4){p[0], p[1], p[2], p[3]};
    LDS_WAIT();
    const int k0 = key - lane;
    for (int kk = 0; kk < nk; ++kk) {
        const float v = (float)Vb[(size_t)(k0 + kk) * 64 + lane];
        const f32x4 pv = *(const f32x4*)(ps + kk * 4);
        o[0] += pv.x * v; o[1] += pv.y * v; o[2] += pv.z * v; o[3] += pv.w * v;
    }
}
__device__ __forceinline__ void attn_naive(const Params& P, unsigned char* lds, int lane, int wave, int gw, int ngw) {
    unsigned char* ws = P.ws;
    float* qs = (float*)lds + wave * (256 + 1024);
    float* ps = qs + 256;
    const h16* QN = (const h16*)(ws + WS_Q);
    const h16* KCC = (const h16*)(ws + WS_KCC); const h16* VCC = (const h16*)(ws + WS_VCC);
    const h16* KS = (const h16*)(ws + WS_KS); const h16* VS = (const h16*)(ws + WS_VS);
    const h16* KW = (const h16*)(ws + WS_KW); const h16* VW = (const h16*)(ws + WS_VW);
    const float* GATE = (const float*)(ws + WS_GATE);
    h16* Y = (h16*)(ws + WS_Y); float* SSA = (float*)(ws + WS_SSA);
    for (int item = gw; item < M * 2; item += ngw) {
        const int g = item & 1, m = item >> 1, b = m >> 12, t = m & 4095, bg = b * 2 + g;
        LDS_WAIT();
#pragma unroll
        for (int h = 0; h < 4; ++h) qs[h * 64 + lane] = (float)QN[(size_t)m * 512 + (4 * g + h) * 64 + lane];
        LDS_WAIT();
        const int nvalid = (t >= 31) ? ((t - 31) >> 4) + 1 : 0;
        float sc[4][4];
#pragma unroll
        for (int i = 0; i < 4; ++i) {
            const int c = lane + 64 * i;
            float s[4]; qk4(KCC + ((size_t)bg * 256 + c) * 64, qs, s);
#pragma unroll
            for (int h = 0; h < 4; ++h) sc[i][h] = (c < nvalid) ? s[h] : -INFINITY;
        }
#pragma unroll
        for (int h = 0; h < 4; ++h) {
            float mxv = fmaxf(fmaxf(sc[0][h], sc[1][h]), fmaxf(sc[2][h], sc[3][h]));
            mxv = wave_max(mxv);
            if (!(mxv > -INFINITY)) mxv = 0.f;
            float ls = 0.f;
#pragma unroll
            for (int i = 0; i < 4; ++i) { sc[i][h] = exp2f(sc[i][h] - mxv); ls += sc[i][h]; }
            ls = wave_sum(ls);
            const float inv = 1.0f / fmaxf(ls, 1e-30f);
#pragma unroll
            for (int i = 0; i < 4; ++i) sc[i][h] *= inv;
        }
#pragma unroll
        for (int i = 0; i < 4; ++i) *(f32x4*)(ps + (lane + 64 * i) * 4) = (f32x4){sc[i][0], sc[i][1], sc[i][2], sc[i][3]};
        LDS_WAIT();
        float ocmp[4] = {0.f, 0.f, 0.f, 0.f};
        for (int c = 0; c < nvalid; ++c) {
            const float v = (float)VCC[((size_t)bg * 256 + c) * 64 + lane];
            const f32x4 pv = *(const f32x4*)(ps + c * 4);
            ocmp[0] += pv.x * v; ocmp[1] += pv.y * v; ocmp[2] += pv.z * v; ocmp[3] += pv.w * v;
        }
        float imp = 0.f;
        {
#pragma unroll
            for (int e = 0; e < 4; ++e) { const f32x4 pv = *(const f32x4*)(ps + (4 * lane + e) * 4); const float sh = (pv.x + pv.y) + (pv.z + pv.w); imp += (e == 3) ? 0.5f * sh : sh; }
            if (lane >= 1) { const f32x4 pv = *(const f32x4*)(ps + (4 * lane - 1) * 4); imp += 0.5f * ((pv.x + pv.y) + (pv.z + pv.w)); }
        }
        const int cur = t >> 6;
        const bool forced = (lane == 0) || (lane == cur) || (lane == cur - 1);
        const bool cand = !forced && lane < cur - 1;
        const int quota = 16 - (1 + (cur >= 1 ? 1 : 0) + (cur >= 2 ? 1 : 0));
        int rank = 0;
        for (int j2 = 0; j2 < 64; ++j2) {
            const float io = __shfl(imp, j2); const int co = __shfl((int)cand, j2);
            if (co && (io > imp || (io == imp && j2 < lane))) ++rank;
        }
        const bool sel = forced || (cand && rank < quota);
        unsigned long long mask = __ballot(sel);
        float mx[4] = {-INFINITY, -INFINITY, -INFINITY, -INFINITY}, ls[4] = {0.f, 0.f, 0.f, 0.f}, os[4] = {0.f, 0.f, 0.f, 0.f};
        while (mask) {
            const int j = __builtin_ctzll(mask); mask &= mask - 1;
            const int key = 64 * j + lane; const int nk = min(64, t - 64 * j + 1);
            attn_group(KS + (size_t)bg * T * 64, VS + (size_t)bg * T * 64, key, key <= t, nk, qs, ps, mx, ls, os, lane);
        }
        float mw[4] = {-INFINITY, -INFINITY, -INFINITY, -INFINITY}, lw[4] = {0.f, 0.f, 0.f, 0.f}, ow[4] = {0.f, 0.f, 0.f, 0.f};
        for (int k0 = max(0, t - 511); k0 <= t; k0 += 64) {
            const int key = k0 + lane; const int nk = min(64, t - k0 + 1);
            attn_group(KW + (size_t)bg * T * 64, VW + (size_t)bg * T * 64, key, key <= t, nk, qs, ps, mw, lw, ow, lane);
        }
        float ssq = 0.f;
#pragma unroll
        for (int h = 0; h < 4; ++h) {
            const float* gp = GATE + (size_t)m * 24 + (4 * g + h) * 3;
            const float o = gp[0] * ocmp[h] + gp[1] * os[h] / ls[h] + gp[2] * ow[h] / lw[h];
            Y[(size_t)m * 1024 + 512 + (4 * g + h) * 64 + lane] = (h16)o;
            ssq += o * o;
        }
        ssq = wave_sum(ssq);
        if (lane == 0) SSA[m * 2 + g] = ssq;
    }
}


typedef float f32x16 __attribute__((ext_vector_type(16)));
typedef short s16x4 __attribute__((ext_vector_type(4)));
constexpr int AT_KV = 0;
constexpr int AT_IMPH = 32768;
constexpr int AT_IMPS = AT_IMPH + 65536;
constexpr int AT_MASK = AT_IMPS + 16384;
constexpr int AT_WSF = AT_MASK + 512;
constexpr int AT_SSQ = AT_WSF + 2048;
constexpr int AT_STG = AT_SSQ + 1024;
constexpr int AT_END = AT_STG + 32768;
__device__ __forceinline__ int crow(int r, int hi) { return (r & 3) + 8 * (r >> 2) + 4 * hi; }
__device__ __forceinline__ float fexp2(float x) { return __builtin_amdgcn_exp2f(x); }

__device__ __forceinline__ void at_qkt(f32x16& p0, f32x16& p1, const LAS3 unsigned char* kb, const h16x8 (&qr)[4], int r32, int hi) {
    const LAS3 unsigned char* kp = kb + hi * 1024 + r32 * 16;
    p0 = (f32x16){0.f, 0.f, 0.f, 0.f, 0.f, 0.f, 0.f, 0.f, 0.f, 0.f, 0.f, 0.f, 0.f, 0.f, 0.f, 0.f}; p1 = p0;
#pragma unroll
    for (int d0 = 0; d0 < 4; ++d0) {
        const h16x8 b0 = *(const LAS3 h16x8*)(kp + d0 * 2048), b1 = *(const LAS3 h16x8*)(kp + d0 * 2048 + 512);
        p0 = __builtin_amdgcn_mfma_f32_32x32x16_f16(b0, qr[d0], p0, 0, 0, 0);
        p1 = __builtin_amdgcn_mfma_f32_32x32x16_f16(b1, qr[d0], p1, 0, 0, 0);
    }
}
__device__ __forceinline__ void at_mask(f32x16& p0, f32x16& p1, int lo, int hb, int hi) {
#pragma unroll
    for (int r = 0; r < 16; ++r) { const int kv = crow(r, hi);
        if (kv < lo || kv >= hb) p0[r] = -INFINITY;
        if (kv + 32 < lo || kv + 32 >= hb) p1[r] = -INFINITY; }
}
__device__ __forceinline__ float at_rowmax(const f32x16& p0, const f32x16& p1) {
    float a = fmaxf(p0[0], p1[0]);
#pragma unroll
    for (int r = 1; r < 16; ++r) a = fmaxf(a, fmaxf(p0[r], p1[r]));
    return fmaxf(a, __shfl_xor(a, 32));
}
__device__ __forceinline__ h16x8 at_pack(const f32x16& p, int b) {
    h16x8 o;
#pragma unroll
    for (int j = 0; j < 8; ++j) o[j] = (h16)p[b + j];
    return o;
}
__device__ __forceinline__ void at_pv(f32x16& o0, f32x16& o1, const LAS3 unsigned char* vb, const f32x16& p0, const f32x16& p1, int lane, int hi) {
    const LAS3 unsigned char* vp = vb + ((lane >> 4) & 1) * 32 + (lane & 3) * 8 + (4 * hi + ((lane & 15) >> 2)) * 64;
    const h16x8 pw0 = at_pack(p0, 0), pw1 = at_pack(p0, 8), pw2 = at_pack(p1, 0), pw3 = at_pack(p1, 8);
#pragma unroll
    for (int dh = 0; dh < 2; ++dh) {
        h16x8 vf[4];
#pragma unroll
        for (int kg = 0; kg < 4; ++kg) {
            const s16x4 lo4 = __builtin_amdgcn_ds_read_tr16_b64_v4i16((LAS3 s16x4*)(vp + dh * 4096 + kg * 1024));
            const s16x4 hi4 = __builtin_amdgcn_ds_read_tr16_b64_v4i16((LAS3 s16x4*)(vp + dh * 4096 + kg * 1024 + 512));
            typedef short s16x8 __attribute__((ext_vector_type(8)));
            const s16x8 w = (s16x8){lo4[0], lo4[1], lo4[2], lo4[3], hi4[0], hi4[1], hi4[2], hi4[3]};
            vf[kg] = __builtin_bit_cast(h16x8, w);
        }
        f32x16& o = dh ? o1 : o0;
        o = __builtin_amdgcn_mfma_f32_32x32x16_f16(pw0, vf[0], o, 0, 0, 0);
        o = __builtin_amdgcn_mfma_f32_32x32x16_f16(pw1, vf[1], o, 0, 0, 0);
        o = __builtin_amdgcn_mfma_f32_32x32x16_f16(pw2, vf[2], o, 0, 0, 0);
        o = __builtin_amdgcn_mfma_f32_32x32x16_f16(pw3, vf[3], o, 0, 0, 0);
    }
}
__device__ __forceinline__ void at_scale_rows(f32x16& o0, f32x16& o1, float f, LAS3 float* wsf, int r32, int hi) {
    LDS_WAIT();
    if (hi == 0) wsf[r32] = f;
    LDS_WAIT();
#pragma unroll
    for (int r = 0; r < 16; ++r) { const float fr = wsf[crow(r, hi)]; o0[r] *= fr; o1[r] *= fr; }
}
__device__ __forceinline__ void at_step(f32x16& p0, f32x16& p1, f32x16& o0, f32x16& o1, float& m, float& l, const LAS3 unsigned char* vb, LAS3 float* wsf, int lane, int r32, int hi) {
    const float rm = at_rowmax(p0, p1);
    const float mn = fmaxf(m, rm);
    if (__any(mn > m)) { const float f = fexp2(m - mn); l *= f; m = mn; at_scale_rows(o0, o1, f, wsf, r32, hi); }
    float s = 0.f;
#pragma unroll
    for (int r = 0; r < 16; ++r) { p0[r] = fexp2(p0[r] - m); p1[r] = fexp2(p1[r] - m); s += p0[r] + p1[r]; }
    l += s;
    at_pv(o0, o1, vb, p0, p1, lane, hi);
}

__device__ __forceinline__ void attn_unit(const Params& P, unsigned char* lds_g, int bg, int qb, int tid_in, int lane_in, int wave) {
    int lane = lane_in; asm volatile("" : "+v"(lane));
    const int tid = wave * 64 + lane; (void)tid_in;
    unsigned char* ws = P.ws;
    LAS3 unsigned char* lds = (LAS3 unsigned char*)lds_g;
    const int r32 = lane & 31, hi = lane >> 5, hl = wave >> 1, th = wave & 1;
    const int b = bg >> 1, g = bg & 1;
    const int tok = 32 * th + r32;
    const int t = 64 * qb + tok;
    const size_t m = (size_t)b * T + t;
    const h16* KCC = (const h16*)(ws + WS_KCC) + (size_t)bg * 256 * 64; const h16* VCC = (const h16*)(ws + WS_VCC) + (size_t)bg * 256 * 64;
    const h16* KS = (const h16*)(ws + WS_KS) + (size_t)bg * T * 64; const h16* VS = (const h16*)(ws + WS_VS) + (size_t)bg * T * 64;
    const h16* KW = (const h16*)(ws + WS_KW) + (size_t)bg * T * 64; const h16* VW = (const h16*)(ws + WS_VW) + (size_t)bg * T * 64;
    LAS3 float* wsf = (LAS3 float*)(lds + AT_WSF) + wave * 64;
    LAS3 float* IMPH = (LAS3 float*)(lds + AT_IMPH); LAS3 float* IMPS = (LAS3 float*)(lds + AT_IMPS);
    const int ntc = (4 * qb + 3 + 63) >> 6, nsl = qb + 1, nwn = min(qb + 1, 9), nt = 2 * ntc + nsl + nwn;
#define AT_KOFF (lane * 64 + wave * 8)
#define AT_VOFF ((16 * (wave & 3) + (lane >> 2)) * 64 + (wave >> 2) * 32 + (lane & 3) * 8)
#define AT_ISSUE(i) do { const int i_ = (i); const h16* ks_; const h16* vs_ = nullptr; int key0_; \
        if (i_ < ntc) { ks_ = KCC; key0_ = 64 * i_; } else if (i_ < 2 * ntc) { ks_ = KCC; vs_ = VCC; key0_ = 64 * (i_ - ntc); } \
        else if (i_ < 2 * ntc + nsl) { ks_ = KS; vs_ = VS; key0_ = 64 * (i_ - 2 * ntc); } else { ks_ = KW; vs_ = VW; key0_ = 64 * (qb - (i_ - 2 * ntc - nsl)); } \
        LAS3 unsigned char* dst_ = lds + AT_KV + (i_ & 1) * 16384 + wave * 1024; \
        __builtin_amdgcn_global_load_lds((const unsigned*)(ks_ + (size_t)key0_ * 64 + AT_KOFF), (LAS3 unsigned*)dst_, 16, 0, 0); \
        if (vs_) __builtin_amdgcn_global_load_lds((const unsigned*)(vs_ + (size_t)key0_ * 64 + AT_VOFF), (LAS3 unsigned*)(dst_ + 8192), 16, 0, 0); } while (0)
    AT_ISSUE(0);
    h16x8 qr[4];
    { const h16* qp = (const h16*)(ws + WS_Q) + m * 512 + (4 * g + hl) * 64 + hi * 8;
#pragma unroll
      for (int d0 = 0; d0 < 4; ++d0) qr[d0] = *(const h16x8*)(qp + d0 * 16); }
    float gt[3];
    { const float* gp = (const float*)(ws + WS_GATE) + m * 24 + (4 * g + hl) * 3; gt[0] = gp[0]; gt[1] = gp[1]; gt[2] = gp[2]; }
    const int nvalid = (t >= 31) ? ((t - 31) >> 4) + 1 : 0;
    f32x16 ot0, ot1, o0, o1;
#pragma unroll
    for (int r = 0; r < 16; ++r) { ot0[r] = 0.f; ot1[r] = 0.f; o0[r] = 0.f; o1[r] = 0.f; }
    float mx = -INFINITY, l = 0.f, cinv = 0.f, carry = 0.f;
    unsigned selw0 = 0u, selw1 = 0u;
    asm volatile("s_waitcnt vmcnt(0)" ::: "memory"); __syncthreads();
    const int lane_outer = lane, r32_outer = r32, hi_outer = hi, tok_outer = tok, tid_outer = tid;
    for (int i = 0; i < nt; ++i) {
        int lane = lane_outer; asm volatile("" : "+v"(lane));
        const int r32 = lane & 31, hi = lane >> 5, tok = 32 * th + r32, tid = wave * 64 + lane;
        if (i + 1 < nt) AT_ISSUE(i + 1);
        const LAS3 unsigned char* kb = lds + AT_KV + (i & 1) * 16384; const LAS3 unsigned char* vb = kb + 8192;
        f32x16 p0, p1;
        at_qkt(p0, p1, kb, qr, r32, hi);
        if (i < ntc) {
            at_mask(p0, p1, 0, nvalid - 64 * i, hi);
            const float rm = at_rowmax(p0, p1);
            const float mn = fmaxf(mx, rm), ms = (mn == -INFINITY) ? 0.f : mn;
            float s = 0.f;
#pragma unroll
            for (int r = 0; r < 16; ++r) s += fexp2(p0[r] - ms) + fexp2(p1[r] - ms);
            l = l * fexp2(mx - ms) + s; mx = mn;
            if (i == ntc - 1) { const float lt = l + __shfl_xor(l, 32); cinv = 1.0f / fmaxf(lt, 1e-30f); if (mx == -INFINITY) mx = 0.f; }
        } else if (i < 2 * ntc) {
            const int tl = i - ntc;
            at_mask(p0, p1, 0, nvalid - 64 * tl, hi);
#pragma unroll
            for (int r = 0; r < 16; ++r) { p0[r] = fexp2(p0[r] - mx) * cinv; p1[r] = fexp2(p1[r] - mx) * cinv; }
#pragma unroll
            for (int gq = 0; gq < 2; ++gq) {
                const f32x16& p = gq ? p1 : p0;
                float tot[4], x[4];
#pragma unroll
                for (int R = 0; R < 4; ++R) { const float sp = 0.5f * p[4 * R + 3]; tot[R] = (p[4 * R] + p[4 * R + 1]) + (p[4 * R + 2] + sp); x[R] = __shfl_xor(sp, 32); }
                if (hi) {
#pragma unroll
                    for (int R = 0; R < 4; ++R) tot[R] += x[R];
                } else { tot[0] += carry; tot[1] += x[0]; tot[2] += x[1]; tot[3] += x[2]; carry = x[3]; }
#pragma unroll
                for (int R = 0; R < 4; ++R) IMPH[(hl * 64 + 16 * tl + 8 * gq + 2 * R + hi) * 64 + tok] = tot[R];
            }
            at_pv(o0, o1, vb, p0, p1, lane, hi);
            if (i == 2 * ntc - 1) {
                at_scale_rows(o0, o1, gt[0], wsf, r32, hi);
#pragma unroll
                for (int r = 0; r < 16; ++r) { ot0[r] += o0[r]; ot1[r] += o1[r]; o0[r] = 0.f; o1[r] = 0.f; }
                mx = -INFINITY; l = 0.f;
                LDS_WAIT(); __syncthreads();
                { const int tk = tid & 63, part = tid >> 6;
                  float own[8];
#pragma unroll
                  for (int e = 0; e < 8; ++e) { const int j = 8 * part + e; float v = 0.f;
                      if (j < 16 * ntc) v = (IMPH[(0 * 64 + j) * 64 + tk] + IMPH[(1 * 64 + j) * 64 + tk]) + (IMPH[(2 * 64 + j) * 64 + tk] + IMPH[(3 * 64 + j) * 64 + tk]);
                      own[e] = v; IMPS[j * 64 + tk] = v; }
                  LDS_WAIT(); __syncthreads();
                  int rank[8];
#pragma unroll
                  for (int e = 0; e < 8; ++e) rank[e] = 0;
                  for (int j2 = 1; j2 <= qb - 2; ++j2) { const float v2 = IMPS[j2 * 64 + tk];
#pragma unroll
                      for (int e = 0; e < 8; ++e) { const int j = 8 * part + e; rank[e] += (v2 > own[e] || (v2 == own[e] && j2 < j)) ? 1 : 0; } }
                  const int quota = 16 - (1 + (qb >= 1 ? 1 : 0) + (qb >= 2 ? 1 : 0));
                  unsigned bits = 0u;
#pragma unroll
                  for (int e = 0; e < 8; ++e) { const int j = 8 * part + e; const bool forced = (j == 0) || (j == qb) || (j == qb - 1); const bool cand = !forced && j >= 1 && j <= qb - 2;
                      if (forced || (cand && rank[e] < quota)) bits |= 1u << e; }
                  ((LAS3 unsigned char*)(lds + AT_MASK))[tk * 8 + part] = (unsigned char)bits;
                  LDS_WAIT(); __syncthreads();
                  const LAS3 unsigned* mp = (const LAS3 unsigned*)(lds + AT_MASK) + tok * 2; selw0 = mp[0]; selw1 = mp[1]; }
            }
        } else if (i < 2 * ntc + nsl) {
            const int j = i - 2 * ntc;
            const bool sel = ((j < 32 ? (selw0 >> j) : (selw1 >> (j - 32))) & 1u) != 0u;
            const int hb = sel ? ((j == qb) ? tok + 1 : 64) : 0;
            at_mask(p0, p1, 0, hb, hi);
            at_step(p0, p1, o0, o1, mx, l, vb, wsf, lane, r32, hi);
            if (j == qb) {
                const float lt = l + __shfl_xor(l, 32);
                at_scale_rows(o0, o1, gt[1] / lt, wsf, r32, hi);
#pragma unroll
                for (int r = 0; r < 16; ++r) { ot0[r] += o0[r]; ot1[r] += o1[r]; o0[r] = 0.f; o1[r] = 0.f; }
                mx = -INFINITY; l = 0.f;
            }
        } else {
            const int jj = i - 2 * ntc - nsl;
            const int lo = (jj == 8) ? tok + 1 : 0, hb = (jj == 0) ? tok + 1 : 64;
            if (jj == 0 || jj == 8) at_mask(p0, p1, lo, hb, hi);
            at_step(p0, p1, o0, o1, mx, l, vb, wsf, lane, r32, hi);
            if (i == nt - 1) {
                const float lt = l + __shfl_xor(l, 32);
                at_scale_rows(o0, o1, gt[2] / lt, wsf, r32, hi);
#pragma unroll
                for (int r = 0; r < 16; ++r) { ot0[r] += o0[r]; ot1[r] += o1[r]; }
            }
        }
        asm volatile("s_waitcnt vmcnt(0)" ::: "memory"); __syncthreads();
    }
#undef AT_ISSUE
#undef AT_KOFF
#undef AT_VOFF
    (void)r32_outer; (void)hi_outer; (void)tok_outer; (void)tid_outer;
    LAS3 h16* stg = (LAS3 h16*)(lds + AT_STG) + wave * 2048;
#pragma unroll
    for (int r = 0; r < 16; ++r) { const int orow = crow(r, hi); stg[orow * 64 + r32] = (h16)ot0[r]; stg[orow * 64 + 32 + r32] = (h16)ot1[r]; }
    LDS_WAIT();
    LAS3 float* SSQ = (LAS3 float*)(lds + AT_SSQ);
    h16* Yb = (h16*)(ws + WS_Y) + ((size_t)b * T + 64 * qb + 32 * th) * 1024 + 512 + (4 * g + hl) * 64;
#pragma unroll
    for (int i2 = 0; i2 < 4; ++i2) { const int row = i2 * 8 + (lane >> 3), ch = lane & 7;
        const h16x8 v = *(const LAS3 h16x8*)(stg + row * 64 + ch * 8);
        *(h16x8*)(Yb + (size_t)row * 1024 + ch * 8) = v;
        float ss = 0.f;
#pragma unroll
        for (int e = 0; e < 8; ++e) { const float f = (float)v[e]; ss += f * f; }
        ss += __shfl_xor(ss, 1); ss += __shfl_xor(ss, 2); ss += __shfl_xor(ss, 4);
        if (ch == 0) SSQ[hl * 64 + 32 * th + row] = ss; }
    LDS_WAIT(); __syncthreads();
    if (tid < 64) ((float*)(ws + WS_SSA))[((size_t)b * T + 64 * qb + tid) * 2 + g] = (SSQ[tid] + SSQ[64 + tid]) + (SSQ[128 + tid] + SSQ[192 + tid]);
    __syncthreads();
}
__device__ __forceinline__ void attn_mfma_phase(const Params& P, unsigned char* lds, int tid, int lane, int wave, int bid, int nb) {
    const bool deal = (nb == 256);
    const int v = (bid & 7) * 32 + (bid >> 3);
    const int nu = deal ? 4 : (1024 - bid + nb - 1) / nb;
    for (int k = 0; k < nu; ++k) {
        int bg, qb;
        if (deal) { const int s = v & 15; bg = v >> 4; qb = (k == 0) ? 63 - s : (k == 1) ? 32 + s : (k == 2) ? 31 - s : s; }
        else { const int u = bid + k * nb; bg = u >> 6; qb = 63 - (u & 63); }
        attn_unit(P, lds, bg, qb, tid, lane, wave);
    }
}


#define XLAS __attribute__((address_space(3)))
#define XB_TMO      128
#define XB_XCNT(j)  (256  + 64 * (j))
#define XB_XSUB(j)  (1280 + 64 * (j))
#define XB_XGEN(j)  (2304 + 64 * (j))
#define XB_TOP      3328
#define XB_TOPGEN   3392
#define XCD_BAR_WORDS 3456
#define XB_SPIN_CAP (1u << 18)

__device__ __forceinline__ unsigned xb_ld(unsigned* p)              { return __hip_atomic_load(p, __ATOMIC_RELAXED, __HIP_MEMORY_SCOPE_AGENT); }
__device__ __forceinline__ unsigned xb_add(unsigned* p, unsigned v) { return __hip_atomic_fetch_add(p, v, __ATOMIC_RELAXED, __HIP_MEMORY_SCOPE_AGENT); }
__device__ __forceinline__ unsigned xb_xcc_id() { return (unsigned)__builtin_amdgcn_s_getreg((3 << 11) | 20) & 0xFu; }
#define XB_SPIN(cond, bar) do { unsigned _sp = 0; while (cond) { __builtin_amdgcn_s_sleep(1); \
    if ((++_sp & 255u) == 0u) { if (xb_ld(&(bar)[XB_TMO])) break; if (_sp > XB_SPIN_CAP) { atomicAdd(&(bar)[XB_TMO], 1u); break; } } } } while (0)

struct XcdBarrier {
    unsigned* bar; unsigned x;
    volatile XLAS unsigned* st;
};

__device__ __forceinline__ XcdBarrier xcd_barrier_post(unsigned* bar, volatile XLAS unsigned* st) {
    XcdBarrier b; b.bar = bar; b.x = xb_xcc_id(); b.st = st;
    if (threadIdx.x == 0) (void)xb_add(&bar[XB_XCNT(b.x)], 1u);
    return b;
}
__device__ __forceinline__ void xcd_barrier_complete(unsigned* bar, unsigned x, unsigned& nloc, unsigned& nx) {
    const unsigned G = gridDim.x * gridDim.y * gridDim.z;
    unsigned sum, cnt, mine, sp = 0u;
    for (;;) {
        sum = 0u; cnt = 0u; mine = 0u;
#pragma unroll
        for (unsigned j = 0; j < 16; ++j) { const unsigned c = xb_ld(&bar[XB_XCNT(j)]); sum += c; cnt += (c > 0u) ? 1u : 0u; mine = (j == x) ? c : mine; }
        if (sum == G) break;
        __builtin_amdgcn_s_sleep(1);
        if ((++sp & 255u) == 0u) { if (xb_ld(&bar[XB_TMO])) break; if (sp > XB_SPIN_CAP) { atomicAdd(&bar[XB_TMO], 1u); break; } }
    }
    nloc = mine > 0u ? mine : 1u; nx = cnt > 0u ? cnt : 1u;
}

__device__ __forceinline__ void xcd_barrier(const XcdBarrier& b) {
    asm volatile("s_waitcnt vmcnt(0)" ::: "memory");
    __syncthreads();
    if (threadIdx.x == 0) {
        unsigned* bar = b.bar;
        __builtin_amdgcn_s_waitcnt(0);
        unsigned nloc = b.st[0], nx = b.st[1];
        if (nloc == 0u) { xcd_barrier_complete(bar, b.x, nloc, nx); b.st[0] = nloc; b.st[1] = nx; }
        const unsigned old = xb_add(&bar[XB_XSUB(b.x)], 1u);
        const unsigned gen = old / nloc;
        if (old + 1u == (gen + 1u) * nloc) {
            __builtin_amdgcn_fence(__ATOMIC_RELEASE, "agent");
            asm volatile("s_waitcnt vmcnt(0)" ::: "memory");
            const unsigned og = xb_add(&bar[XB_TOP], 1u);
            const unsigned tg = og / nx;
            if (og + 1u == (tg + 1u) * nx) xb_add(&bar[XB_TOPGEN], 1u);
            else XB_SPIN(xb_ld(&bar[XB_TOPGEN]) == tg, bar);
            __builtin_amdgcn_fence(__ATOMIC_ACQUIRE, "agent");
            xb_add(&bar[XB_XGEN(b.x)], 1u);
            asm volatile("s_waitcnt vmcnt(0)" ::: "memory");
        } else {
            XB_SPIN(xb_ld(&bar[XB_XGEN(b.x)]) == gen, bar);
            __builtin_amdgcn_fence(__ATOMIC_ACQUIRE, "agent");
            asm volatile("s_waitcnt vmcnt(0)" ::: "memory");
        }
    }
    __syncthreads();
}

#ifndef PHMASK
#define PHMASK 0x1ff
#endif
constexpr int NPHASE = 9;
#ifndef FAST_GEMM
#define FAST_GEMM 7
#endif
#ifndef FAST_ATTN
#define FAST_ATTN 1
#endif
#ifndef DUPMASK
#define DUPMASK 0
#endif
#define REP(bit) for (int rep_ = 0; rep_ < ((DUPMASK >> (bit)) & 1) + 1; ++rep_)
constexpr int LDS_BYTES = 155648, LDS_MISC = LDS_BYTES - 64;
static_assert(AT_END <= LDS_MISC && pg8::STAGE_BYTES <= LDS_BYTES, "LDS map");
__global__ void __launch_bounds__(NTHREADS, 2) hymba_fwd(Params P) {
    extern __shared__ __attribute__((aligned(16))) unsigned char lds[];
    cg::grid_group grid = cg::this_grid();
    const int tid = threadIdx.x, lane = tid & 63, wave = __builtin_amdgcn_readfirstlane(tid >> 6);
    const int bid = blockIdx.x, nb = gridDim.x;
    const int gw = bid * NWAVES + wave, ngw = nb * NWAVES;
    unsigned char* ws = P.ws;
    const int lo = P.ph_lo, hi = P.ph_hi;
    volatile XLAS unsigned* misc = (volatile XLAS unsigned*)((XLAS unsigned char*)lds + LDS_MISC);
    if (tid < 16) misc[tid] = 0u;
    __syncthreads();
    XcdBarrier bar = xcd_barrier_post((unsigned*)(ws + WS_CTL), misc);
    if (hi < 0) grid.sync();
#define PH_BEGIN(k) if (lo <= (k) && (k) < hi) { if ((k) > lo) xcd_barrier(bar);
#define PH_END }
#if PHMASK & (1 << 0)
        PH_BEGIN(0) REP(0) phase0(P, lds, tid, lane, wave, bid, nb); PH_END
#endif
#if PHMASK & (1 << 1)
        PH_BEGIN(1) {
#if FAST_GEMM & 1
            REP(1) {
            pg8::Gemm g{(const pg8::bf16_t*)(ws + WS_XH), (const pg8::bf16_t*)(ws + WS_WIN), M, NP1, 1024}; pg8::StaticOrder S; S.init(M, NP1, nb, bid);
            pg8::gemm_phase<EpiProjF, pg8::StaticOrder, true, true>((PG8_LAS unsigned char*)lds, g, S, EpiProjF{ws});
            }
#else
            GemmN g{(const h16*)(ws + WS_XH), 1024, (const h16*)(ws + WS_WIN), 1024, 1024, nullptr, 0, nullptr, 0, 0, M, NP1, 0};
            gemm_naive<false>(g, EpiProj{ws}, gw, ngw, lane);
#endif
        } PH_END
#endif
#if PHMASK & (1 << 2)
        PH_BEGIN(2) {
            normrope_rows(P, gw, ngw, lane);
            REP(2) rglru_local(P, lds, tid, lane, wave, bid, nb);
            REP(3) for (int w = 0; w < 2; ++w) {
                GemmN g{(const h16*)(ws + (w ? WS_VCT : WS_KCT)), 1024, (const h16*)(ws + (w ? WS_W1V : WS_W1K)), CMPK, CMPK, nullptr, 0, nullptr, 0, 0, 4096, CMPH, 0};
                gemm_naive<false>(g, EpiCmpA{(h16*)(ws + WS_H1) + (size_t)w * 4096 * CMPH, (const float*)(ws + WS_B1) + w * 256}, gw, ngw, lane);
            }
        } PH_END
#endif
#if PHMASK & (1 << 3)
        PH_BEGIN(3) {
            for (int w = 0; w < 2; ++w) {
                GemmN g{(const h16*)(ws + WS_H1) + (size_t)w * 4096 * CMPH, CMPH, (const h16*)(ws + (w ? WS_W2V : WS_W2K)), CMPH, CMPH, nullptr, 0, nullptr, 0, 0, 4096, HD, 0};
                gemm_naive<false>(g, EpiCmpB{(float*)(ws + WS_CRAW) + (size_t)w * 4096 * HD}, gw, ngw, lane);
            }
        } PH_END
#endif
#if PHMASK & (1 << 4)
        PH_BEGIN(4) compress_finish(P, gw, ngw, lane); PH_END
#endif
#if PHMASK & (1 << 5)
        PH_BEGIN(5) {
            REP(5) rglru_fixup(P, gw, ngw, lane);
#if FAST_ATTN
            REP(6) attn_mfma_phase(P, lds, tid, lane, wave, bid, nb);
#else
            attn_naive(P, lds, lane, wave, gw, ngw);
#endif
        } PH_END
#endif
#if PHMASK & (1 << 6)
        PH_BEGIN(6) {
#if FAST_GEMM & 2
            REP(7) {
            pg8::Gemm g{(const pg8::bf16_t*)(ws + WS_Y), (const pg8::bf16_t*)(ws + WS_WOUT), M, D, 1024}; pg8::StaticOrder S; S.init(M, D, nb, bid);
            pg8::gemm_phase<EpiOutF, pg8::StaticOrder, true, true>((PG8_LAS unsigned char*)lds, g, S,
                EpiOutF{P.x, P.out, (h16*)(ws + WS_X1H), (const float*)(ws + WS_SSR), (const float*)(ws + WS_SSA), (float*)(ws + WS_SS2P)});
            }
#else
            const h16* Y = (const h16*)(ws + WS_Y); const h16* W = (const h16*)(ws + WS_WOUT);
            GemmN g{Y, 1024, W, 1024, 512, Y + 512, 1024, W + 512, 1024, 512, M, D, 0};
            gemm_naive<true>(g, EpiOut{P.x, P.out, (h16*)(ws + WS_X1H), (const float*)(ws + WS_SSR), (const float*)(ws + WS_SSA)}, gw, ngw, lane);
#endif
        } PH_END
#endif
#if PHMASK & (1 << 7)
        PH_BEGIN(7) {
#if FAST_GEMM & 2
            REP(8) {
            pg8::Gemm g{(const pg8::bf16_t*)(ws + WS_X1H), (const pg8::bf16_t*)(ws + WS_WGU), M, 2 * DFF, 1024}; pg8::StaticOrder S; S.init(M, 2 * DFF, nb, bid);
            pg8::gemm_phase<EpiGUF, pg8::StaticOrder, true, true>((PG8_LAS unsigned char*)lds, g, S, EpiGUF{(h16*)(ws + WS_HM), (const float*)(ws + WS_SS2P)});
            }
#else
            const h16* A = (const h16*)(ws + WS_X1H); const h16* W = (const h16*)(ws + WS_WGU);
            GemmN g{A, 1024, W, 1024, 1024, A, 1024, W, 1024, 1024, M, DFF, 1};
            gemm_naive<true>(g, EpiGU{(h16*)(ws + WS_HM), (const float*)(ws + WS_RSTD2)}, gw, ngw, lane);
#endif
        } PH_END
#endif
#if PHMASK & (1 << 8)
        PH_BEGIN(8) {
#if FAST_GEMM & 4
            pg8::Gemm g{(const pg8::bf16_t*)(ws + WS_HM), (const pg8::bf16_t*)(ws + WS_WD), M, D, DFF}; pg8::StaticOrder S; S.init(M, D, nb, bid);
            pg8::gemm_phase<EpiDownF, pg8::StaticOrder, true, true>((PG8_LAS unsigned char*)lds, g, S, EpiDownF{P.out});
#else
            GemmN g{(const h16*)(ws + WS_HM), DFF, (const h16*)(ws + WS_WD), DFF, DFF, nullptr, 0, nullptr, 0, 0, M, D, 0};
            gemm_naive<false>(g, EpiDown{P.out}, gw, ngw, lane);
#endif
        } PH_END
#endif
}

#ifndef N_LAUNCH_PER_PHASE
#define N_LAUNCH_PER_PHASE 0
#endif
extern "C" void kernel_launch(void* const* d_in, const int* in_sizes, int n_in, void* d_out, int out_size, void* d_ws, size_t ws_size, hipStream_t stream) {
    static int grid = 0;
    if (grid == 0) {
        if (n_in != 25 || in_sizes[0] != M * D || out_size != M * D || ws_size < WS_END) {
            fprintf(stderr, "kernel_launch: unexpected problem (n_in %d, in0 %d, out %d, ws %zu)\n", n_in, n_in > 0 ? in_sizes[0] : -1, out_size, ws_size); grid = -1; return; }
        int dev = 0, cus = 0, per_cu = 0;
        hipGetDevice(&dev);
        hipDeviceGetAttribute(&cus, hipDeviceAttributeMultiprocessorCount, dev);
        hipFuncSetAttribute((const void*)hymba_fwd, hipFuncAttributeMaxDynamicSharedMemorySize, LDS_BYTES);
        hipOccupancyMaxActiveBlocksPerMultiprocessor(&per_cu, (const void*)hymba_fwd, NTHREADS, LDS_BYTES);
        if (per_cu < 1) { fprintf(stderr, "kernel_launch: occupancy query says %d blocks per CU\n", per_cu); grid = -1; return; }
        grid = cus;
    }
    if (grid < 0) return;
    if (hipMemsetAsync((char*)d_ws + WS_CTL, 0, CTL_BYTES, stream) != hipSuccess) { fprintf(stderr, "kernel_launch: memset failed\n"); return; }
    Params p{};
    const float** pf = (const float**)&p;
    for (int i = 0; i < 25; ++i) pf[i] = (const float*)d_in[i];
    p.out = (float*)d_out; p.ws = (unsigned char*)d_ws;
#if N_LAUNCH_PER_PHASE
    for (int ph = 0; ph < NPHASE; ++ph) {
        p.ph_lo = ph; p.ph_hi = ph + 1;
        void* args[] = {&p};
        hipError_t e = hipLaunchCooperativeKernel((const void*)hymba_fwd, dim3(grid), dim3(NTHREADS), args, LDS_BYTES, stream);
        if (e != hipSuccess) { fprintf(stderr, "launch failed: %s\n", hipGetErrorString(e)); return; }
    }
#else
    p.ph_lo = 0; p.ph_hi = NPHASE;
    void* args[] = {&p};
    hipError_t e = hipLaunchCooperativeKernel((const void*)hymba_fwd, dim3(grid), dim3(NTHREADS), args, LDS_BYTES, stream);
    if (e != hipSuccess) fprintf(stderr, "launch failed: %s\n", hipGetErrorString(e));
#endif
}
```

```cpp
#include <hip/hip_runtime.h>
#include <hip/hip_cooperative_groups.h>
#include <cstdio>
#include <cstdint>
namespace cg = cooperative_groups;

typedef _Float16 h16;
typedef _Float16 h16x8 __attribute__((ext_vector_type(8)));
typedef _Float16 h16x4 __attribute__((ext_vector_type(4)));
typedef _Float16 h16x2 __attribute__((ext_vector_type(2)));
typedef float f32x4 __attribute__((ext_vector_type(4)));
typedef float f32x2 __attribute__((ext_vector_type(2)));
typedef unsigned u32x4 __attribute__((ext_vector_type(4)));
typedef unsigned u32x2 __attribute__((ext_vector_type(2)));

constexpr int BATCH = 8, T = 4096, M = BATCH * T, D = 1024;
constexpr int DRNN = 512, NBLK = 8, DATT = 512, NH = 8, NKV = 2, HPG = 4, HD = 64;
constexpr int DIN = 2328, NP1 = 2560;
constexpr int DFF = 2816;
constexpr int NCMP = 255, NCP = 256;
constexpr int CMPK = 2048, CMPH = 256;
constexpr float EPS = 1e-6f;
constexpr float C2 = 0.125f * 1.4426950408889634f;
constexpr int NTHREADS = 512, NWAVES = 8;

constexpr size_t MiB = 1u << 20;
constexpr size_t WS_WIN = 0;
constexpr size_t WS_WOUT = 6 * MiB;
constexpr size_t WS_WGU = 8 * MiB;
constexpr size_t WS_WD = 20 * MiB;
constexpr size_t WS_W1K = 26 * MiB, WS_W1V = 27 * MiB;
constexpr size_t WS_W2K = 28 * MiB, WS_W2V = 28 * MiB + 65536;
constexpr size_t WS_B1 = 28 * MiB + 131072;
constexpr size_t WS_RSTD1 = 29 * MiB;
constexpr size_t WS_RSTD2 = 29 * MiB + 262144;
constexpr size_t WS_SS2P = 456 * MiB;
constexpr size_t WS_ROPE = 30 * MiB;
constexpr size_t WS_XH = 32 * MiB;
constexpr size_t WS_XR = 96 * MiB;
constexpr size_t WS_GRG = 128 * MiB;
constexpr size_t WS_Q = 160 * MiB;
constexpr size_t WS_HL = 192 * MiB;
constexpr size_t WS_HM = 32 * MiB;
constexpr size_t WS_AC = 224 * MiB;
constexpr size_t WS_KCT = 256 * MiB;
constexpr size_t WS_VCT = 265 * MiB;
constexpr size_t WS_KS = 274 * MiB, WS_VS = 282 * MiB, WS_KW = 290 * MiB, WS_VW = 298 * MiB;
constexpr size_t WS_GATE = 306 * MiB;
constexpr size_t WS_H1 = 310 * MiB;
constexpr size_t WS_CRAW = 314 * MiB;
constexpr size_t WS_KCC = 316 * MiB, WS_VCC = 317 * MiB;
constexpr size_t WS_AGG = 318 * MiB;
constexpr size_t WS_SSR = 326 * MiB, WS_SSA = 327 * MiB;
constexpr size_t WS_Y = 328 * MiB;
constexpr size_t WS_X1H = 392 * MiB;
constexpr size_t WS_CTL = 458 * MiB;
constexpr size_t CTL_BYTES = 16384;
constexpr size_t WS_END = 459 * MiB;

#define LDS_WAIT() asm volatile("s_waitcnt lgkmcnt(0)" ::: "memory")
#define LAS3 __attribute__((address_space(3)))
__device__ __forceinline__ float wave_sum(float v) {
#pragma unroll
    for (int o = 1; o < 64; o <<= 1) v += __shfl_xor(v, o);
    return v;
}
__device__ __forceinline__ float wave_max(float v) {
#pragma unroll
    for (int o = 1; o < 64; o <<= 1) v = fmaxf(v, __shfl_xor(v, o));
    return v;
}
__device__ __forceinline__ float gelu_tanh(float x) {
    const float u = 0.7978845608028654f * (x + 0.044715f * x * x * x);
    return 0.5f * x * (1.0f + tanhf(u));
}
__device__ __forceinline__ float sigmoidf_(float x) { return 1.0f / (1.0f + __expf(-x)); }

struct Params {
    const float* x; const int* pos; const float* attn_norm_w; const float* w_in; const float* conv_w; const float* conv_b;
    const float* gate_a_w; const float* gate_a_b; const float* gate_x_w; const float* gate_x_b; const float* lru_lambda;
    const float* q_norm_w; const float* k_norm_w; const float* cmp_pos; const float* cmp_k_w1; const float* cmp_k_w2;
    const float* cmp_v_w1; const float* cmp_v_w2; const float* rnn_out_norm_w; const float* attn_out_norm_w; const float* w_out;
    const float* ffn_norm_w; const float* w_gate; const float* w_up; const float* w_down;
    float* out; unsigned char* ws; int ph_lo, ph_hi;
};

__device__ __forceinline__ void p0_transpose_item(const float* W, int K, int N, const float* s0, const float* s1, int ksplit,
                                                  h16* WT, int ldt, int mode, int nblk, float* scr, int item, int lane) {
    const int kb = item / nblk, nb = item % nblk, k0 = 64 * kb, n0 = 32 * nb;
#pragma unroll 8
    for (int i = 0; i < 32; ++i) {
        const int kk = 2 * i + (lane >> 5), n = n0 + (lane & 31), k = k0 + kk;
        float v = 0.f;
        if (n < N) { v = W[(size_t)k * N + n]; if (s0) v *= (k < ksplit) ? s0[k] : s1[k - ksplit]; }
        scr[kk * 33 + (lane & 31)] = v;
    }
    LDS_WAIT();
    const int c = lane & 7;
#pragma unroll
    for (int j = 0; j < 4; ++j) {
        const int nl = (lane >> 3) + 8 * j, n = n0 + nl;
        const float* s = scr + (8 * c) * 33 + nl;
        h16x8 o;
#pragma unroll
        for (int e = 0; e < 8; ++e) o[e] = (h16)s[e * 33];
        int orow = n;
        if (mode == 1) orow = (n >> 7) * 256 + (n & 127);
        else if (mode == 2) orow = (n >> 7) * 256 + (n & 127) + 128;
        *(h16x8*)(WT + (size_t)orow * ldt + k0 + 8 * c) = o;
    }
    LDS_WAIT();
}

__device__ __forceinline__ void phase0(const Params& P, unsigned char* lds, int tid, int lane, int wave, int bid, int nb) {
    unsigned char* ws = P.ws;
    float* scr = (float*)lds + wave * (64 * 33);
    const int gw = bid * NWAVES + wave, ngw = nb * NWAVES;
    constexpr int I_IN = 16 * 80, I_OUT = 16 * 32, I_G = 16 * 88, I_U = 16 * 88, I_D = 44 * 32, I_C1 = 32 * 8, I_C2 = 4 * 2;
    constexpr int NIT = I_IN + I_OUT + I_G + I_U + I_D + 2 * I_C1 + 2 * I_C2;
    for (int it = gw; it < NIT; it += ngw) {
        int r = it;
        const float* W; int K, N; const float* s0 = nullptr; const float* s1 = nullptr; int ksplit = 0; size_t wo; int ldt, mode = 0, nblk;
        if (r < I_IN) { W = P.w_in; K = 1024; N = DIN; s0 = P.attn_norm_w; s1 = P.attn_norm_w; ksplit = 1024; wo = WS_WIN; ldt = 1024; nblk = 80; }
        else if ((r -= I_IN) < I_OUT) { W = P.w_out; K = 1024; N = 1024; s0 = P.rnn_out_norm_w; s1 = P.attn_out_norm_w; ksplit = 512; wo = WS_WOUT; ldt = 1024; nblk = 32; }
        else if ((r -= I_OUT) < I_G) { W = P.w_gate; K = 1024; N = DFF; s0 = P.ffn_norm_w; s1 = P.ffn_norm_w; ksplit = 1024; wo = WS_WGU; ldt = 1024; mode = 1; nblk = 88; }
        else if ((r -= I_G) < I_U) { W = P.w_up; K = 1024; N = DFF; s0 = P.ffn_norm_w; s1 = P.ffn_norm_w; ksplit = 1024; wo = WS_WGU; ldt = 1024; mode = 2; nblk = 88; }
        else if ((r -= I_U) < I_D) { W = P.w_down; K = DFF; N = 1024; wo = WS_WD; ldt = DFF; nblk = 32; }
        else if ((r -= I_D) < I_C1) { W = P.cmp_k_w1; K = CMPK; N = CMPH; wo = WS_W1K; ldt = CMPK; nblk = 8; }
        else if ((r -= I_C1) < I_C1) { W = P.cmp_v_w1; K = CMPK; N = CMPH; wo = WS_W1V; ldt = CMPK; nblk = 8; }
        else if ((r -= I_C1) < I_C2) { W = P.cmp_k_w2; K = CMPH; N = HD; wo = WS_W2K; ldt = CMPH; nblk = 2; }
        else { r -= I_C2; W = P.cmp_v_w2; K = CMPH; N = HD; wo = WS_W2V; ldt = CMPH; nblk = 2; }
        p0_transpose_item(W, K, N, s0, s1, ksplit, (h16*)(ws + wo), ldt, mode, nblk, scr, r, lane);
    }
    h16* XH = (h16*)(ws + WS_XH); float* RSTD1 = (float*)(ws + WS_RSTD1);
    for (int m = gw; m < M; m += ngw) {
        const f32x4* xr = (const f32x4*)(P.x + (size_t)m * D) + lane;
        f32x4 v[4]; float s = 0.f;
#pragma unroll
        for (int j = 0; j < 4; ++j) { v[j] = xr[64 * j]; s += (v[j].x * v[j].x + v[j].y * v[j].y) + (v[j].z * v[j].z + v[j].w * v[j].w); }
        s = wave_sum(s);
        if (lane == 0) RSTD1[m] = 1.0f / sqrtf(s * (1.0f / D) + EPS);
        h16x4* o = (h16x4*)(XH + (size_t)m * D) + lane;
#pragma unroll
        for (int j = 0; j < 4; ++j) { h16x4 h; h.x = (h16)v[j].x; h.y = (h16)v[j].y; h.z = (h16)v[j].z; h.w = (h16)v[j].w; o[64 * j] = h; }
    }
    float* ROPE = (float*)(ws + WS_ROPE);
    for (int e = bid * NTHREADS + tid; e < M * 8; e += nb * NTHREADS) {
        const int m = e >> 3, i = e & 7;
        const float inv = (float)pow(500000.0, -(double)i / 8.0);
        const float ang = (float)P.pos[m] * inv;
        ROPE[m * 16 + i] = (float)cos((double)ang);
        ROPE[m * 16 + 8 + i] = (float)sin((double)ang);
    }
    if (bid < 64) {
        const int which = bid >> 5, n = (bid & 31) * 8 + (tid & 7), ks = tid >> 3;
        const float* w1 = (which ? P.cmp_v_w1 : P.cmp_k_w1) + n; const float* cp = P.cmp_pos + ks * 32;
        float s = 0.f;
#pragma unroll
        for (int k = 0; k < 32; ++k) s += cp[k] * w1[(size_t)(ks * 32 + k) * CMPH];
        float* red = (float*)lds + NWAVES * 64 * 33;
        red[tid] = s;
        __syncthreads();
        if (tid < 8) { float a = 0.f; for (int q = 0; q < 64; ++q) a += red[q * 8 + tid]; ((float*)(ws + WS_B1))[which * 256 + (bid & 31) * 8 + tid] = a; }
        __syncthreads();
    }
    if (bid == 64 % nb) {
        h16* kp = (h16*)(ws + WS_KCT) + (size_t)16 * T * 64; h16* vp = (h16*)(ws + WS_VCT) + (size_t)16 * T * 64;
        for (int e = tid; e < 2048; e += NTHREADS) { kp[e] = (h16)0.f; vp[e] = (h16)0.f; }
    }
}

struct GemmN { const h16* A1; int lda1; const h16* B1; int ldb1; int K1; const h16* A2; int lda2; const h16* B2; int ldb2; int K2; int Mr, Nc; int bmap; };
template <bool DUAL, class Epi>
__device__ __forceinline__ void gemm_naive(const GemmN& g, const Epi& epi, int gw, int ngw, int lane) {
    const int tn = g.Nc / 64, tm = g.Mr / 64, ntile = tm * tn;
    const int fr = lane & 15, fq = lane >> 4;
    for (int tile = gw; tile < ntile; tile += ngw) {
        const int tr = tile / tn, tc = tile % tn;
        f32x4 acc1[4][4], acc2[4][4];
#pragma unroll
        for (int i = 0; i < 4; ++i)
#pragma unroll
            for (int j = 0; j < 4; ++j) { acc1[i][j] = (f32x4){0.f, 0.f, 0.f, 0.f}; acc2[i][j] = (f32x4){0.f, 0.f, 0.f, 0.f}; }
        const int bcol = tc * 64 + fr;
        const int brow0 = g.bmap ? ((bcol >> 7) * 256 + (bcol & 127)) : bcol;
        {
            const h16* ap = g.A1 + (size_t)(tr * 64 + fr) * g.lda1 + fq * 8;
            const h16* bp = g.B1 + (size_t)brow0 * g.ldb1 + fq * 8;
            for (int k0 = 0; k0 < g.K1; k0 += 32) {
                h16x8 a[4], b[4];
#pragma unroll
                for (int i = 0; i < 4; ++i) a[i] = *(const h16x8*)(ap + (size_t)i * 16 * g.lda1 + k0);
#pragma unroll
                for (int j = 0; j < 4; ++j) b[j] = *(const h16x8*)(bp + (size_t)j * 16 * g.ldb1 + k0);
#pragma unroll
                for (int i = 0; i < 4; ++i)
#pragma unroll
                    for (int j = 0; j < 4; ++j) acc1[i][j] = __builtin_amdgcn_mfma_f32_16x16x32_f16(a[i], b[j], acc1[i][j], 0, 0, 0);
            }
        }
        if (DUAL) {
            const h16* ap = g.A2 + (size_t)(tr * 64 + fr) * g.lda2 + fq * 8;
            const h16* bp = g.B2 + (size_t)(brow0 + (g.bmap ? 128 : 0)) * g.ldb2 + fq * 8;
            for (int k0 = 0; k0 < g.K2; k0 += 32) {
                h16x8 a[4], b[4];
#pragma unroll
                for (int i = 0; i < 4; ++i) a[i] = *(const h16x8*)(ap + (size_t)i * 16 * g.lda2 + k0);
#pragma unroll
                for (int j = 0; j < 4; ++j) b[j] = *(const h16x8*)(bp + (size_t)j * 16 * g.ldb2 + k0);
#pragma unroll
                for (int i = 0; i < 4; ++i)
#pragma unroll
                    for (int j = 0; j < 4; ++j) acc2[i][j] = __builtin_amdgcn_mfma_f32_16x16x32_f16(a[i], b[j], acc2[i][j], 0, 0, 0);
            }
        }
#pragma unroll
        for (int i = 0; i < 4; ++i)
#pragma unroll
            for (int j = 0; j < 4; ++j)
#pragma unroll
                for (int r = 0; r < 4; ++r) epi(tr * 64 + 16 * i + 4 * fq + r, tc * 64 + 16 * j + fr, acc1[i][j][r], DUAL ? acc2[i][j][r] : 0.f);
    }
}

struct EpiProj {
    unsigned char* ws;
    __device__ __forceinline__ void operator()(int m, int c, float v, float) const {
        v *= ((const float*)(ws + WS_RSTD1))[m];
        if (c < 512) { ((h16*)(ws + WS_XR))[(size_t)m * 512 + c] = (h16)v; return; }
        if (c < 1024) { ((h16*)(ws + WS_GRG))[(size_t)m * 512 + c - 512] = (h16)gelu_tanh(v); return; }
        if (c < 1536) { ((h16*)(ws + WS_Q))[(size_t)m * 512 + c - 1024] = (h16)v; return; }
        if (c < 2304) {
            const int idx = (c - 1536) >> 7, cc = (c - 1536) & 127, g = cc >> 6, d = cc & 63, b = m >> 12, t = m & 4095;
            const size_t off = ((size_t)(b * 2 + g) * T + t) * 64 + d;
            h16* base = (h16*)(ws + (idx == 0 ? WS_KCT : idx == 1 ? WS_VCT : idx == 2 ? WS_KS : idx == 3 ? WS_VS : idx == 4 ? WS_KW : WS_VW));
            base[off] = (h16)v; return;
        }
        if (c < DIN) ((float*)(ws + WS_GATE))[(size_t)m * 24 + c - 2304] = sigmoidf_(v);
    }
};
struct EpiCmpA {
    h16* H1; const float* b1;
    __device__ __forceinline__ void operator()(int r, int c, float v, float) const { H1[(size_t)r * CMPH + c] = (h16)gelu_tanh(v + b1[c]); }
};
struct EpiCmpB {
    float* O;
    __device__ __forceinline__ void operator()(int r, int c, float v, float) const { O[(size_t)r * HD + c] = v; }
};
struct EpiOut {
    const float* x; float* out; h16* x1h; const float* rsr; const float* ssa2;
    __device__ __forceinline__ void operator()(int m, int c, float v1, float v2) const {
        const float s1 = rsr[m], s2 = 1.0f / sqrtf((ssa2[m * 2] + ssa2[m * 2 + 1]) * (1.0f / 512.0f) + EPS);
        const float x1 = x[(size_t)m * D + c] + s1 * v1 + s2 * v2;
        out[(size_t)m * D + c] = x1; x1h[(size_t)m * D + c] = (h16)x1;
    }
};
struct EpiGU {
    h16* hm; const float* rstd2;
    __device__ __forceinline__ void operator()(int m, int c, float vg, float vu) const {
        const float r = rstd2[m], g = vg * r, u = vu * r;
        hm[(size_t)m * DFF + c] = (h16)(g * sigmoidf_(g) * u);
    }
};
struct EpiDown {
    float* out;
    __device__ __forceinline__ void operator()(int m, int c, float v, float) const { out[(size_t)m * D + c] += v; }
};

namespace pg8 {
#define PG8_LAS __attribute__((address_space(3)))
typedef unsigned short bf16_t;
typedef _Float16 bf16x8 __attribute__((ext_vector_type(8)));
typedef float f32x4 __attribute__((ext_vector_type(4)));
typedef unsigned u32x4 __attribute__((ext_vector_type(4)));
constexpr int BM = 256, BK = 64, HALF = 128, HTB = HALF * BK * 2  , STAGE_BYTES = 8 * HTB, NXCD = 8, WGM = 8;

__host__ __device__ __forceinline__ int lds_byte(int r, int c) { const int st = (r >> 4) * 2 + (c >> 5), rr = r & 15, cc = c & 31, ob = rr * 64 + cc * 2; return st * 1024 + (ob ^ (((ob >> 9) & 1) << 5)); }
__host__ __device__ __forceinline__ void stage_rc(int b, int& R, int& C) { const int st = b / 1024, sb = b % 1024, swz = sb ^ (((sb >> 9) & 1) << 5); R = (st >> 1) * 16 + swz / 64; C = (st & 1) * 32 + (swz % 64) / 2; }
__host__ __device__ __forceinline__ int perm32(int rho) { const int n = rho >> 4, i = rho & 15; return 8 * (i >> 2) + 4 * n + (i & 3); }

struct Unit { int pm, pn; };
struct Gemm { const bf16_t* A; const bf16_t* Bt; int M, N, K; };

struct StaticOrder {
    int nM, nN, nwg, G, c;
    __host__ __device__ void init(int M, int N, int G_, int c_) { nM = M / BM; nN = N / BM; nwg = nM * nN; G = G_; c = c_; }
    __host__ __device__ bool next(int i, Unit& u) const {
        const long L = (long)i * G + c; if (L >= nwg) return false;
        int wgid = (int)L; { const int q = nwg / NXCD, r = nwg % NXCD, xcd = wgid % NXCD, off = wgid / NXCD; wgid = (xcd < r ? xcd * (q + 1) : r * (q + 1) + (xcd - r) * q) + off; }
        const int nig = WGM * nN, gid = wgid / nig, fm = gid * WGM, gsz = (nM - fm) < WGM ? (nM - fm) : WGM;
        u.pm = fm + ((wgid % nig) % gsz); u.pn = (wgid % nig) / gsz; return true;
    }
    __device__ __forceinline__ void a_ready(const Unit&) const {}
    __device__ __forceinline__ void done(const Unit&) const {}
};
template <class Epi, class Sched, bool ALIGN_EPI = false, bool SP2 = false>
__device__ __forceinline__ void gemm_phase(PG8_LAS unsigned char* lds, const Gemm g, const Sched& S, const Epi& E) {
    const int tid = threadIdx.x, wid = __builtin_amdgcn_readfirstlane(tid >> 6), lane = tid & 63, wr = wid >> 2, wc = wid & 3, fr = lane & 15, fq = lane >> 4;
    const int K = g.K, nt = K / BK;
    unsigned voffA[2], voffB[2];
#pragma unroll
    for (int i = 0; i < 2; ++i) { int R, C; stage_rc(tid * 16 + i * 8192, R, C); const int Rb = Epi::PERM ? ((R & ~31) + perm32(R & 31)) : R;
        voffA[i] = (unsigned)(R * K + C) * 2u; voffB[i] = (unsigned)(Rb * K + C) * 2u; }
    const size_t kstep = (size_t)(BK * 2);
    const size_t hstep = (size_t)HALF * K * 2;
    const size_t tstep = 2 * hstep;
    const unsigned ldsw = (unsigned)wid * 1024u;
    const int aoff = lds_byte(wr * 64 + fr, fq * 8), boff = lds_byte(wc * 32 + fr, fq * 8);
#define PG8_SA(b, h) (((b) * 2 + (h)) * HTB)
#define PG8_SB(b, h) ((4 + (b) * 2 + (h)) * HTB)
#define PG8_STAGE(bufoff, gbase, voff) do { _Pragma("unroll") for (int _i = 0; _i < 2; ++_i) \
        __builtin_amdgcn_global_load_lds((const unsigned*)((const char*)(gbase) + (voff)[_i]), (PG8_LAS unsigned*)(lds + (bufoff) + ldsw + _i * 8192), 16, 0, 0); } while (0)
#define PG8_LDA(dst, b, h) do { _Pragma("unroll") for (int m = 0; m < 4; ++m) _Pragma("unroll") for (int k = 0; k < 2; ++k) dst[m][k] = *(const PG8_LAS bf16x8*)(lds + PG8_SA(b, h) + aoff + m * 2048 + k * 1024); } while (0)
#define PG8_LDB(dst, b, h) do { _Pragma("unroll") for (int n = 0; n < 2; ++n) _Pragma("unroll") for (int k = 0; k < 2; ++k) dst[n][k] = *(const PG8_LAS bf16x8*)(lds + PG8_SB(b, h) + boff + n * 2048 + k * 1024); } while (0)
#define PG8_MMA(ai, bj, At, Bt) do { __builtin_amdgcn_s_setprio(1); _Pragma("unroll") for (int m = 0; m < 4; ++m) _Pragma("unroll") for (int n = 0; n < 2; ++n) _Pragma("unroll") for (int k = 0; k < 2; ++k) \
        acc[ai][bj][m][n] = __builtin_amdgcn_mfma_f32_16x16x32_f16(Bt[n][k], At[m][k], acc[ai][bj][m][n], 0, 0, 0); __builtin_amdgcn_s_setprio(0); } while (0)
#define PG8_WAIT_V(n) asm volatile("s_waitcnt vmcnt(" #n ")" ::: "memory")
#define PG8_WAIT_L(n) asm volatile("s_waitcnt lgkmcnt(" #n ")" ::: "memory")
#define PG8_BAR __builtin_amdgcn_s_barrier()
#define PG8_SCHED __builtin_amdgcn_sched_barrier(0)
    Unit cur, nxt; int ui = 0;
    if (!S.next(0, cur)) return;
    f32x4 acc[2][2][4][2];
#pragma unroll
    for (int a = 0; a < 2; ++a)
#pragma unroll
        for (int b = 0; b < 2; ++b)
#pragma unroll
            for (int m = 0; m < 4; ++m)
#pragma unroll
                for (int n = 0; n < 2; ++n) acc[a][b][m][n] = (f32x4){0.f, 0.f, 0.f, 0.f};
    bf16x8 At[4][2], B0[2][2], B1[2][2];
    const char* cA = (const char*)g.A + (size_t)cur.pm * tstep; const char* cB = (const char*)g.Bt + (size_t)cur.pn * tstep;
    S.a_ready(cur);
    if constexpr (SP2) {
        PG8_STAGE(PG8_SB(0, 0), cB, voffB); PG8_STAGE(PG8_SB(0, 1), cB + hstep, voffB); PG8_STAGE(PG8_SA(0, 0), cA, voffA); PG8_STAGE(PG8_SA(0, 1), cA + hstep, voffA);
        if (wr == 1) PG8_BAR;
        PG8_WAIT_V(2); PG8_BAR;
        PG8_STAGE(PG8_SB(1, 0), cB + kstep, voffB); PG8_STAGE(PG8_SA(1, 0), cA + kstep, voffA); PG8_STAGE(PG8_SB(1, 1), cB + hstep + kstep, voffB);
        PG8_WAIT_V(6); PG8_BAR;
    } else {
        PG8_STAGE(PG8_SB(0, 0), cB, voffB); PG8_STAGE(PG8_SA(0, 0), cA, voffA); PG8_STAGE(PG8_SB(0, 1), cB + hstep, voffB); PG8_STAGE(PG8_SA(0, 1), cA + hstep, voffA);
        if (wr == 1) PG8_BAR;
        PG8_WAIT_V(4); PG8_BAR;
        PG8_STAGE(PG8_SB(1, 0), cB + kstep, voffB); PG8_STAGE(PG8_SA(1, 0), cA + kstep, voffA); PG8_STAGE(PG8_SB(1, 1), cB + hstep + kstep, voffB);
        PG8_WAIT_V(6); PG8_BAR;
    }
    for (;;) {
        const bool has_next = S.next(ui + 1, nxt);
        const char* nA = has_next ? (const char*)g.A + (size_t)nxt.pm * tstep : cA; const char* nB = has_next ? (const char*)g.Bt + (size_t)nxt.pn * tstep : cB;
        for (int t = 0; t < nt; t += 2) {
            const bool last = (t == nt - 2);
            const char* a1 = cA + (size_t)(t + 1) * kstep;
            const char* a2 = last ? nA : cA + (size_t)(t + 2) * kstep; const char* b2 = last ? nB : cB + (size_t)(t + 2) * kstep;
            const char* a3 = a2 + kstep; const char* b3 = b2 + kstep;
            if (last && has_next) S.a_ready(nxt);
            if constexpr (Epi::MIDK) { if (t == nt / 2) E.mid(acc, cur, wr, wc, fr, fq); }
            if constexpr (SP2) {
            PG8_LDB(B0, 0, 0); PG8_LDB(B1, 0, 1); PG8_SCHED; PG8_LDA(At, 0, 0); PG8_STAGE(PG8_SA(1, 1), a1 + hstep, voffA);
            PG8_WAIT_V(8); PG8_WAIT_L(0); PG8_BAR; PG8_MMA(0, 0, At, B0); PG8_MMA(0, 1, At, B1); PG8_BAR; PG8_SCHED;
            PG8_LDA(At, 0, 1); PG8_STAGE(PG8_SB(0, 0), b2, voffB); PG8_STAGE(PG8_SB(0, 1), b2 + hstep, voffB); PG8_STAGE(PG8_SA(0, 0), a2, voffA);
            PG8_WAIT_V(8); PG8_WAIT_L(0); PG8_BAR; PG8_MMA(1, 0, At, B0); PG8_MMA(1, 1, At, B1); PG8_BAR; PG8_SCHED;
            PG8_LDB(B0, 1, 0); PG8_LDB(B1, 1, 1); PG8_SCHED; PG8_LDA(At, 1, 0); PG8_STAGE(PG8_SA(0, 1), a2 + hstep, voffA);
            PG8_WAIT_V(8); PG8_WAIT_L(0); PG8_BAR; PG8_MMA(0, 0, At, B0); PG8_MMA(0, 1, At, B1); PG8_BAR; PG8_SCHED;
            PG8_LDA(At, 1, 1); PG8_STAGE(PG8_SB(1, 0), b3, voffB); PG8_STAGE(PG8_SB(1, 1), b3 + hstep, voffB); PG8_STAGE(PG8_SA(1, 0), a3, voffA);
            PG8_WAIT_V(8); PG8_WAIT_L(0); PG8_BAR; PG8_MMA(1, 0, At, B0); PG8_MMA(1, 1, At, B1); PG8_BAR; PG8_SCHED;
            } else {
            PG8_LDB(B0, 0, 0); PG8_SCHED; PG8_LDA(At, 0, 0); PG8_STAGE(PG8_SA(1, 1), a1 + hstep, voffA);
            PG8_WAIT_L(8); PG8_BAR; PG8_WAIT_L(0); PG8_MMA(0, 0, At, B0); PG8_BAR; PG8_SCHED;
            PG8_LDB(B1, 0, 1); PG8_STAGE(PG8_SB(0, 0), b2, voffB);
            PG8_BAR; PG8_WAIT_L(0); PG8_MMA(0, 1, At, B1); PG8_BAR;
            PG8_LDA(At, 0, 1); PG8_STAGE(PG8_SA(0, 0), a2, voffA);
            PG8_BAR; PG8_WAIT_L(0); PG8_MMA(1, 0, At, B0); PG8_BAR; PG8_SCHED;
            PG8_STAGE(PG8_SB(0, 1), b2 + hstep, voffB);
            PG8_WAIT_V(6); PG8_BAR; PG8_MMA(1, 1, At, B1); PG8_BAR;
            PG8_LDB(B0, 1, 0); PG8_SCHED; PG8_LDA(At, 1, 0); PG8_STAGE(PG8_SA(0, 1), a2 + hstep, voffA);
            PG8_WAIT_L(8); PG8_BAR; PG8_WAIT_L(0); PG8_MMA(0, 0, At, B0); PG8_BAR; PG8_SCHED;
            PG8_LDB(B1, 1, 1); PG8_STAGE(PG8_SB(1, 0), b3, voffB);
            PG8_BAR; PG8_WAIT_L(0); PG8_MMA(0, 1, At, B1); PG8_BAR;
            PG8_LDA(At, 1, 1); PG8_STAGE(PG8_SA(1, 0), a3, voffA);
            PG8_BAR; PG8_WAIT_L(0); PG8_MMA(1, 0, At, B0); PG8_BAR; PG8_SCHED;
            PG8_STAGE(PG8_SB(1, 1), b3 + hstep, voffB);
            PG8_WAIT_V(6); PG8_BAR; PG8_MMA(1, 1, At, B1); PG8_BAR;
            }
        }
        if constexpr (ALIGN_EPI) { if (wr == 0) PG8_BAR; }
        if constexpr (!Epi::AFTER_DRAIN) { E(acc, cur, wr, wc, fr, fq); S.done(cur); }
        if (!has_next) break;
#pragma unroll
        for (int a = 0; a < 2; ++a)
#pragma unroll
            for (int b = 0; b < 2; ++b)
#pragma unroll
                for (int m = 0; m < 4; ++m)
#pragma unroll
                    for (int n = 0; n < 2; ++n) acc[a][b][m][n] = (f32x4){0.f, 0.f, 0.f, 0.f};
        cur = nxt; cA = nA; cB = nB; ++ui;
        if constexpr (ALIGN_EPI) { if (wr == 1) PG8_BAR; }
    }
    PG8_WAIT_V(0);
    if constexpr (!ALIGN_EPI) { if (wr == 0) PG8_BAR; }
    PG8_BAR;
    if constexpr (Epi::AFTER_DRAIN) { E.fused(acc, cur, wr, wc, fr, fq, lds, wid, lane); S.done(cur); }
#undef PG8_SA
#undef PG8_SB
#undef PG8_STAGE
#undef PG8_LDA
#undef PG8_LDB
#undef PG8_MMA
#undef PG8_WAIT_V
#undef PG8_WAIT_L
#undef PG8_BAR
#undef PG8_SCHED
}
}

__device__ __forceinline__ float fsigmoid(float x) { return __builtin_amdgcn_rcpf(1.0f + __builtin_amdgcn_exp2f(-1.4426950408889634f * x)); }
__device__ __forceinline__ float fgelu_tanh(float x) { const float u2 = 1.5957691216057308f * (x + 0.044715f * x * x * x); return x * fsigmoid(u2); }
__device__ __forceinline__ h16x8 pack8(const f32x4 a, const f32x4 b) {
    h16x8 o; o[0] = (h16)a[0]; o[1] = (h16)a[1]; o[2] = (h16)a[2]; o[3] = (h16)a[3]; o[4] = (h16)b[0]; o[5] = (h16)b[1]; o[6] = (h16)b[2]; o[7] = (h16)b[3]; return o;
}
struct EpiProjF {
    static constexpr bool PERM = true, AFTER_DRAIN = false, MIDK = false;
    unsigned char* ws;
    __device__ __forceinline__ void operator()(const f32x4 (&acc)[2][2][4][2], const pg8::Unit& u, int wr, int wc, int fr, int fq) const {
        const float* RSTD1 = (const float*)(ws + WS_RSTD1);
        const int row0 = u.pm * 256 + wr * 64 + fr, pn = u.pn, c8 = wc * 32 + 8 * fq;
#pragma unroll
        for (int ai = 0; ai < 2; ++ai)
#pragma unroll
            for (int m = 0; m < 4; ++m) {
                const int row = row0 + ai * 128 + m * 16; const float rs = RSTD1[row];
#pragma unroll
                for (int bj = 0; bj < 2; ++bj) {
                    f32x4 v0 = acc[ai][bj][m][0] * rs, v1 = acc[ai][bj][m][1] * rs;
                    const int cb = bj * 128 + c8;
                    if (pn < 2) { *(h16x8*)((h16*)(ws + WS_XR) + (size_t)row * 512 + pn * 256 + cb) = pack8(v0, v1); }
                    else if (pn < 4) {
#pragma unroll
                        for (int e = 0; e < 4; ++e) { v0[e] = fgelu_tanh(v0[e]); v1[e] = fgelu_tanh(v1[e]); }
                        *(h16x8*)((h16*)(ws + WS_GRG) + (size_t)row * 512 + (pn - 2) * 256 + cb) = pack8(v0, v1); }
                    else if (pn < 6) { *(h16x8*)((h16*)(ws + WS_Q) + (size_t)row * 512 + (pn - 4) * 256 + cb) = pack8(v0, v1); }
                    else if (pn < 9) {
                        const int idx = 2 * (pn - 6) + bj, g = c8 >> 6, d = c8 & 63, b = row >> 12, t = row & 4095;
                        h16* base = (h16*)(ws + (idx == 0 ? WS_KCT : idx == 1 ? WS_VCT : idx == 2 ? WS_KS : idx == 3 ? WS_VS : idx == 4 ? WS_KW : WS_VW));
                        *(h16x8*)(base + ((size_t)(b * 2 + g) * T + t) * 64 + d) = pack8(v0, v1); }
                    else if (bj == 0 && c8 < 24) {
                        float* gp = (float*)(ws + WS_GATE) + (size_t)row * 24 + c8;
#pragma unroll
                        for (int e = 0; e < 4; ++e) { v0[e] = fsigmoid(v0[e]); v1[e] = fsigmoid(v1[e]); }
                        *(f32x4*)gp = v0; *(f32x4*)(gp + 4) = v1; }
                }
            }
    }
};
struct EpiOutF {
    static constexpr bool PERM = false, AFTER_DRAIN = false, MIDK = true;
    const float* x; float* out; h16* x1h; const float* rsr; const float* ssa2; float* ss2p;
    __device__ __forceinline__ float rsa_of(int row) const { const f32x2 a = *(const f32x2*)(ssa2 + (size_t)row * 2); return 1.0f / sqrtf((a[0] + a[1]) * (1.0f / 512.0f) + EPS); }
    __device__ __forceinline__ void mid(f32x4 (&acc)[2][2][4][2], const pg8::Unit& u, int wr, int wc, int fr, int fq) const {
        int row0 = u.pm * 256 + wr * 64 + fr; asm volatile("" : "+v"(row0));
#pragma unroll
        for (int ai = 0; ai < 2; ++ai)
#pragma unroll
            for (int m = 0; m < 4; ++m) { const int row = row0 + ai * 128 + m * 16; const float ratio = rsr[row] / rsa_of(row);
#pragma unroll
                for (int bj = 0; bj < 2; ++bj)
#pragma unroll
                    for (int n = 0; n < 2; ++n) acc[ai][bj][m][n] *= ratio; }
    }
    __device__ __forceinline__ void operator()(const f32x4 (&acc)[2][2][4][2], const pg8::Unit& u, int wr, int wc, int fr, int fq) const {
        const int row0 = u.pm * 256 + wr * 64 + fr, col0 = u.pn * 256 + wc * 32 + 4 * fq;
#pragma unroll
        for (int ai = 0; ai < 2; ++ai)
#pragma unroll
            for (int m = 0; m < 4; ++m) { const int row = row0 + ai * 128 + m * 16; const float s2 = rsa_of(row); float ss = 0.f;
#pragma unroll
                for (int bj = 0; bj < 2; ++bj)
#pragma unroll
                    for (int n = 0; n < 2; ++n) { const size_t off = (size_t)row * D + col0 + bj * 128 + n * 16;
                        const f32x4 v = *(const f32x4*)(x + off) + acc[ai][bj][m][n] * s2;
                        *(f32x4*)(out + off) = v; h16x4 h; h[0] = (h16)v[0]; h[1] = (h16)v[1]; h[2] = (h16)v[2]; h[3] = (h16)v[3]; *(h16x4*)(x1h + off) = h;
                        ss += (v[0] * v[0] + v[1] * v[1]) + (v[2] * v[2] + v[3] * v[3]); }
                ss += __shfl_xor(ss, 16); ss += __shfl_xor(ss, 32);
                if (fq == 0) ss2p[(size_t)row * 16 + u.pn * 4 + wc] = ss;
                if (m & 1) asm volatile("" ::: "memory"); }
    }
};
struct EpiGUF {
    static constexpr bool PERM = true, AFTER_DRAIN = false, MIDK = false;
    h16* hm; const float* ss2p;
    __device__ __forceinline__ void operator()(const f32x4 (&acc)[2][2][4][2], const pg8::Unit& u, int wr, int wc, int fr, int fq) const {
        const int row0 = u.pm * 256 + wr * 64 + fr, col = u.pn * 128 + wc * 32 + 8 * fq;
#pragma unroll
        for (int ai = 0; ai < 2; ++ai)
#pragma unroll
            for (int m = 0; m < 4; ++m) { const int row = row0 + ai * 128 + m * 16; const f32x4* sp = (const f32x4*)(ss2p + (size_t)row * 16);
                const f32x4 s0 = sp[0], s1 = sp[1], s2 = sp[2], s3 = sp[3];
                const float tot = ((s0[0] + s0[1]) + (s0[2] + s0[3])) + ((s1[0] + s1[1]) + (s1[2] + s1[3])) + ((s2[0] + s2[1]) + (s2[2] + s2[3])) + ((s3[0] + s3[1]) + (s3[2] + s3[3]));
                const float rs = 1.0f / sqrtf(tot * (1.0f / D) + EPS);
                f32x4 o[2];
#pragma unroll
                for (int n = 0; n < 2; ++n) { const f32x4 g = acc[ai][0][m][n] * rs, uu = acc[ai][1][m][n] * rs;
#pragma unroll
                    for (int e = 0; e < 4; ++e) o[n][e] = g[e] * fsigmoid(g[e]) * uu[e]; }
                *(h16x8*)(hm + (size_t)row * DFF + col) = pack8(o[0], o[1]); }
    }
};
struct EpiDownF {
    static constexpr bool PERM = false, AFTER_DRAIN = false, MIDK = false;
    float* out;
    __device__ __forceinline__ void operator()(const f32x4 (&acc)[2][2][4][2], const pg8::Unit& u, int wr, int wc, int fr, int fq) const {
        const int row0 = u.pm * 256 + wr * 64 + fr, col0 = u.pn * 256 + wc * 32 + 4 * fq;
#pragma unroll
        for (int ai = 0; ai < 2; ++ai)
#pragma unroll
            for (int m = 0; m < 4; ++m) { const int row = row0 + ai * 128 + m * 16;
#pragma unroll
                for (int bj = 0; bj < 2; ++bj)
#pragma unroll
                    for (int n = 0; n < 2; ++n) { float* p = out + (size_t)row * D + col0 + bj * 128 + n * 16; *(f32x4*)p = *(const f32x4*)p + acc[ai][bj][m][n]; } }
    }
};

__device__ __forceinline__ void normrope_rows(const Params& P, int gw, int ngw, int lane) {
    unsigned char* ws = P.ws;
    const float* ROPE = (const float*)(ws + WS_ROPE);
    const int sub = lane & 7;
    for (int m = gw; m < M; m += ngw) {
        const int b = m >> 12, t = m & 4095;
        float cs[8], sn[8];
#pragma unroll
        for (int i = 0; i < 8; ++i) { cs[i] = ROPE[m * 16 + i]; sn[i] = ROPE[m * 16 + 8 + i]; }
#pragma unroll
        for (int which = 0; which < 3; ++which) {
            h16* p; const float* nw; float scale;
            bool act = true;
            if (which == 0) { p = (h16*)(ws + WS_Q) + (size_t)m * 512 + (lane >> 3) * 64 + sub * 8; nw = P.q_norm_w; scale = C2; }
            else { act = lane < 16; const int g = (lane >> 3) & 1; p = (h16*)(ws + (which == 1 ? WS_KS : WS_KW)) + ((size_t)(b * 2 + g) * T + t) * 64 + sub * 8; nw = P.k_norm_w; scale = 1.0f; }
            float v[8]; float ss = 0.f;
            if (act) { const h16x8 h = *(const h16x8*)p;
#pragma unroll
                for (int e = 0; e < 8; ++e) { v[e] = (float)h[e]; ss += v[e] * v[e]; } }
            else {
#pragma unroll
                for (int e = 0; e < 8; ++e) v[e] = 0.f; }
            ss += __shfl_xor(ss, 1); ss += __shfl_xor(ss, 2); ss += __shfl_xor(ss, 4);
            const float rstd = 1.0f / sqrtf(ss * (1.0f / 64.0f) + EPS);
#pragma unroll
            for (int e = 0; e < 8; ++e) v[e] = v[e] * rstd * nw[sub * 8 + e];
            float o[8];
#pragma unroll
            for (int e = 0; e < 8; ++e) {
                const float other = __shfl_xor(v[e], 1);
                if (sub == 0) o[e] = v[e] * cs[e] - other * sn[e];
                else if (sub == 1) o[e] = v[e] * cs[e] + other * sn[e];
                else o[e] = v[e];
            }
            if (act) { h16x8 h;
#pragma unroll
                for (int e = 0; e < 8; ++e) h[e] = (h16)(o[e] * scale);
                *(h16x8*)p = h; }
        }
    }
}

constexpr int RL_WT = 0;
constexpr int RL_XCF = 16384;
constexpr int RL_AGW = RL_XCF + 8 * 16 * 68 * 4;
constexpr int RL_TRS = RL_AGW + 2 * 8 * 2 * 64 * 4;
constexpr int RL_END = RL_TRS + 8 * 2048;
__device__ __forceinline__ void rglru_local(const Params& P, unsigned char* lds_g, int tid_in, int lane_in, int wave, int bid, int nb) {
    unsigned char* ws = P.ws;
    LAS3 unsigned char* lds = (LAS3 unsigned char*)lds_g;
    const h16* XR = (const h16*)(ws + WS_XR);
    h16* HL = (h16*)(ws + WS_HL); h16* AC = (h16*)(ws + WS_AC); float* AGG = (float*)(ws + WS_AGG);
    int n_loaded = -1, it = 0;
    for (int item = bid; item < 8 * 8 * 32; item += nb, ++it) {
        int lane = lane_in; asm volatile("" : "+v"(lane));
        const int tid = wave * 64 + lane, fr = lane & 15, fq = lane >> 4;
        const int n = item & 7, b = (item >> 3) & 7, ck = item >> 6;
        if (n != n_loaded) {
            __syncthreads();
            LAS3 h16* WT = (LAS3 h16*)(lds + RL_WT);
            for (int e = tid; e < 8192; e += NTHREADS) { const int gte = e >> 12, d = (e >> 6) & 63, eo = e & 63;
                WT[gte * 4096 + eo * 64 + d] = (h16)(gte ? P.gate_x_w : P.gate_a_w)[n * 4096 + d * 64 + eo]; }
            LDS_WAIT(); __syncthreads(); n_loaded = n;
        }
        const size_t m0 = (size_t)b * T + ck * 128 + wave * 16;
        const int tloc = ck * 128 + wave * 16 + fr;
        h16x8 af[2];
        LAS3 float* XCF = (LAS3 float*)(lds + RL_XCF) + wave * (16 * 68);
#pragma unroll
        for (int s = 0; s < 2; ++s) {
            const int cb = n * 64 + 32 * s + 8 * fq;
            float xc[8];
            { const f32x4 b0 = *(const f32x4*)(P.conv_b + cb), b1 = *(const f32x4*)(P.conv_b + cb + 4);
              xc[0] = b0[0]; xc[1] = b0[1]; xc[2] = b0[2]; xc[3] = b0[3]; xc[4] = b1[0]; xc[5] = b1[1]; xc[6] = b1[2]; xc[7] = b1[3]; }
#pragma unroll
            for (int k = 0; k < 4; ++k) {
                h16x8 xv;
#pragma unroll
                for (int e = 0; e < 8; ++e) xv[e] = (h16)0.f;
                if (tloc - 3 + k >= 0) xv = *(const h16x8*)(XR + (m0 + fr - 3 + k) * 512 + cb);
                const f32x4 w0 = *(const f32x4*)(P.conv_w + k * 512 + cb), w1 = *(const f32x4*)(P.conv_w + k * 512 + cb + 4);
#pragma unroll
                for (int e = 0; e < 4; ++e) { xc[e] += w0[e] * (float)xv[e]; xc[4 + e] += w1[e] * (float)xv[4 + e]; }
            }
#pragma unroll
            for (int e = 0; e < 8; ++e) af[s][e] = (h16)xc[e];
            *(LAS3 f32x4*)(XCF + fr * 68 + 32 * s + 8 * fq) = (f32x4){xc[0], xc[1], xc[2], xc[3]};
            *(LAS3 f32x4*)(XCF + fr * 68 + 32 * s + 8 * fq + 4) = (f32x4){xc[4], xc[5], xc[6], xc[7]};
        }
        f32x4 ga[4], gx[4];
        { const LAS3 h16* WT = (const LAS3 h16*)(lds + RL_WT);
#pragma unroll
          for (int nt = 0; nt < 4; ++nt) {
              ga[nt] = (f32x4){0.f, 0.f, 0.f, 0.f}; gx[nt] = ga[nt];
#pragma unroll
              for (int s = 0; s < 2; ++s) {
                  const h16x8 ba_ = *(const LAS3 h16x8*)(WT + (16 * nt + fr) * 64 + 32 * s + 8 * fq);
                  const h16x8 bx_ = *(const LAS3 h16x8*)(WT + 4096 + (16 * nt + fr) * 64 + 32 * s + 8 * fq);
                  ga[nt] = __builtin_amdgcn_mfma_f32_16x16x32_f16(af[s], ba_, ga[nt], 0, 0, 0);
                  gx[nt] = __builtin_amdgcn_mfma_f32_16x16x32_f16(af[s], bx_, gx[nt], 0, 0, 0);
              }
          } }
        LDS_WAIT();
        float hl_[4][4], ac_[4][4], A4[4], H4[4];
#pragma unroll
        for (int nt = 0; nt < 4; ++nt) {
            const int ch = n * 64 + 16 * nt + fr;
            const float bav = P.gate_a_b[ch], bxv = P.gate_x_b[ch], sp8 = -8.0f * log1pf(__expf(-P.lru_lambda[ch]));
            float h = 0.f, A = 1.0f;
#pragma unroll
            for (int r = 0; r < 4; ++r) {
                const float xcv = XCF[(4 * fq + r) * 68 + 16 * nt + fr];
                const float rg = fsigmoid(ga[nt][r] + bav), ig = fsigmoid(gx[nt][r] + bxv);
                const float la = sp8 * rg, a = __builtin_amdgcn_exp2f(la * 1.4426950408889634f);
                const float x2 = 2.0f * la;
                const float poly = -x2 * (1.0f + x2 * (0.5f + x2 * (0.16666667f + x2 * (0.041666668f + x2 * (0.0083333338f + x2 * 0.0013888889f)))));
                const float em = (x2 > -0.25f) ? poly : (1.0f - a * a);
                const float bq = sqrtf(em) * (ig * xcv);
                h = a * h + bq; A *= a;
                hl_[nt][r] = h; ac_[nt][r] = A;
            }
            A4[nt] = A; H4[nt] = h;
        }
        float Ap[4], Hp[4], A16[4], H16[4];
#pragma unroll
        for (int nt = 0; nt < 4; ++nt) {
            float Aq = 1.0f, Hq = 0.f; Ap[nt] = 1.0f; Hp[nt] = 0.f;
#pragma unroll
            for (int q = 0; q < 4; ++q) {
                const float aq = __shfl(A4[nt], fr + 16 * q), hq = __shfl(H4[nt], fr + 16 * q);
                if (q == fq) { Ap[nt] = Aq; Hp[nt] = Hq; }
                Hq = aq * Hq + hq; Aq = aq * Aq;
            }
            A16[nt] = Aq; H16[nt] = Hq;
        }
        LAS3 float* AGW = (LAS3 float*)(lds + RL_AGW) + (it & 1) * (8 * 128);
        if (fq == 0) {
#pragma unroll
            for (int nt = 0; nt < 4; ++nt) { AGW[wave * 128 + 16 * nt + fr] = A16[nt]; AGW[wave * 128 + 64 + 16 * nt + fr] = H16[nt]; }
        }
        LDS_WAIT(); __syncthreads();
        LAS3 h16* TRS = (LAS3 h16*)(lds + RL_TRS) + wave * 1024;
        float S0[4], Apre[4];
#pragma unroll
        for (int nt = 0; nt < 4; ++nt) {
            float Aw = 1.0f, Hw = 0.f, At = 1.0f, Ht = 0.f;
#pragma unroll
            for (int w2 = 0; w2 < 8; ++w2) {
                const float aw = AGW[w2 * 128 + 16 * nt + fr], hw = AGW[w2 * 128 + 64 + 16 * nt + fr];
                if (w2 == wave) { Aw = At; Hw = Ht; }
                Ht = aw * Ht + hw; At = aw * At;
            }
            S0[nt] = Ap[nt] * Hw + Hp[nt]; Apre[nt] = Ap[nt] * Aw;
            if (wave == 0 && fq == 0) { float* ag = AGG + ((size_t)(b * 8 + n) * 32 + ck) * 128; ag[16 * nt + fr] = At; ag[64 + 16 * nt + fr] = Ht; }
        }
#pragma unroll
        for (int arr = 0; arr < 2; ++arr) {
            LDS_WAIT();
#pragma unroll
            for (int nt = 0; nt < 4; ++nt)
#pragma unroll
                for (int r = 0; r < 4; ++r) {
                    const float v = arr ? ac_[nt][r] * Apre[nt] : hl_[nt][r] + ac_[nt][r] * S0[nt];
                    TRS[(4 * fq + r) * 64 + 16 * nt + fr] = (h16)v; }
            LDS_WAIT();
            h16* dst = (arr ? AC : HL) + (m0 + (lane >> 2)) * 512 + n * 64 + (lane & 3) * 16;
            const h16x8 v0 = *(const LAS3 h16x8*)(TRS + (lane >> 2) * 64 + (lane & 3) * 16), v1 = *(const LAS3 h16x8*)(TRS + (lane >> 2) * 64 + (lane & 3) * 16 + 8);
            *(h16x8*)dst = v0; *(h16x8*)(dst + 8) = v1;
        }
    }
    __syncthreads();
}

__device__ __forceinline__ void rglru_fixup(const Params& P, int gw, int ngw, int lane) {
    unsigned char* ws = P.ws;
    const h16* HL = (const h16*)(ws + WS_HL); const h16* AC = (const h16*)(ws + WS_AC); const h16* GRG = (const h16*)(ws + WS_GRG);
    const float* AGG = (const float*)(ws + WS_AGG);
    h16* Y = (h16*)(ws + WS_Y); float* RSR = (float*)(ws + WS_SSR);
    for (int item = gw; item < 8 * 256; item += ngw) {
        const int seg = item & 255, b = item >> 8, ck = seg >> 3, n = lane >> 3, c8 = (lane & 7) * 8;
        const float* ag = AGG + ((size_t)(b * 8 + n) * 32) * 128 + c8;
        float carry[8];
#pragma unroll
        for (int e = 0; e < 8; ++e) carry[e] = 0.f;
        for (int c0 = 0; c0 < ck; c0 += 4) {
            f32x4 a_[4][2], h_[4][2];
#pragma unroll
            for (int u = 0; u < 4; ++u) { const int cc = min(c0 + u, ck - 1); const float* p = ag + (size_t)cc * 128;
                a_[u][0] = *(const f32x4*)p; a_[u][1] = *(const f32x4*)(p + 4); h_[u][0] = *(const f32x4*)(p + 64); h_[u][1] = *(const f32x4*)(p + 68); }
#pragma unroll
            for (int u = 0; u < 4; ++u) if (c0 + u < ck) {
#pragma unroll
                for (int e = 0; e < 8; ++e) carry[e] = a_[u][e >> 2][e & 3] * carry[e] + h_[u][e >> 2][e & 3]; }
        }
        const size_t mrow = (size_t)b * T + seg * 16;
        const int ch = n * 64 + c8;
#pragma unroll 4
        for (int tt = 0; tt < 16; ++tt) {
            const size_t m = mrow + tt;
            const h16x8 hv = *(const h16x8*)(HL + m * 512 + ch), av = *(const h16x8*)(AC + m * 512 + ch), gv = *(const h16x8*)(GRG + m * 512 + ch);
            h16x8 yo; float ss = 0.f;
#pragma unroll
            for (int e = 0; e < 8; ++e) { const float y = (float)gv[e] * ((float)hv[e] + (float)av[e] * carry[e]); yo[e] = (h16)y; ss += y * y; }
            *(h16x8*)(Y + m * 1024 + ch) = yo;
            ss = wave_sum(ss);
            if (lane == 0) RSR[m] = 1.0f / sqrtf(ss * (1.0f / 512.0f) + EPS);
        }
    }
}

__device__ __forceinline__ void compress_finish(const Params& P, int gw, int ngw, int lane) {
    unsigned char* ws = P.ws;
    const float* CR = (const float*)(ws + WS_CRAW); const float* ROPE = (const float*)(ws + WS_ROPE);
    h16* KCC = (h16*)(ws + WS_KCC); h16* VCC = (h16*)(ws + WS_VCC);
    for (int r = gw; r < 4096; r += ngw) {
        const int bg = r >> 8, c = r & 255, b = bg >> 1;
        float kv = CR[(size_t)r * 64 + lane], vv = CR[(size_t)(4096 + r) * 64 + lane];
        if (c == 255) { KCC[(size_t)r * 64 + lane] = (h16)0.f; VCC[(size_t)r * 64 + lane] = (h16)0.f; continue; }
        const float ss = wave_sum(kv * kv);
        kv = kv * (1.0f / sqrtf(ss * (1.0f / 64.0f) + EPS)) * P.k_norm_w[lane];
        const int mp = b * T + 16 * c + 31;
        const float other = __shfl_xor(kv, 8);
        float o = kv;
        if (lane < 8) o = kv * ROPE[mp * 16 + lane] - other * ROPE[mp * 16 + 8 + lane];
        else if (lane < 16) o = kv * ROPE[mp * 16 + lane - 8] + other * ROPE[mp * 16 + 8 + lane - 8];
        KCC[(size_t)r * 64 + lane] = (h16)o; VCC[(size_t)r * 64 + lane] = (h16)vv;
    }
}


constexpr int CU_H1 = 0;
constexpr int CU_O = 64 * 264 * 2;
constexpr int CU_END = CU_O + 64 * 68 * 4;
__device__ __forceinline__ void compress_unit(const Params& P, unsigned char* lds_g, int unit, int lane_in, int wave) {
    int lane = lane_in; asm volatile("" : "+v"(lane));
    unsigned char* ws = P.ws;
    LAS3 unsigned char* lds = (LAS3 unsigned char*)lds_g;
    const int fr = lane & 15, fq = lane >> 4, tid = wave * 64 + lane;
    const int which = unit >> 6, bg = (unit >> 2) & 15, rt = unit & 3, b = bg >> 1;
    const h16* A = (const h16*)(ws + (which ? WS_VCT : WS_KCT)) + ((size_t)bg * 4096 + 1024 * rt) * 64;
    const h16* W1 = (const h16*)(ws + (which ? WS_W1V : WS_W1K));
    const h16* W2 = (const h16*)(ws + (which ? WS_W2V : WS_W2K));
    const float* b1 = (const float*)(ws + WS_B1) + which * 256;
    f32x4 acc[4][2];
#pragma unroll
    for (int i = 0; i < 4; ++i) { acc[i][0] = (f32x4){0.f, 0.f, 0.f, 0.f}; acc[i][1] = acc[i][0]; }
    const h16* ap = A + (size_t)fr * 1024 + fq * 8;
    const h16* bp = W1 + (size_t)(32 * wave + fr) * CMPK + fq * 8;
    h16x8 a0[4], b0[2], a1[4], b1f[2];
#define CU_LOAD(a, bb, k0) do { _Pragma("unroll") for (int i = 0; i < 4; ++i) a[i] = *(const h16x8*)(ap + (size_t)i * 16 * 1024 + (k0)); \
        bb[0] = *(const h16x8*)(bp + (k0)); bb[1] = *(const h16x8*)(bp + (size_t)16 * CMPK + (k0)); } while (0)
#define CU_MMA(a, bb) do { _Pragma("unroll") for (int i = 0; i < 4; ++i) { acc[i][0] = __builtin_amdgcn_mfma_f32_16x16x32_f16(a[i], bb[0], acc[i][0], 0, 0, 0); \
        acc[i][1] = __builtin_amdgcn_mfma_f32_16x16x32_f16(a[i], bb[1], acc[i][1], 0, 0, 0); } } while (0)
    CU_LOAD(a0, b0, 0); CU_LOAD(a1, b1f, 32);
    for (int k0 = 0; k0 < CMPK; k0 += 64) {
        CU_MMA(a0, b0); if (k0 + 64 < CMPK) CU_LOAD(a0, b0, k0 + 64);
        CU_MMA(a1, b1f); if (k0 + 96 < CMPK) CU_LOAD(a1, b1f, k0 + 96);
    }
#undef CU_LOAD
#undef CU_MMA
    LAS3 h16* H1s = (LAS3 h16*)(lds + CU_H1); LAS3 float* Os = (LAS3 float*)(lds + CU_O);
#pragma unroll
    for (int j = 0; j < 2; ++j) { const int col = 32 * wave + 16 * j + fr; const float bv = b1[col];
#pragma unroll
        for (int i = 0; i < 4; ++i)
#pragma unroll
            for (int r = 0; r < 4; ++r) H1s[(16 * i + 4 * fq + r) * 264 + col] = (h16)fgelu_tanh(acc[i][j][r] + bv); }
    LDS_WAIT(); __syncthreads();
    {
        const int mi = wave & 3, nj0 = 2 * (wave >> 2);
        f32x4 o2[2] = {(f32x4){0.f, 0.f, 0.f, 0.f}, (f32x4){0.f, 0.f, 0.f, 0.f}};
#pragma unroll
        for (int ks = 0; ks < 8; ++ks) {
            const h16x8 af = *(const LAS3 h16x8*)(H1s + (16 * mi + fr) * 264 + 32 * ks + 8 * fq);
#pragma unroll
            for (int j = 0; j < 2; ++j) { const h16x8 bf = *(const h16x8*)(W2 + (size_t)(16 * (nj0 + j) + fr) * CMPH + 32 * ks + 8 * fq);
                o2[j] = __builtin_amdgcn_mfma_f32_16x16x32_f16(af, bf, o2[j], 0, 0, 0); }
        }
#pragma unroll
        for (int j = 0; j < 2; ++j)
#pragma unroll
            for (int r = 0; r < 4; ++r) Os[(16 * mi + 4 * fq + r) * 68 + 16 * (nj0 + j) + fr] = o2[j][r];
    }
    LDS_WAIT(); __syncthreads();
    {
        const int row = tid >> 3, sub = tid & 7, c = 64 * rt + row;
        const f32x4 v0 = *(const LAS3 f32x4*)(Os + row * 68 + 8 * sub), v1 = *(const LAS3 f32x4*)(Os + row * 68 + 8 * sub + 4);
        float v[8] = {v0[0], v0[1], v0[2], v0[3], v1[0], v1[1], v1[2], v1[3]};
        if (which == 0) {
            float ss = 0.f;
#pragma unroll
            for (int e = 0; e < 8; ++e) ss += v[e] * v[e];
            ss += __shfl_xor(ss, 1); ss += __shfl_xor(ss, 2); ss += __shfl_xor(ss, 4);
            const float rstd = 1.0f / sqrtf(ss * (1.0f / 64.0f) + EPS);
            const float* rp = (const float*)(ws + WS_ROPE) + ((size_t)b * T + 16 * min(c, 254) + 31) * 16;
#pragma unroll
            for (int e = 0; e < 8; ++e) v[e] = v[e] * rstd * P.k_norm_w[8 * sub + e];
#pragma unroll
            for (int e = 0; e < 8; ++e) { const float other = __shfl_xor(v[e], 1);
                if (sub == 0) v[e] = v[e] * rp[e] - other * rp[8 + e]; else if (sub == 1) v[e] = v[e] * rp[e] + other * rp[8 + e]; }
        }
        h16x8 o;
#pragma unroll
        for (int e = 0; e < 8; ++e) o[e] = (c == 255) ? (h16)0.f : (h16)v[e];
        *(h16x8*)((h16*)(ws + (which ? WS_VCC : WS_KCC)) + ((size_t)bg * 256 + c) * 64 + 8 * sub) = o;
    }
    __syncthreads();
}

__device__ __forceinline__ void qk4(const h16* krow, const float* qs, float (&s)[4]) {
    s[0] = s[1] = s[2] = s[3] = 0.f;
#pragma unroll
    for (int c = 0; c < 8; ++c) {
        const h16x8 k8 = *(const h16x8*)(krow + c * 8);
#pragma unroll
        for (int e = 0; e < 8; ++e) { const float kf = (float)k8[e];
#pragma unroll
            for (int h = 0; h < 4; ++h) s[h] += qs[h * 64 + c * 8 + e] * kf; }
    }
}
__device__ __forceinline__ void attn_group(const h16* Kb, const h16* Vb, int key, bool valid, int nk, const float* qs, float* ps,
                                           float (&mx)[4], float (&l)[4], float (&o)[4], int lane) {
    float s[4];
    qk4(Kb + (size_t)(valid ? key : 0) * 64, qs, s);
    float p[4];
#pragma unroll
    for (int h = 0; h < 4; ++h) {
        const float sv = valid ? s[h] : -INFINITY;
        const float mn = fmaxf(mx[h], wave_max(sv));
        const float f = exp2f(mx[h] - mn);
        p[h] = exp2f(sv - mn);
        l[h] = l[h] * f + wave_sum(p[h]); o[h] *= f; mx[h] = mn;
    }
    LDS_WAIT();
    *(f32x4*)(ps + lane * 4) = (f32x4){p[0], p[1], p[2], p[3]};
    LDS_WAIT();
    const int k0 = key - lane;
    for (int kk = 0; kk < nk; ++kk) {
        const float v = (float)Vb[(size_t)(k0 + kk) * 64 + lane];
        const f32x4 pv = *(const f32x4*)(ps + kk * 4);
        o[0] += pv.x * v; o[1] += pv.y * v; o[2] += pv.z * v; o[3] += pv.w * v;
    }
}
__device__ __forceinline__ void attn_naive(const Params& P, unsigned char* lds, int lane, int wave, int gw, int ngw) {
    unsigned char* ws = P.ws;
    float* qs = (float*)lds + wave * (256 + 1024);
    float* ps = qs + 256;
    const h16* QN = (const h16*)(ws + WS_Q);
    const h16* KCC = (const h16*)(ws + WS_KCC); const h16* VCC = (const h16*)(ws + WS_VCC);
    const h16* KS = (const h16*)(ws + WS_KS); const h16* VS = (const h16*)(ws + WS_VS);
    const h16* KW = (const h16*)(ws + WS_KW); const h16* VW = (const h16*)(ws + WS_VW);
    const float* GATE = (const float*)(ws + WS_GATE);
    h16* Y = (h16*)(ws + WS_Y); float* SSA = (float*)(ws + WS_SSA);
    for (int item = gw; item < M * 2; item += ngw) {
        const int g = item & 1, m = item >> 1, b = m >> 12, t = m & 4095, bg = b * 2 + g;
        LDS_WAIT();
#pragma unroll
        for (int h = 0; h < 4; ++h) qs[h * 64 + lane] = (float)QN[(size_t)m * 512 + (4 * g + h) * 64 + lane];
        LDS_WAIT();
        const int nvalid = (t >= 31) ? ((t - 31) >> 4) + 1 : 0;
        float sc[4][4];
#pragma unroll
        for (int i = 0; i < 4; ++i) {
            const int c = lane + 64 * i;
            float s[4]; qk4(KCC + ((size_t)bg * 256 + c) * 64, qs, s);
#pragma unroll
            for (int h = 0; h < 4; ++h) sc[i][h] = (c < nvalid) ? s[h] : -INFINITY;
        }
#pragma unroll
        for (int h = 0; h < 4; ++h) {
            float mxv = fmaxf(fmaxf(sc[0][h], sc[1][h]), fmaxf(sc[2][h], sc[3][h]));
            mxv = wave_max(mxv);
            if (!(mxv > -INFINITY)) mxv = 0.f;
            float ls = 0.f;
#pragma unroll
            for (int i = 0; i < 4; ++i) { sc[i][h] = exp2f(sc[i][h] - mxv); ls += sc[i][h]; }
            ls = wave_sum(ls);
            const float inv = 1.0f / fmaxf(ls, 1e-30f);
#pragma unroll
            for (int i = 0; i < 4; ++i) sc[i][h] *= inv;
        }
#pragma unroll
        for (int i = 0; i < 4; ++i) *(f32x4*)(ps + (lane + 64 * i) * 4) = (f32x4){sc[i][0], sc[i][1], sc[i][2], sc[i][3]};
        LDS_WAIT();
        float ocmp[4] = {0.f, 0.f, 0.f, 0.f};
        for (int c = 0; c < nvalid; ++c) {
            const float v = (float)VCC[((size_t)bg * 256 + c) * 64 + lane];
            const f32x4 pv = *(const f32x4*)(ps + c * 4);
            ocmp[0] += pv.x * v; ocmp[1] += pv.y * v; ocmp[2] += pv.z * v; ocmp[3] += pv.w * v;
        }
        float imp = 0.f;
        {
#pragma unroll
            for (int e = 0; e < 4; ++e) { const f32x4 pv = *(const f32x4*)(ps + (4 * lane + e) * 4); const float sh = (pv.x + pv.y) + (pv.z + pv.w); imp += (e == 3) ? 0.5f * sh : sh; }
            if (lane >= 1) { const f32x4 pv = *(const f32x4*)(ps + (4 * lane - 1) * 4); imp += 0.5f * ((pv.x + pv.y) + (pv.z + pv.w)); }
        }
        const int cur = t >> 6;
        const bool forced = (lane == 0) || (lane == cur) || (lane == cur - 1);
        const bool cand = !forced && lane < cur - 1;
        const int quota = 16 - (1 + (cur >= 1 ? 1 : 0) + (cur >= 2 ? 1 : 0));
        int rank = 0;
        for (int j2 = 0; j2 < 64; ++j2) {
            const float io = __shfl(imp, j2); const int co = __shfl((int)cand, j2);
            if (co && (io > imp || (io == imp && j2 < lane))) ++rank;
        }
        const bool sel = forced || (cand && rank < quota);
        unsigned long long mask = __ballot(sel);
        float mx[4] = {-INFINITY, -INFINITY, -INFINITY, -INFINITY}, ls[4] = {0.f, 0.f, 0.f, 0.f}, os[4] = {0.f, 0.f, 0.f, 0.f};
        while (mask) {
            const int j = __builtin_ctzll(mask); mask &= mask - 1;
            const int key = 64 * j + lane; const int nk = min(64, t - 64 * j + 1);
            attn_group(KS + (size_t)bg * T * 64, VS + (size_t)bg * T * 64, key, key <= t, nk, qs, ps, mx, ls, os, lane);
        }
        float mw[4] = {-INFINITY, -INFINITY, -INFINITY, -INFINITY}, lw[4] = {0.f, 0.f, 0.f, 0.f}, ow[4] = {0.f, 0.f, 0.f, 0.f};
        for (int k0 = max(0, t - 511); k0 <= t; k0 += 64) {
            const int key = k0 + lane; const int nk = min(64, t - k0 + 1);
            attn_group(KW + (size_t)bg * T * 64, VW + (size_t)bg * T * 64, key, key <= t, nk, qs, ps, mw, lw, ow, lane);
        }
        float ssq = 0.f;
#pragma unroll
        for (int h = 0; h < 4; ++h) {
            const float* gp = GATE + (size_t)m * 24 + (4 * g + h) * 3;
            const float o = gp[0] * ocmp[h] + gp[1] * os[h] / ls[h] + gp[2] * ow[h] / lw[h];
            Y[(size_t)m * 1024 + 512 + (4 * g + h) * 64 + lane] = (h16)o;
            ssq += o * o;
        }
        ssq = wave_sum(ssq);
        if (lane == 0) SSA[m * 2 + g] = ssq;
    }
}


typedef float f32x16 __attribute__((ext_vector_type(16)));
typedef short s16x4 __attribute__((ext_vector_type(4)));
constexpr int AT_KV = 0;
constexpr int AT_IMPH = 32768;
constexpr int AT_IMPS = AT_IMPH + 65536;
constexpr int AT_MASK = AT_IMPS + 16384;
constexpr int AT_WSF = AT_MASK + 512;
constexpr int AT_SSQ = AT_WSF + 2048;
constexpr int AT_STG = AT_SSQ + 1024;
constexpr int AT_END = AT_STG + 32768;
__device__ __forceinline__ int crow(int r, int hi) { return (r & 3) + 8 * (r >> 2) + 4 * hi; }
__device__ __forceinline__ float fexp2(float x) { return __builtin_amdgcn_exp2f(x); }

__device__ __forceinline__ void at_qkt(f32x16& p0, f32x16& p1, const LAS3 unsigned char* kb, const h16x8 (&qr)[4], int r32, int hi) {
    const LAS3 unsigned char* kp = kb + hi * 1024 + r32 * 16;
    p0 = (f32x16){0.f, 0.f, 0.f, 0.f, 0.f, 0.f, 0.f, 0.f, 0.f, 0.f, 0.f, 0.f, 0.f, 0.f, 0.f, 0.f}; p1 = p0;
#pragma unroll
    for (int d0 = 0; d0 < 4; ++d0) {
        const h16x8 b0 = *(const LAS3 h16x8*)(kp + d0 * 2048), b1 = *(const LAS3 h16x8*)(kp + d0 * 2048 + 512);
        p0 = __builtin_amdgcn_mfma_f32_32x32x16_f16(b0, qr[d0], p0, 0, 0, 0);
        p1 = __builtin_amdgcn_mfma_f32_32x32x16_f16(b1, qr[d0], p1, 0, 0, 0);
    }
}
__device__ __forceinline__ void at_mask(f32x16& p0, f32x16& p1, int lo, int hb, int hi) {
#pragma unroll
    for (int r = 0; r < 16; ++r) { const int kv = crow(r, hi);
        if (kv < lo || kv >= hb) p0[r] = -INFINITY;
        if (kv + 32 < lo || kv + 32 >= hb) p1[r] = -INFINITY; }
}
__device__ __forceinline__ float at_rowmax(const f32x16& p0, const f32x16& p1) {
    float a = fmaxf(p0[0], p1[0]);
#pragma unroll
    for (int r = 1; r < 16; ++r) a = fmaxf(a, fmaxf(p0[r], p1[r]));
    return fmaxf(a, __shfl_xor(a, 32));
}
__device__ __forceinline__ h16x8 at_pack(const f32x16& p, int b) {
    h16x8 o;
#pragma unroll
    for (int j = 0; j < 8; ++j) o[j] = (h16)p[b + j];
    return o;
}
__device__ __forceinline__ void at_pv(f32x16& o0, f32x16& o1, const LAS3 unsigned char* vb, const f32x16& p0, const f32x16& p1, int lane, int hi) {
    const LAS3 unsigned char* vp = vb + ((lane >> 4) & 1) * 32 + (lane & 3) * 8 + (4 * hi + ((lane & 15) >> 2)) * 64;
    const h16x8 pw0 = at_pack(p0, 0), pw1 = at_pack(p0, 8), pw2 = at_pack(p1, 0), pw3 = at_pack(p1, 8);
#pragma unroll
    for (int dh = 0; dh < 2; ++dh) {
        h16x8 vf[4];
#pragma unroll
        for (int kg = 0; kg < 4; ++kg) {
            const s16x4 lo4 = __builtin_amdgcn_ds_read_tr16_b64_v4i16((LAS3 s16x4*)(vp + dh * 4096 + kg * 1024));
            const s16x4 hi4 = __builtin_amdgcn_ds_read_tr16_b64_v4i16((LAS3 s16x4*)(vp + dh * 4096 + kg * 1024 + 512));
            typedef short s16x8 __attribute__((ext_vector_type(8)));
            const s16x8 w = (s16x8){lo4[0], lo4[1], lo4[2], lo4[3], hi4[0], hi4[1], hi4[2], hi4[3]};
            vf[kg] = __builtin_bit_cast(h16x8, w);
        }
        f32x16& o = dh ? o1 : o0;
        o = __builtin_amdgcn_mfma_f32_32x32x16_f16(pw0, vf[0], o, 0, 0, 0);
        o = __builtin_amdgcn_mfma_f32_32x32x16_f16(pw1, vf[1], o, 0, 0, 0);
        o = __builtin_amdgcn_mfma_f32_32x32x16_f16(pw2, vf[2], o, 0, 0, 0);
        o = __builtin_amdgcn_mfma_f32_32x32x16_f16(pw3, vf[3], o, 0, 0, 0);
    }
}
__device__ __forceinline__ void at_scale_rows(f32x16& o0, f32x16& o1, float f, LAS3 float* wsf, int r32, int hi) {
    LDS_WAIT();
    if (hi == 0) wsf[r32] = f;
    LDS_WAIT();
#pragma unroll
    for (int r = 0; r < 16; ++r) { const float fr = wsf[crow(r, hi)]; o0[r] *= fr; o1[r] *= fr; }
}
__device__ __forceinline__ void at_step(f32x16& p0, f32x16& p1, f32x16& o0, f32x16& o1, float& m, float& l, const LAS3 unsigned char* vb, LAS3 float* wsf, int lane, int r32, int hi) {
    const float rm = at_rowmax(p0, p1);
    const float mn = fmaxf(m, rm);
    if (__any(mn > m)) { const float f = fexp2(m - mn); l *= f; m = mn; at_scale_rows(o0, o1, f, wsf, r32, hi); }
    float s = 0.f;
#pragma unroll
    for (int r = 0; r < 16; ++r) { p0[r] = fexp2(p0[r] - m); p1[r] = fexp2(p1[r] - m); s += p0[r] + p1[r]; }
    l += s;
    at_pv(o0, o1, vb, p0, p1, lane, hi);
}

__device__ __forceinline__ void attn_unit(const Params& P, unsigned char* lds_g, int bg, int qb, int tid_in, int lane_in, int wave) {
    int lane = lane_in; asm volatile("" : "+v"(lane));
    const int tid = wave * 64 + lane; (void)tid_in;
    unsigned char* ws = P.ws;
    LAS3 unsigned char* lds = (LAS3 unsigned char*)lds_g;
    const int r32 = lane & 31, hi = lane >> 5, hl = wave >> 1, th = wave & 1;
    const int b = bg >> 1, g = bg & 1;
    const int tok = 32 * th + r32;
    const int t = 64 * qb + tok;
    const size_t m = (size_t)b * T + t;
    const h16* KCC = (const h16*)(ws + WS_KCC) + (size_t)bg * 256 * 64; const h16* VCC = (const h16*)(ws + WS_VCC) + (size_t)bg * 256 * 64;
    const h16* KS = (const h16*)(ws + WS_KS) + (size_t)bg * T * 64; const h16* VS = (const h16*)(ws + WS_VS) + (size_t)bg * T * 64;
    const h16* KW = (const h16*)(ws + WS_KW) + (size_t)bg * T * 64; const h16* VW = (const h16*)(ws + WS_VW) + (size_t)bg * T * 64;
    LAS3 float* wsf = (LAS3 float*)(lds + AT_WSF) + wave * 64;
    LAS3 float* IMPH = (LAS3 float*)(lds + AT_IMPH); LAS3 float* IMPS = (LAS3 float*)(lds + AT_IMPS);
    const int ntc = (4 * qb + 3 + 63) >> 6, nsl = qb + 1, nwn = min(qb + 1, 9), nt = 2 * ntc + nsl + nwn;
#define AT_KOFF (lane * 64 + wave * 8)
#define AT_VOFF ((16 * (wave & 3) + (lane >> 2)) * 64 + (wave >> 2) * 32 + (lane & 3) * 8)
#define AT_ISSUE(i) do { const int i_ = (i); const h16* ks_; const h16* vs_ = nullptr; int key0_; \
        if (i_ < ntc) { ks_ = KCC; key0_ = 64 * i_; } else if (i_ < 2 * ntc) { ks_ = KCC; vs_ = VCC; key0_ = 64 * (i_ - ntc); } \
        else if (i_ < 2 * ntc + nsl) { ks_ = KS; vs_ = VS; key0_ = 64 * (i_ - 2 * ntc); } else { ks_ = KW; vs_ = VW; key0_ = 64 * (qb - (i_ - 2 * ntc - nsl)); } \
        LAS3 unsigned char* dst_ = lds + AT_KV + (i_ & 1) * 16384 + wave * 1024; \
        __builtin_amdgcn_global_load_lds((const unsigned*)(ks_ + (size_t)key0_ * 64 + AT_KOFF), (LAS3 unsigned*)dst_, 16, 0, 0); \
        if (vs_) __builtin_amdgcn_global_load_lds((const unsigned*)(vs_ + (size_t)key0_ * 64 + AT_VOFF), (LAS3 unsigned*)(dst_ + 8192), 16, 0, 0); } while (0)
    AT_ISSUE(0);
    h16x8 qr[4];
    { const h16* qp = (const h16*)(ws + WS_Q) + m * 512 + (4 * g + hl) * 64 + hi * 8;
#pragma unroll
      for (int d0 = 0; d0 < 4; ++d0) qr[d0] = *(const h16x8*)(qp + d0 * 16); }
    float gt[3];
    { const float* gp = (const float*)(ws + WS_GATE) + m * 24 + (4 * g + hl) * 3; gt[0] = gp[0]; gt[1] = gp[1]; gt[2] = gp[2]; }
    const int nvalid = (t >= 31) ? ((t - 31) >> 4) + 1 : 0;
    f32x16 ot0, ot1, o0, o1;
#pragma unroll
    for (int r = 0; r < 16; ++r) { ot0[r] = 0.f; ot1[r] = 0.f; o0[r] = 0.f; o1[r] = 0.f; }
    float mx = -INFINITY, l = 0.f, cinv = 0.f, carry = 0.f;
    unsigned selw0 = 0u, selw1 = 0u;
    asm volatile("s_waitcnt vmcnt(0)" ::: "memory"); __syncthreads();
    const int lane_outer = lane, r32_outer = r32, hi_outer = hi, tok_outer = tok, tid_outer = tid;
    for (int i = 0; i < nt; ++i) {
        int lane = lane_outer; asm volatile("" : "+v"(lane));
        const int r32 = lane & 31, hi = lane >> 5, tok = 32 * th + r32, tid = wave * 64 + lane;
        if (i + 1 < nt) AT_ISSUE(i + 1);
        const LAS3 unsigned char* kb = lds + AT_KV + (i & 1) * 16384; const LAS3 unsigned char* vb = kb + 8192;
        f32x16 p0, p1;
        at_qkt(p0, p1, kb, qr, r32, hi);
        if (i < ntc) {
            at_mask(p0, p1, 0, nvalid - 64 * i, hi);
            const float rm = at_rowmax(p0, p1);
            const float mn = fmaxf(mx, rm), ms = (mn == -INFINITY) ? 0.f : mn;
            float s = 0.f;
#pragma unroll
            for (int r = 0; r < 16; ++r) s += fexp2(p0[r] - ms) + fexp2(p1[r] - ms);
            l = l * fexp2(mx - ms) + s; mx = mn;
            if (i == ntc - 1) { const float lt = l + __shfl_xor(l, 32); cinv = 1.0f / fmaxf(lt, 1e-30f); if (mx == -INFINITY) mx = 0.f; }
        } else if (i < 2 * ntc) {
            const int tl = i - ntc;
            at_mask(p0, p1, 0, nvalid - 64 * tl, hi);
#pragma unroll
            for (int r = 0; r < 16; ++r) { p0[r] = fexp2(p0[r] - mx) * cinv; p1[r] = fexp2(p1[r] - mx) * cinv; }
#pragma unroll
            for (int gq = 0; gq < 2; ++gq) {
                const f32x16& p = gq ? p1 : p0;
                float tot[4], x[4];
#pragma unroll
                for (int R = 0; R < 4; ++R) { const float sp = 0.5f * p[4 * R + 3]; tot[R] = (p[4 * R] + p[4 * R + 1]) + (p[4 * R + 2] + sp); x[R] = __shfl_xor(sp, 32); }
                if (hi) {
#pragma unroll
                    for (int R = 0; R < 4; ++R) tot[R] += x[R];
                } else { tot[0] += carry; tot[1] += x[0]; tot[2] += x[1]; tot[3] += x[2]; carry = x[3]; }
#pragma unroll
                for (int R = 0; R < 4; ++R) IMPH[(hl * 64 + 16 * tl + 8 * gq + 2 * R + hi) * 64 + tok] = tot[R];
            }
            at_pv(o0, o1, vb, p0, p1, lane, hi);
            if (i == 2 * ntc - 1) {
                at_scale_rows(o0, o1, gt[0], wsf, r32, hi);
#pragma unroll
                for (int r = 0; r < 16; ++r) { ot0[r] += o0[r]; ot1[r] += o1[r]; o0[r] = 0.f; o1[r] = 0.f; }
                mx = -INFINITY; l = 0.f;
                LDS_WAIT(); __syncthreads();
                { const int tk = tid & 63, part = tid >> 6;
                  float own[8];
#pragma unroll
                  for (int e = 0; e < 8; ++e) { const int j = 8 * part + e; float v = 0.f;
                      if (j < 16 * ntc) v = (IMPH[(0 * 64 + j) * 64 + tk] + IMPH[(1 * 64 + j) * 64 + tk]) + (IMPH[(2 * 64 + j) * 64 + tk] + IMPH[(3 * 64 + j) * 64 + tk]);
                      own[e] = v; IMPS[j * 64 + tk] = v; }
                  LDS_WAIT(); __syncthreads();
                  int rank[8];
#pragma unroll
                  for (int e = 0; e < 8; ++e) rank[e] = 0;
                  for (int j2 = 1; j2 <= qb - 2; ++j2) { const float v2 = IMPS[j2 * 64 + tk];
#pragma unroll
                      for (int e = 0; e < 8; ++e) { const int j = 8 * part + e; rank[e] += (v2 > own[e] || (v2 == own[e] && j2 < j)) ? 1 : 0; } }
                  const int quota = 16 - (1 + (qb >= 1 ? 1 : 0) + (qb >= 2 ? 1 : 0));
                  unsigned bits = 0u;
#pragma unroll
                  for (int e = 0; e < 8; ++e) { const int j = 8 * part + e; const bool forced = (j == 0) || (j == qb) || (j == qb - 1); const bool cand = !forced && j >= 1 && j <= qb - 2;
                      if (forced || (cand && rank[e] < quota)) bits |= 1u << e; }
                  ((LAS3 unsigned char*)(lds + AT_MASK))[tk * 8 + part] = (unsigned char)bits;
                  LDS_WAIT(); __syncthreads();
                  const LAS3 unsigned* mp = (const LAS3 unsigned*)(lds + AT_MASK) + tok * 2; selw0 = mp[0]; selw1 = mp[1]; }
            }
        } else if (i < 2 * ntc + nsl) {
            const int j = i - 2 * ntc;
            const bool sel = ((j < 32 ? (selw0 >> j) : (selw1 >> (j - 32))) & 1u) != 0u;
            const int hb = sel ? ((j == qb) ? tok + 1 : 64) : 0;
            at_mask(p0, p1, 0, hb, hi);
            at_step(p0, p1, o0, o1, mx, l, vb, wsf, lane, r32, hi);
            if (j == qb) {
                const float lt = l + __shfl_xor(l, 32);
                at_scale_rows(o0, o1, gt[1] / lt, wsf, r32, hi);
#pragma unroll
                for (int r = 0; r < 16; ++r) { ot0[r] += o0[r]; ot1[r] += o1[r]; o0[r] = 0.f; o1[r] = 0.f; }
                mx = -INFINITY; l = 0.f;
            }
        } else {
            const int jj = i - 2 * ntc - nsl;
            const int lo = (jj == 8) ? tok + 1 : 0, hb = (jj == 0) ? tok + 1 : 64;
            if (jj == 0 || jj == 8) at_mask(p0, p1, lo, hb, hi);
            at_step(p0, p1, o0, o1, mx, l, vb, wsf, lane, r32, hi);
            if (i == nt - 1) {
                const float lt = l + __shfl_xor(l, 32);
                at_scale_rows(o0, o1, gt[2] / lt, wsf, r32, hi);
#pragma unroll
                for (int r = 0; r < 16; ++r) { ot0[r] += o0[r]; ot1[r] += o1[r]; }
            }
        }
        asm volatile("s_waitcnt vmcnt(0)" ::: "memory"); __syncthreads();
    }
#undef AT_ISSUE
#undef AT_KOFF
#undef AT_VOFF
    (void)r32_outer; (void)hi_outer; (void)tok_outer; (void)tid_outer;
    LAS3 h16* stg = (LAS3 h16*)(lds + AT_STG) + wave * 2048;
#pragma unroll
    for (int r = 0; r < 16; ++r) { const int orow = crow(r, hi); stg[orow * 64 + r32] = (h16)ot0[r]; stg[orow * 64 + 32 + r32] = (h16)ot1[r]; }
    LDS_WAIT();
    LAS3 float* SSQ = (LAS3 float*)(lds + AT_SSQ);
    h16* Yb = (h16*)(ws + WS_Y) + ((size_t)b * T + 64 * qb + 32 * th) * 1024 + 512 + (4 * g + hl) * 64;
#pragma unroll
    for (int i2 = 0; i2 < 4; ++i2) { const int row = i2 * 8 + (lane >> 3), ch = lane & 7;
        const h16x8 v = *(const LAS3 h16x8*)(stg + row * 64 + ch * 8);
        *(h16x8*)(Yb + (size_t)row * 1024 + ch * 8) = v;
        float ss = 0.f;
#pragma unroll
        for (int e = 0; e < 8; ++e) { const float f = (float)v[e]; ss += f * f; }
        ss += __shfl_xor(ss, 1); ss += __shfl_xor(ss, 2); ss += __shfl_xor(ss, 4);
        if (ch == 0) SSQ[hl * 64 + 32 * th + row] = ss; }
    LDS_WAIT(); __syncthreads();
    if (tid < 64) ((float*)(ws + WS_SSA))[((size_t)b * T + 64 * qb + tid) * 2 + g] = (SSQ[tid] + SSQ[64 + tid]) + (SSQ[128 + tid] + SSQ[192 + tid]);
    __syncthreads();
}
__device__ __forceinline__ void attn_mfma_phase(const Params& P, unsigned char* lds, int tid, int lane, int wave, int bid, int nb) {
    const bool deal = (nb == 256);
    const int v = (bid & 7) * 32 + (bid >> 3);
    const int nu = deal ? 4 : (1024 - bid + nb - 1) / nb;
    for (int k = 0; k < nu; ++k) {
        int bg, qb;
        if (deal) { const int s = v & 15; bg = v >> 4; qb = (k == 0) ? 63 - s : (k == 1) ? 32 + s : (k == 2) ? 31 - s : s; }
        else { const int u = bid + k * nb; bg = u >> 6; qb = 63 - (u & 63); }
        attn_unit(P, lds, bg, qb, tid, lane, wave);
    }
}


#define XLAS __attribute__((address_space(3)))
#define XB_TMO      128
#define XB_XCNT(j)  (256  + 64 * (j))
#define XB_XSUB(j)  (1280 + 64 * (j))
#define XB_XGEN(j)  (2304 + 64 * (j))
#define XB_TOP      3328
#define XB_TOPGEN   3392
#define XCD_BAR_WORDS 3456
#define XB_SPIN_CAP (1u << 18)

__device__ __forceinline__ unsigned xb_ld(unsigned* p)              { return __hip_atomic_load(p, __ATOMIC_RELAXED, __HIP_MEMORY_SCOPE_AGENT); }
__device__ __forceinline__ unsigned xb_add(unsigned* p, unsigned v) { return __hip_atomic_fetch_add(p, v, __ATOMIC_RELAXED, __HIP_MEMORY_SCOPE_AGENT); }
__device__ __forceinline__ unsigned xb_xcc_id() { return (unsigned)__builtin_amdgcn_s_getreg((3 << 11) | 20) & 0xFu; }
#define XB_SPIN(cond, bar) do { unsigned _sp = 0; while (cond) { __builtin_amdgcn_s_sleep(1); \
    if ((++_sp & 255u) == 0u) { if (xb_ld(&(bar)[XB_TMO])) break; if (_sp > XB_SPIN_CAP) { atomicAdd(&(bar)[XB_TMO], 1u); break; } } } } while (0)

struct XcdBarrier {
    unsigned* bar; unsigned x;
    volatile XLAS unsigned* st;
};

__device__ __forceinline__ XcdBarrier xcd_barrier_post(unsigned* bar, volatile XLAS unsigned* st) {
    XcdBarrier b; b.bar = bar; b.x = xb_xcc_id(); b.st = st;
    if (threadIdx.x == 0) (void)xb_add(&bar[XB_XCNT(b.x)], 1u);
    return b;
}
__device__ __forceinline__ void xcd_barrier_complete(unsigned* bar, unsigned x, unsigned& nloc, unsigned& nx) {
    const unsigned G = gridDim.x * gridDim.y * gridDim.z;
    unsigned sum, cnt, mine, sp = 0u;
    for (;;) {
        sum = 0u; cnt = 0u; mine = 0u;
#pragma unroll
        for (unsigned j = 0; j < 16; ++j) { const unsigned c = xb_ld(&bar[XB_XCNT(j)]); sum += c; cnt += (c > 0u) ? 1u : 0u; mine = (j == x) ? c : mine; }
        if (sum == G) break;
        __builtin_amdgcn_s_sleep(1);
        if ((++sp & 255u) == 0u) { if (xb_ld(&bar[XB_TMO])) break; if (sp > XB_SPIN_CAP) { atomicAdd(&bar[XB_TMO], 1u); break; } }
    }
    nloc = mine > 0u ? mine : 1u; nx = cnt > 0u ? cnt : 1u;
}

__device__ __forceinline__ void xcd_barrier(const XcdBarrier& b) {
    asm volatile("s_waitcnt vmcnt(0)" ::: "memory");
    __syncthreads();
    if (threadIdx.x == 0) {
        unsigned* bar = b.bar;
        __builtin_amdgcn_s_waitcnt(0);
        unsigned nloc = b.st[0], nx = b.st[1];
        if (nloc == 0u) { xcd_barrier_complete(bar, b.x, nloc, nx); b.st[0] = nloc; b.st[1] = nx; }
        const unsigned old = xb_add(&bar[XB_XSUB(b.x)], 1u);
        const unsigned gen = old / nloc;
        if (old + 1u == (gen + 1u) * nloc) {
            __builtin_amdgcn_fence(__ATOMIC_RELEASE, "agent");
            asm volatile("s_waitcnt vmcnt(0)" ::: "memory");
            const unsigned og = xb_add(&bar[XB_TOP], 1u);
            const unsigned tg = og / nx;
            if (og + 1u == (tg + 1u) * nx) xb_add(&bar[XB_TOPGEN], 1u);
            else XB_SPIN(xb_ld(&bar[XB_TOPGEN]) == tg, bar);
            __builtin_amdgcn_fence(__ATOMIC_ACQUIRE, "agent");
            xb_add(&bar[XB_XGEN(b.x)], 1u);
            asm volatile("s_waitcnt vmcnt(0)" ::: "memory");
        } else {
            XB_SPIN(xb_ld(&bar[XB_XGEN(b.x)]) == gen, bar);
            __builtin_amdgcn_fence(__ATOMIC_ACQUIRE, "agent");
            asm volatile("s_waitcnt vmcnt(0)" ::: "memory");
        }
    }
    __syncthreads();
}

#ifndef PHMASK
#define PHMASK 0x7f
#endif
constexpr int NPHASE = 7;
#ifndef FAST_GEMM
#define FAST_GEMM 7
#endif
#ifndef FAST_ATTN
#define FAST_ATTN 1
#endif
#ifndef DUPMASK
#define DUPMASK 0
#endif
#define REP(bit) for (int rep_ = 0; rep_ < ((DUPMASK >> (bit)) & 1) + 1; ++rep_)
constexpr int LDS_BYTES = 155648, LDS_MISC = LDS_BYTES - 64;
static_assert(RL_END <= LDS_MISC && CU_END <= LDS_MISC && AT_END <= LDS_MISC && pg8::STAGE_BYTES <= LDS_BYTES, "LDS map");
__global__ void __launch_bounds__(NTHREADS, 2) hymba_fwd(Params P) {
    extern __shared__ __attribute__((aligned(16))) unsigned char lds[];
    cg::grid_group grid = cg::this_grid();
    const int tid = threadIdx.x, lane = tid & 63, wave = __builtin_amdgcn_readfirstlane(tid >> 6);
    const int bid = blockIdx.x, nb = gridDim.x;
    const int gw = bid * NWAVES + wave, ngw = nb * NWAVES;
    unsigned char* ws = P.ws;
    const int lo = P.ph_lo, hi = P.ph_hi;
    volatile XLAS unsigned* misc = (volatile XLAS unsigned*)((XLAS unsigned char*)lds + LDS_MISC);
    if (tid < 16) misc[tid] = 0u;
    __syncthreads();
    XcdBarrier bar = xcd_barrier_post((unsigned*)(ws + WS_CTL), misc);
    if (hi < 0) grid.sync();
#define PH_BEGIN(k) if (lo <= (k) && (k) < hi) { if ((k) > lo) xcd_barrier(bar);
#define PH_END }
#if PHMASK & (1 << 0)
        PH_BEGIN(0) REP(0) phase0(P, lds, tid, lane, wave, bid, nb); PH_END
#endif
#if PHMASK & (1 << 1)
        PH_BEGIN(1) {
#if FAST_GEMM & 1
            REP(1) {
            pg8::Gemm g{(const pg8::bf16_t*)(ws + WS_XH), (const pg8::bf16_t*)(ws + WS_WIN), M, NP1, 1024}; pg8::StaticOrder S; S.init(M, NP1, nb, bid);
            pg8::gemm_phase<EpiProjF, pg8::StaticOrder, true, true>((PG8_LAS unsigned char*)lds, g, S, EpiProjF{ws});
            }
#else
            GemmN g{(const h16*)(ws + WS_XH), 1024, (const h16*)(ws + WS_WIN), 1024, 1024, nullptr, 0, nullptr, 0, 0, M, NP1, 0};
            gemm_naive<false>(g, EpiProj{ws}, gw, ngw, lane);
#endif
        } PH_END
#endif
#if PHMASK & (1 << 2)
        PH_BEGIN(2) {
            normrope_rows(P, gw, ngw, lane);
            REP(2) rglru_local(P, lds, tid, lane, wave, bid, nb);
            REP(3) for (int u = (bid + nb / 2) % nb; u < 128; u += nb) compress_unit(P, lds, u, lane, wave);
        } PH_END
#endif
#if PHMASK & (1 << 3)
        PH_BEGIN(3) {
            REP(5) rglru_fixup(P, gw, ngw, lane);
#if FAST_ATTN
            REP(6) attn_mfma_phase(P, lds, tid, lane, wave, bid, nb);
#else
            attn_naive(P, lds, lane, wave, gw, ngw);
#endif
        } PH_END
#endif
#if PHMASK & (1 << 4)
        PH_BEGIN(4) {
#if FAST_GEMM & 2
            REP(7) {
            pg8::Gemm g{(const pg8::bf16_t*)(ws + WS_Y), (const pg8::bf16_t*)(ws + WS_WOUT), M, D, 1024}; pg8::StaticOrder S; S.init(M, D, nb, bid);
            pg8::gemm_phase<EpiOutF, pg8::StaticOrder, true, true>((PG8_LAS unsigned char*)lds, g, S,
                EpiOutF{P.x, P.out, (h16*)(ws + WS_X1H), (const float*)(ws + WS_SSR), (const float*)(ws + WS_SSA), (float*)(ws + WS_SS2P)});
            }
#else
            const h16* Y = (const h16*)(ws + WS_Y); const h16* W = (const h16*)(ws + WS_WOUT);
            GemmN g{Y, 1024, W, 1024, 512, Y + 512, 1024, W + 512, 1024, 512, M, D, 0};
            gemm_naive<true>(g, EpiOut{P.x, P.out, (h16*)(ws + WS_X1H), (const float*)(ws + WS_SSR), (const float*)(ws + WS_SSA)}, gw, ngw, lane);
#endif
        } PH_END
#endif
#if PHMASK & (1 << 5)
        PH_BEGIN(5) {
#if FAST_GEMM & 2
            REP(8) {
            pg8::Gemm g{(const pg8::bf16_t*)(ws + WS_X1H), (const pg8::bf16_t*)(ws + WS_WGU), M, 2 * DFF, 1024}; pg8::StaticOrder S; S.init(M, 2 * DFF, nb, bid);
            pg8::gemm_phase<EpiGUF, pg8::StaticOrder, true, true>((PG8_LAS unsigned char*)lds, g, S, EpiGUF{(h16*)(ws + WS_HM), (const float*)(ws + WS_SS2P)});
            }
#else
            const h16* A = (const h16*)(ws + WS_X1H); const h16* W = (const h16*)(ws + WS_WGU);
            GemmN g{A, 1024, W, 1024, 1024, A, 1024, W, 1024, 1024, M, DFF, 1};
            gemm_naive<true>(g, EpiGU{(h16*)(ws + WS_HM), (const float*)(ws + WS_RSTD2)}, gw, ngw, lane);
#endif
        } PH_END
#endif
#if PHMASK & (1 << 6)
        PH_BEGIN(6) {
#if FAST_GEMM & 4
            pg8::Gemm g{(const pg8::bf16_t*)(ws + WS_HM), (const pg8::bf16_t*)(ws + WS_WD), M, D, DFF}; pg8::StaticOrder S; S.init(M, D, nb, bid);
            pg8::gemm_phase<EpiDownF, pg8::StaticOrder, true, true>((PG8_LAS unsigned char*)lds, g, S, EpiDownF{P.out});
#else
            GemmN g{(const h16*)(ws + WS_HM), DFF, (const h16*)(ws + WS_WD), DFF, DFF, nullptr, 0, nullptr, 0, 0, M, D, 0};
            gemm_naive<false>(g, EpiDown{P.out}, gw, ngw, lane);
#endif
        } PH_END
#endif
}

#ifndef N_LAUNCH_PER_PHASE
#define N_LAUNCH_PER_PHASE 0
#endif
extern "C" void kernel_launch(void* const* d_in, const int* in_sizes, int n_in, void* d_out, int out_size, void* d_ws, size_t ws_size, hipStream_t stream) {
    static int grid = 0;
    if (grid == 0) {
        if (n_in != 25 || in_sizes[0] != M * D || out_size != M * D || ws_size < WS_END) {
            fprintf(stderr, "kernel_launch: unexpected problem (n_in %d, in0 %d, out %d, ws %zu)\n", n_in, n_in > 0 ? in_sizes[0] : -1, out_size, ws_size); grid = -1; return; }
        int dev = 0, cus = 0, per_cu = 0;
        hipGetDevice(&dev);
        hipDeviceGetAttribute(&cus, hipDeviceAttributeMultiprocessorCount, dev);
        hipFuncSetAttribute((const void*)hymba_fwd, hipFuncAttributeMaxDynamicSharedMemorySize, LDS_BYTES);
        hipOccupancyMaxActiveBlocksPerMultiprocessor(&per_cu, (const void*)hymba_fwd, NTHREADS, LDS_BYTES);
        if (per_cu < 1) { fprintf(stderr, "kernel_launch: occupancy query says %d blocks per CU\n", per_cu); grid = -1; return; }
        grid = cus;
    }
    if (grid < 0) return;
    if (hipMemsetAsync((char*)d_ws + WS_CTL, 0, CTL_BYTES, stream) != hipSuccess) { fprintf(stderr, "kernel_launch: memset failed\n"); return; }
    Params p{};
    const float** pf = (const float**)&p;
    for (int i = 0; i < 25; ++i) pf[i] = (const float*)d_in[i];
    p.out = (float*)d_out; p.ws = (unsigned char*)d_ws;
#if N_LAUNCH_PER_PHASE
    for (int ph = 0; ph < NPHASE; ++ph) {
        p.ph_lo = ph; p.ph_hi = ph + 1;
        void* args[] = {&p};
        hipError_t e = hipLaunchCooperativeKernel((const void*)hymba_fwd, dim3(grid), dim3(NTHREADS), args, LDS_BYTES, stream);
        if (e != hipSuccess) { fprintf(stderr, "launch failed: %s\n", hipGetErrorString(e)); return; }
    }
#else
    p.ph_lo = 0; p.ph_hi = NPHASE;
    void* args[] = {&p};
    hipError_t e = hipLaunchCooperativeKernel((const void*)hymba_fwd, dim3(grid), dim3(NTHREADS), args, LDS_BYTES, stream);
    if (e != hipSuccess) fprintf(stderr, "launch failed: %s\n", hipGetErrorString(e));
#endif
}
```

```cpp
#include <hip/hip_runtime.h>
#include <hip/hip_cooperative_groups.h>
#include <cstdio>
#include <cstdint>
namespace cg = cooperative_groups;

typedef _Float16 h16;
typedef _Float16 h16x8 __attribute__((ext_vector_type(8)));
typedef _Float16 h16x4 __attribute__((ext_vector_type(4)));
typedef _Float16 h16x2 __attribute__((ext_vector_type(2)));
typedef float f32x4 __attribute__((ext_vector_type(4)));
typedef float f32x2 __attribute__((ext_vector_type(2)));
typedef unsigned u32x4 __attribute__((ext_vector_type(4)));
typedef unsigned u32x2 __attribute__((ext_vector_type(2)));

constexpr int BATCH = 8, T = 4096, M = BATCH * T, D = 1024;
constexpr int DRNN = 512, NBLK = 8, DATT = 512, NH = 8, NKV = 2, HPG = 4, HD = 64;
constexpr int DIN = 2328, NP1 = 2560;
constexpr int DFF = 2816;
constexpr int NCMP = 255, NCP = 256;
constexpr int CMPK = 2048, CMPH = 256;
constexpr float EPS = 1e-6f;
constexpr float C2 = 0.125f * 1.4426950408889634f;
constexpr int NTHREADS = 512, NWAVES = 8;

constexpr size_t MiB = 1u << 20;
constexpr size_t WS_WIN = 0;
constexpr size_t WS_WOUT = 6 * MiB;
constexpr size_t WS_WGU = 8 * MiB;
constexpr size_t WS_WD = 20 * MiB;
constexpr size_t WS_W1K = 26 * MiB, WS_W1V = 27 * MiB;
constexpr size_t WS_W2K = 28 * MiB, WS_W2V = 28 * MiB + 65536;
constexpr size_t WS_B1 = 28 * MiB + 131072;
constexpr size_t WS_RSTD1 = 29 * MiB;
constexpr size_t WS_RSTD2 = 29 * MiB + 262144;
constexpr size_t WS_SS2P = 456 * MiB;
constexpr size_t WS_ROPE = 30 * MiB;
constexpr size_t WS_XH = 32 * MiB;
constexpr size_t WS_XR = 96 * MiB;
constexpr size_t WS_GRG = 128 * MiB;
constexpr size_t WS_Q = 160 * MiB;
constexpr size_t WS_HL = 192 * MiB;
constexpr size_t WS_HM = 32 * MiB;
constexpr size_t WS_AC = 224 * MiB;
constexpr size_t WS_KCT = 256 * MiB;
constexpr size_t WS_VCT = 265 * MiB;
constexpr size_t WS_KS = 274 * MiB, WS_VS = 282 * MiB, WS_KW = 290 * MiB, WS_VW = 298 * MiB;
constexpr size_t WS_GATE = 306 * MiB;
constexpr size_t WS_H1 = 310 * MiB;
constexpr size_t WS_CRAW = 314 * MiB;
constexpr size_t WS_KCC = 316 * MiB, WS_VCC = 317 * MiB;
constexpr size_t WS_AGG = 318 * MiB;
constexpr size_t WS_SSR = 326 * MiB, WS_SSA = 327 * MiB;
constexpr size_t WS_Y = 328 * MiB;
constexpr size_t WS_X1H = 392 * MiB;
constexpr size_t WS_CTL = 458 * MiB;
constexpr size_t CTL_BYTES = 16384;
constexpr size_t WS_END = 459 * MiB;

#define LDS_WAIT() asm volatile("s_waitcnt lgkmcnt(0)" ::: "memory")
#define LAS3 __attribute__((address_space(3)))
__device__ __forceinline__ float wave_sum(float v) {
#pragma unroll
    for (int o = 1; o < 64; o <<= 1) v += __shfl_xor(v, o);
    return v;
}
__device__ __forceinline__ float wave_max(float v) {
#pragma unroll
    for (int o = 1; o < 64; o <<= 1) v = fmaxf(v, __shfl_xor(v, o));
    return v;
}
__device__ __forceinline__ float gelu_tanh(float x) {
    const float u = 0.7978845608028654f * (x + 0.044715f * x * x * x);
    return 0.5f * x * (1.0f + tanhf(u));
}
__device__ __forceinline__ float sigmoidf_(float x) { return 1.0f / (1.0f + __expf(-x)); }

struct Params {
    const float* x; const int* pos; const float* attn_norm_w; const float* w_in; const float* conv_w; const float* conv_b;
    const float* gate_a_w; const float* gate_a_b; const float* gate_x_w; const float* gate_x_b; const float* lru_lambda;
    const float* q_norm_w; const float* k_norm_w; const float* cmp_pos; const float* cmp_k_w1; const float* cmp_k_w2;
    const float* cmp_v_w1; const float* cmp_v_w2; const float* rnn_out_norm_w; const float* attn_out_norm_w; const float* w_out;
    const float* ffn_norm_w; const float* w_gate; const float* w_up; const float* w_down;
    float* out; unsigned char* ws; int ph_lo, ph_hi;
};

__device__ __forceinline__ void p0_transpose_item(const float* W, int K, int N, const float* s0, const float* s1, int ksplit,
                                                  h16* WT, int ldt, int mode, int nblk, float* scr, int item, int lane) {
    const int kb = item / nblk, nb = item % nblk, k0 = 64 * kb, n0 = 32 * nb;
#pragma unroll 8
    for (int i = 0; i < 32; ++i) {
        const int kk = 2 * i + (lane >> 5), n = n0 + (lane & 31), k = k0 + kk;
        float v = 0.f;
        if (n < N) { v = W[(size_t)k * N + n]; if (s0) v *= (k < ksplit) ? s0[k] : s1[k - ksplit]; }
        scr[kk * 33 + (lane & 31)] = v;
    }
    LDS_WAIT();
    const int c = lane & 7;
#pragma unroll
    for (int j = 0; j < 4; ++j) {
        const int nl = (lane >> 3) + 8 * j, n = n0 + nl;
        const float* s = scr + (8 * c) * 33 + nl;
        h16x8 o;
#pragma unroll
        for (int e = 0; e < 8; ++e) o[e] = (h16)s[e * 33];
        int orow = n;
        if (mode == 1) orow = (n >> 7) * 256 + (n & 127);
        else if (mode == 2) orow = (n >> 7) * 256 + (n & 127) + 128;
        *(h16x8*)(WT + (size_t)orow * ldt + k0 + 8 * c) = o;
    }
    LDS_WAIT();
}

__device__ __forceinline__ void phase0(const Params& P, unsigned char* lds, int tid, int lane, int wave, int bid, int nb) {
    unsigned char* ws = P.ws;
    float* scr = (float*)lds + wave * (64 * 33);
    const int gw = bid * NWAVES + wave, ngw = nb * NWAVES;
    constexpr int I_IN = 16 * 80, I_OUT = 16 * 32, I_G = 16 * 88, I_U = 16 * 88, I_D = 44 * 32, I_C1 = 32 * 8, I_C2 = 4 * 2;
    constexpr int NIT = I_IN + I_OUT + I_G + I_U + I_D + 2 * I_C1 + 2 * I_C2;
    for (int it = gw; it < NIT; it += ngw) {
        int r = it;
        const float* W; int K, N; const float* s0 = nullptr; const float* s1 = nullptr; int ksplit = 0; size_t wo; int ldt, mode = 0, nblk;
        if (r < I_IN) { W = P.w_in; K = 1024; N = DIN; s0 = P.attn_norm_w; s1 = P.attn_norm_w; ksplit = 1024; wo = WS_WIN; ldt = 1024; nblk = 80; }
        else if ((r -= I_IN) < I_OUT) { W = P.w_out; K = 1024; N = 1024; s0 = P.rnn_out_norm_w; s1 = P.attn_out_norm_w; ksplit = 512; wo = WS_WOUT; ldt = 1024; nblk = 32; }
        else if ((r -= I_OUT) < I_G) { W = P.w_gate; K = 1024; N = DFF; s0 = P.ffn_norm_w; s1 = P.ffn_norm_w; ksplit = 1024; wo = WS_WGU; ldt = 1024; mode = 1; nblk = 88; }
        else if ((r -= I_G) < I_U) { W = P.w_up; K = 1024; N = DFF; s0 = P.ffn_norm_w; s1 = P.ffn_norm_w; ksplit = 1024; wo = WS_WGU; ldt = 1024; mode = 2; nblk = 88; }
        else if ((r -= I_U) < I_D) { W = P.w_down; K = DFF; N = 1024; wo = WS_WD; ldt = DFF; nblk = 32; }
        else if ((r -= I_D) < I_C1) { W = P.cmp_k_w1; K = CMPK; N = CMPH; wo = WS_W1K; ldt = CMPK; nblk = 8; }
        else if ((r -= I_C1) < I_C1) { W = P.cmp_v_w1; K = CMPK; N = CMPH; wo = WS_W1V; ldt = CMPK; nblk = 8; }
        else if ((r -= I_C1) < I_C2) { W = P.cmp_k_w2; K = CMPH; N = HD; wo = WS_W2K; ldt = CMPH; nblk = 2; }
        else { r -= I_C2; W = P.cmp_v_w2; K = CMPH; N = HD; wo = WS_W2V; ldt = CMPH; nblk = 2; }
        p0_transpose_item(W, K, N, s0, s1, ksplit, (h16*)(ws + wo), ldt, mode, nblk, scr, r, lane);
    }
    h16* XH = (h16*)(ws + WS_XH); float* RSTD1 = (float*)(ws + WS_RSTD1);
    for (int m = gw; m < M; m += ngw) {
        const f32x4* xr = (const f32x4*)(P.x + (size_t)m * D) + lane;
        f32x4 v[4]; float s = 0.f;
#pragma unroll
        for (int j = 0; j < 4; ++j) { v[j] = xr[64 * j]; s += (v[j].x * v[j].x + v[j].y * v[j].y) + (v[j].z * v[j].z + v[j].w * v[j].w); }
        s = wave_sum(s);
        if (lane == 0) RSTD1[m] = 1.0f / sqrtf(s * (1.0f / D) + EPS);
        h16x4* o = (h16x4*)(XH + (size_t)m * D) + lane;
#pragma unroll
        for (int j = 0; j < 4; ++j) { h16x4 h; h.x = (h16)v[j].x; h.y = (h16)v[j].y; h.z = (h16)v[j].z; h.w = (h16)v[j].w; o[64 * j] = h; }
    }
    float* ROPE = (float*)(ws + WS_ROPE);
    for (int e = bid * NTHREADS + tid; e < M * 8; e += nb * NTHREADS) {
        const int m = e >> 3, i = e & 7;
        const float inv = (float)pow(500000.0, -(double)i / 8.0);
        const float ang = (float)P.pos[m] * inv;
        ROPE[m * 16 + i] = (float)cos((double)ang);
        ROPE[m * 16 + 8 + i] = (float)sin((double)ang);
    }
    if (bid < 64) {
        const int which = bid >> 5, n = (bid & 31) * 8 + (tid & 7), ks = tid >> 3;
        const float* w1 = (which ? P.cmp_v_w1 : P.cmp_k_w1) + n; const float* cp = P.cmp_pos + ks * 32;
        float s = 0.f;
#pragma unroll
        for (int k = 0; k < 32; ++k) s += cp[k] * w1[(size_t)(ks * 32 + k) * CMPH];
        float* red = (float*)lds + NWAVES * 64 * 33;
        red[tid] = s;
        __syncthreads();
        if (tid < 8) { float a = 0.f; for (int q = 0; q < 64; ++q) a += red[q * 8 + tid]; ((float*)(ws + WS_B1))[which * 256 + (bid & 31) * 8 + tid] = a; }
        __syncthreads();
    }
    if (bid == 64 % nb) {
        h16* kp = (h16*)(ws + WS_KCT) + (size_t)16 * T * 64; h16* vp = (h16*)(ws + WS_VCT) + (size_t)16 * T * 64;
        for (int e = tid; e < 2048; e += NTHREADS) { kp[e] = (h16)0.f; vp[e] = (h16)0.f; }
    }
}

struct GemmN { const h16* A1; int lda1; const h16* B1; int ldb1; int K1; const h16* A2; int lda2; const h16* B2; int ldb2; int K2; int Mr, Nc; int bmap; };
template <bool DUAL, class Epi>
__device__ __forceinline__ void gemm_naive(const GemmN& g, const Epi& epi, int gw, int ngw, int lane) {
    const int tn = g.Nc / 64, tm = g.Mr / 64, ntile = tm * tn;
    const int fr = lane & 15, fq = lane >> 4;
    for (int tile = gw; tile < ntile; tile += ngw) {
        const int tr = tile / tn, tc = tile % tn;
        f32x4 acc1[4][4], acc2[4][4];
#pragma unroll
        for (int i = 0; i < 4; ++i)
#pragma unroll
            for (int j = 0; j < 4; ++j) { acc1[i][j] = (f32x4){0.f, 0.f, 0.f, 0.f}; acc2[i][j] = (f32x4){0.f, 0.f, 0.f, 0.f}; }
        const int bcol = tc * 64 + fr;
        const int brow0 = g.bmap ? ((bcol >> 7) * 256 + (bcol & 127)) : bcol;
        {
            const h16* ap = g.A1 + (size_t)(tr * 64 + fr) * g.lda1 + fq * 8;
            const h16* bp = g.B1 + (size_t)brow0 * g.ldb1 + fq * 8;
            for (int k0 = 0; k0 < g.K1; k0 += 32) {
                h16x8 a[4], b[4];
#pragma unroll
                for (int i = 0; i < 4; ++i) a[i] = *(const h16x8*)(ap + (size_t)i * 16 * g.lda1 + k0);
#pragma unroll
                for (int j = 0; j < 4; ++j) b[j] = *(const h16x8*)(bp + (size_t)j * 16 * g.ldb1 + k0);
#pragma unroll
                for (int i = 0; i < 4; ++i)
#pragma unroll
                    for (int j = 0; j < 4; ++j) acc1[i][j] = __builtin_amdgcn_mfma_f32_16x16x32_f16(a[i], b[j], acc1[i][j], 0, 0, 0);
            }
        }
        if (DUAL) {
            const h16* ap = g.A2 + (size_t)(tr * 64 + fr) * g.lda2 + fq * 8;
            const h16* bp = g.B2 + (size_t)(brow0 + (g.bmap ? 128 : 0)) * g.ldb2 + fq * 8;
            for (int k0 = 0; k0 < g.K2; k0 += 32) {
                h16x8 a[4], b[4];
#pragma unroll
                for (int i = 0; i < 4; ++i) a[i] = *(const h16x8*)(ap + (size_t)i * 16 * g.lda2 + k0);
#pragma unroll
                for (int j = 0; j < 4; ++j) b[j] = *(const h16x8*)(bp + (size_t)j * 16 * g.ldb2 + k0);
#pragma unroll
                for (int i = 0; i < 4; ++i)
#pragma unroll
                    for (int j = 0; j < 4; ++j) acc2[i][j] = __builtin_amdgcn_mfma_f32_16x16x32_f16(a[i], b[j], acc2[i][j], 0, 0, 0);
            }
        }
#pragma unroll
        for (int i = 0; i < 4; ++i)
#pragma unroll
            for (int j = 0; j < 4; ++j)
#pragma unroll
                for (int r = 0; r < 4; ++r) epi(tr * 64 + 16 * i + 4 * fq + r, tc * 64 + 16 * j + fr, acc1[i][j][r], DUAL ? acc2[i][j][r] : 0.f);
    }
}

struct EpiProj {
    unsigned char* ws;
    __device__ __forceinline__ void operator()(int m, int c, float v, float) const {
        v *= ((const float*)(ws + WS_RSTD1))[m];
        if (c < 512) { ((h16*)(ws + WS_XR))[(size_t)m * 512 + c] = (h16)v; return; }
        if (c < 1024) { ((h16*)(ws + WS_GRG))[(size_t)m * 512 + c - 512] = (h16)gelu_tanh(v); return; }
        if (c < 1536) { ((h16*)(ws + WS_Q))[(size_t)m * 512 + c - 1024] = (h16)v; return; }
        if (c < 2304) {
            const int idx = (c - 1536) >> 7, cc = (c - 1536) & 127, g = cc >> 6, d = cc & 63, b = m >> 12, t = m & 4095;
            const size_t off = ((size_t)(b * 2 + g) * T + t) * 64 + d;
            h16* base = (h16*)(ws + (idx == 0 ? WS_KCT : idx == 1 ? WS_VCT : idx == 2 ? WS_KS : idx == 3 ? WS_VS : idx == 4 ? WS_KW : WS_VW));
            base[off] = (h16)v; return;
        }
        if (c < DIN) ((float*)(ws + WS_GATE))[(size_t)m * 24 + c - 2304] = sigmoidf_(v);
    }
};
struct EpiCmpA {
    h16* H1; const float* b1;
    __device__ __forceinline__ void operator()(int r, int c, float v, float) const { H1[(size_t)r * CMPH + c] = (h16)gelu_tanh(v + b1[c]); }
};
struct EpiCmpB {
    float* O;
    __device__ __forceinline__ void operator()(int r, int c, float v, float) const { O[(size_t)r * HD + c] = v; }
};
struct EpiOut {
    const float* x; float* out; h16* x1h; const float* rsr; const float* ssa2;
    __device__ __forceinline__ void operator()(int m, int c, float v1, float v2) const {
        const float s1 = rsr[m], s2 = 1.0f / sqrtf((ssa2[m * 2] + ssa2[m * 2 + 1]) * (1.0f / 512.0f) + EPS);
        const float x1 = x[(size_t)m * D + c] + s1 * v1 + s2 * v2;
        out[(size_t)m * D + c] = x1; x1h[(size_t)m * D + c] = (h16)x1;
    }
};
struct EpiGU {
    h16* hm; const float* rstd2;
    __device__ __forceinline__ void operator()(int m, int c, float vg, float vu) const {
        const float r = rstd2[m], g = vg * r, u = vu * r;
        hm[(size_t)m * DFF + c] = (h16)(g * sigmoidf_(g) * u);
    }
};
struct EpiDown {
    float* out;
    __device__ __forceinline__ void operator()(int m, int c, float v, float) const { out[(size_t)m * D + c] += v; }
};

namespace pg8 {
#define PG8_LAS __attribute__((address_space(3)))
typedef unsigned short bf16_t;
typedef _Float16 bf16x8 __attribute__((ext_vector_type(8)));
typedef float f32x4 __attribute__((ext_vector_type(4)));
typedef unsigned u32x4 __attribute__((ext_vector_type(4)));
constexpr int BM = 256, BK = 64, HALF = 128, HTB = HALF * BK * 2  , STAGE_BYTES = 8 * HTB, NXCD = 8, WGM = 8;

__host__ __device__ __forceinline__ int lds_byte(int r, int c) { const int st = (r >> 4) * 2 + (c >> 5), rr = r & 15, cc = c & 31, ob = rr * 64 + cc * 2; return st * 1024 + (ob ^ (((ob >> 9) & 1) << 5)); }
__host__ __device__ __forceinline__ void stage_rc(int b, int& R, int& C) { const int st = b / 1024, sb = b % 1024, swz = sb ^ (((sb >> 9) & 1) << 5); R = (st >> 1) * 16 + swz / 64; C = (st & 1) * 32 + (swz % 64) / 2; }
__host__ __device__ __forceinline__ int perm32(int rho) { const int n = rho >> 4, i = rho & 15; return 8 * (i >> 2) + 4 * n + (i & 3); }

struct Unit { int pm, pn; };
struct Gemm { const bf16_t* A; const bf16_t* Bt; int M, N, K; };

struct StaticOrder {
    int nM, nN, nwg, G, c;
    __host__ __device__ void init(int M, int N, int G_, int c_) { nM = M / BM; nN = N / BM; nwg = nM * nN; G = G_; c = c_; }
    __host__ __device__ bool next(int i, Unit& u) const {
        const long L = (long)i * G + c; if (L >= nwg) return false;
        int wgid = (int)L; { const int q = nwg / NXCD, r = nwg % NXCD, xcd = wgid % NXCD, off = wgid / NXCD; wgid = (xcd < r ? xcd * (q + 1) : r * (q + 1) + (xcd - r) * q) + off; }
        const int nig = WGM * nN, gid = wgid / nig, fm = gid * WGM, gsz = (nM - fm) < WGM ? (nM - fm) : WGM;
        u.pm = fm + ((wgid % nig) % gsz); u.pn = (wgid % nig) / gsz; return true;
    }
    __device__ __forceinline__ void a_ready(const Unit&) const {}
    __device__ __forceinline__ void done(const Unit&) const {}
};
template <class Epi, class Sched, bool ALIGN_EPI = false, bool SP2 = false>
__device__ __forceinline__ void gemm_phase(PG8_LAS unsigned char* lds, const Gemm g, const Sched& S, const Epi& E) {
    const int tid = threadIdx.x, wid = __builtin_amdgcn_readfirstlane(tid >> 6), lane = tid & 63, wr = wid >> 2, wc = wid & 3, fr = lane & 15, fq = lane >> 4;
    const int K = g.K, nt = K / BK;
    unsigned voffA[2], voffB[2];
#pragma unroll
    for (int i = 0; i < 2; ++i) { int R, C; stage_rc(tid * 16 + i * 8192, R, C); const int Rb = Epi::PERM ? ((R & ~31) + perm32(R & 31)) : R;
        voffA[i] = (unsigned)(R * K + C) * 2u; voffB[i] = (unsigned)(Rb * K + C) * 2u; }
    const size_t kstep = (size_t)(BK * 2);
    const size_t hstep = (size_t)HALF * K * 2;
    const size_t tstep = 2 * hstep;
    const unsigned ldsw = (unsigned)wid * 1024u;
    const int aoff = lds_byte(wr * 64 + fr, fq * 8), boff = lds_byte(wc * 32 + fr, fq * 8);
#define PG8_SA(b, h) (((b) * 2 + (h)) * HTB)
#define PG8_SB(b, h) ((4 + (b) * 2 + (h)) * HTB)
#define PG8_STAGE(bufoff, gbase, voff) do { _Pragma("unroll") for (int _i = 0; _i < 2; ++_i) \
        __builtin_amdgcn_global_load_lds((const unsigned*)((const char*)(gbase) + (voff)[_i]), (PG8_LAS unsigned*)(lds + (bufoff) + ldsw + _i * 8192), 16, 0, 0); } while (0)
#define PG8_LDA(dst, b, h) do { _Pragma("unroll") for (int m = 0; m < 4; ++m) _Pragma("unroll") for (int k = 0; k < 2; ++k) dst[m][k] = *(const PG8_LAS bf16x8*)(lds + PG8_SA(b, h) + aoff + m * 2048 + k * 1024); } while (0)
#define PG8_LDB(dst, b, h) do { _Pragma("unroll") for (int n = 0; n < 2; ++n) _Pragma("unroll") for (int k = 0; k < 2; ++k) dst[n][k] = *(const PG8_LAS bf16x8*)(lds + PG8_SB(b, h) + boff + n * 2048 + k * 1024); } while (0)
#define PG8_MMA(ai, bj, At, Bt) do { __builtin_amdgcn_s_setprio(1); _Pragma("unroll") for (int m = 0; m < 4; ++m) _Pragma("unroll") for (int n = 0; n < 2; ++n) _Pragma("unroll") for (int k = 0; k < 2; ++k) \
        acc[ai][bj][m][n] = __builtin_amdgcn_mfma_f32_16x16x32_f16(Bt[n][k], At[m][k], acc[ai][bj][m][n], 0, 0, 0); __builtin_amdgcn_s_setprio(0); } while (0)
#define PG8_WAIT_V(n) asm volatile("s_waitcnt vmcnt(" #n ")" ::: "memory")
#define PG8_WAIT_L(n) asm volatile("s_waitcnt lgkmcnt(" #n ")" ::: "memory")
#define PG8_BAR __builtin_amdgcn_s_barrier()
#define PG8_SCHED __builtin_amdgcn_sched_barrier(0)
    Unit cur, nxt; int ui = 0;
    if (!S.next(0, cur)) return;
    f32x4 acc[2][2][4][2];
#pragma unroll
    for (int a = 0; a < 2; ++a)
#pragma unroll
        for (int b = 0; b < 2; ++b)
#pragma unroll
            for (int m = 0; m < 4; ++m)
#pragma unroll
                for (int n = 0; n < 2; ++n) acc[a][b][m][n] = (f32x4){0.f, 0.f, 0.f, 0.f};
    bf16x8 At[4][2], B0[2][2], B1[2][2];
    const char* cA = (const char*)g.A + (size_t)cur.pm * tstep; const char* cB = (const char*)g.Bt + (size_t)cur.pn * tstep;
    S.a_ready(cur);
    if constexpr (SP2) {
        PG8_STAGE(PG8_SB(0, 0), cB, voffB); PG8_STAGE(PG8_SB(0, 1), cB + hstep, voffB); PG8_STAGE(PG8_SA(0, 0), cA, voffA); PG8_STAGE(PG8_SA(0, 1), cA + hstep, voffA);
        if (wr == 1) PG8_BAR;
        PG8_WAIT_V(2); PG8_BAR;
        PG8_STAGE(PG8_SB(1, 0), cB + kstep, voffB); PG8_STAGE(PG8_SA(1, 0), cA + kstep, voffA); PG8_STAGE(PG8_SB(1, 1), cB + hstep + kstep, voffB);
        PG8_WAIT_V(6); PG8_BAR;
    } else {
        PG8_STAGE(PG8_SB(0, 0), cB, voffB); PG8_STAGE(PG8_SA(0, 0), cA, voffA); PG8_STAGE(PG8_SB(0, 1), cB + hstep, voffB); PG8_STAGE(PG8_SA(0, 1), cA + hstep, voffA);
        if (wr == 1) PG8_BAR;
        PG8_WAIT_V(4); PG8_BAR;
        PG8_STAGE(PG8_SB(1, 0), cB + kstep, voffB); PG8_STAGE(PG8_SA(1, 0), cA + kstep, voffA); PG8_STAGE(PG8_SB(1, 1), cB + hstep + kstep, voffB);
        PG8_WAIT_V(6); PG8_BAR;
    }
    for (;;) {
        const bool has_next = S.next(ui + 1, nxt);
        const char* nA = has_next ? (const char*)g.A + (size_t)nxt.pm * tstep : cA; const char* nB = has_next ? (const char*)g.Bt + (size_t)nxt.pn * tstep : cB;
        for (int t = 0; t < nt; t += 2) {
            const bool last = (t == nt - 2);
            const char* a1 = cA + (size_t)(t + 1) * kstep;
            const char* a2 = last ? nA : cA + (size_t)(t + 2) * kstep; const char* b2 = last ? nB : cB + (size_t)(t + 2) * kstep;
            const char* a3 = a2 + kstep; const char* b3 = b2 + kstep;
            if (last && has_next) S.a_ready(nxt);
            if constexpr (Epi::MIDK) { if (t == nt / 2) E.mid(acc, cur, wr, wc, fr, fq); }
            if constexpr (SP2) {
            PG8_LDB(B0, 0, 0); PG8_LDB(B1, 0, 1); PG8_SCHED; PG8_LDA(At, 0, 0); PG8_STAGE(PG8_SA(1, 1), a1 + hstep, voffA);
            PG8_WAIT_V(8); PG8_WAIT_L(0); PG8_BAR; PG8_MMA(0, 0, At, B0); PG8_MMA(0, 1, At, B1); PG8_BAR; PG8_SCHED;
            PG8_LDA(At, 0, 1); PG8_STAGE(PG8_SB(0, 0), b2, voffB); PG8_STAGE(PG8_SB(0, 1), b2 + hstep, voffB); PG8_STAGE(PG8_SA(0, 0), a2, voffA);
            PG8_WAIT_V(8); PG8_WAIT_L(0); PG8_BAR; PG8_MMA(1, 0, At, B0); PG8_MMA(1, 1, At, B1); PG8_BAR; PG8_SCHED;
            PG8_LDB(B0, 1, 0); PG8_LDB(B1, 1, 1); PG8_SCHED; PG8_LDA(At, 1, 0); PG8_STAGE(PG8_SA(0, 1), a2 + hstep, voffA);
            PG8_WAIT_V(8); PG8_WAIT_L(0); PG8_BAR; PG8_MMA(0, 0, At, B0); PG8_MMA(0, 1, At, B1); PG8_BAR; PG8_SCHED;
            PG8_LDA(At, 1, 1); PG8_STAGE(PG8_SB(1, 0), b3, voffB); PG8_STAGE(PG8_SB(1, 1), b3 + hstep, voffB); PG8_STAGE(PG8_SA(1, 0), a3, voffA);
            PG8_WAIT_V(8); PG8_WAIT_L(0); PG8_BAR; PG8_MMA(1, 0, At, B0); PG8_MMA(1, 1, At, B1); PG8_BAR; PG8_SCHED;
            } else {
            PG8_LDB(B0, 0, 0); PG8_SCHED; PG8_LDA(At, 0, 0); PG8_STAGE(PG8_SA(1, 1), a1 + hstep, voffA);
            PG8_WAIT_L(8); PG8_BAR; PG8_WAIT_L(0); PG8_MMA(0, 0, At, B0); PG8_BAR; PG8_SCHED;
            PG8_LDB(B1, 0, 1); PG8_STAGE(PG8_SB(0, 0), b2, voffB);
            PG8_BAR; PG8_WAIT_L(0); PG8_MMA(0, 1, At, B1); PG8_BAR;
            PG8_LDA(At, 0, 1); PG8_STAGE(PG8_SA(0, 0), a2, voffA);
            PG8_BAR; PG8_WAIT_L(0); PG8_MMA(1, 0, At, B0); PG8_BAR; PG8_SCHED;
            PG8_STAGE(PG8_SB(0, 1), b2 + hstep, voffB);
            PG8_WAIT_V(6); PG8_BAR; PG8_MMA(1, 1, At, B1); PG8_BAR;
            PG8_LDB(B0, 1, 0); PG8_SCHED; PG8_LDA(At, 1, 0); PG8_STAGE(PG8_SA(0, 1), a2 + hstep, voffA);
            PG8_WAIT_L(8); PG8_BAR; PG8_WAIT_L(0); PG8_MMA(0, 0, At, B0); PG8_BAR; PG8_SCHED;
            PG8_LDB(B1, 1, 1); PG8_STAGE(PG8_SB(1, 0), b3, voffB);
            PG8_BAR; PG8_WAIT_L(0); PG8_MMA(0, 1, At, B1); PG8_BAR;
            PG8_LDA(At, 1, 1); PG8_STAGE(PG8_SA(1, 0), a3, voffA);
            PG8_BAR; PG8_WAIT_L(0); PG8_MMA(1, 0, At, B0); PG8_BAR; PG8_SCHED;
            PG8_STAGE(PG8_SB(1, 1), b3 + hstep, voffB);
            PG8_WAIT_V(6); PG8_BAR; PG8_MMA(1, 1, At, B1); PG8_BAR;
            }
        }
        if constexpr (ALIGN_EPI) { if (wr == 0) PG8_BAR; }
        if constexpr (!Epi::AFTER_DRAIN) { E(acc, cur, wr, wc, fr, fq); S.done(cur); }
        if (!has_next) break;
#pragma unroll
        for (int a = 0; a < 2; ++a)
#pragma unroll
            for (int b = 0; b < 2; ++b)
#pragma unroll
                for (int m = 0; m < 4; ++m)
#pragma unroll
                    for (int n = 0; n < 2; ++n) acc[a][b][m][n] = (f32x4){0.f, 0.f, 0.f, 0.f};
        cur = nxt; cA = nA; cB = nB; ++ui;
        if constexpr (ALIGN_EPI) { if (wr == 1) PG8_BAR; }
    }
    PG8_WAIT_V(0);
    if constexpr (!ALIGN_EPI) { if (wr == 0) PG8_BAR; }
    PG8_BAR;
    if constexpr (Epi::AFTER_DRAIN) { E.fused(acc, cur, wr, wc, fr, fq, lds, wid, lane); S.done(cur); }
#undef PG8_SA
#undef PG8_SB
#undef PG8_STAGE
#undef PG8_LDA
#undef PG8_LDB
#undef PG8_MMA
#undef PG8_WAIT_V
#undef PG8_WAIT_L
#undef PG8_BAR
#undef PG8_SCHED
}
}

__device__ __forceinline__ float fsigmoid(float x) { return __builtin_amdgcn_rcpf(1.0f + __builtin_amdgcn_exp2f(-1.4426950408889634f * x)); }
__device__ __forceinline__ float fgelu_tanh(float x) { const float u2 = 1.5957691216057308f * (x + 0.044715f * x * x * x); return x * fsigmoid(u2); }
__device__ __forceinline__ h16x8 pack8(const f32x4 a, const f32x4 b) {
    h16x8 o; o[0] = (h16)a[0]; o[1] = (h16)a[1]; o[2] = (h16)a[2]; o[3] = (h16)a[3]; o[4] = (h16)b[0]; o[5] = (h16)b[1]; o[6] = (h16)b[2]; o[7] = (h16)b[3]; return o;
}
struct EpiProjF {
    static constexpr bool PERM = true, AFTER_DRAIN = false, MIDK = false;
    unsigned char* ws;
    __device__ __forceinline__ void operator()(const f32x4 (&acc)[2][2][4][2], const pg8::Unit& u, int wr, int wc, int fr, int fq) const {
        const float* RSTD1 = (const float*)(ws + WS_RSTD1);
        const int row0 = u.pm * 256 + wr * 64 + fr, pn = u.pn, c8 = wc * 32 + 8 * fq;
#pragma unroll
        for (int ai = 0; ai < 2; ++ai)
#pragma unroll
            for (int m = 0; m < 4; ++m) {
                const int row = row0 + ai * 128 + m * 16; const float rs = RSTD1[row];
#pragma unroll
                for (int bj = 0; bj < 2; ++bj) {
                    f32x4 v0 = acc[ai][bj][m][0] * rs, v1 = acc[ai][bj][m][1] * rs;
                    const int cb = bj * 128 + c8;
                    if (pn < 2) { *(h16x8*)((h16*)(ws + WS_XR) + (size_t)row * 512 + pn * 256 + cb) = pack8(v0, v1); }
                    else if (pn < 4) {
#pragma unroll
                        for (int e = 0; e < 4; ++e) { v0[e] = fgelu_tanh(v0[e]); v1[e] = fgelu_tanh(v1[e]); }
                        *(h16x8*)((h16*)(ws + WS_GRG) + (size_t)row * 512 + (pn - 2) * 256 + cb) = pack8(v0, v1); }
                    else if (pn < 6) { *(h16x8*)((h16*)(ws + WS_Q) + (size_t)row * 512 + (pn - 4) * 256 + cb) = pack8(v0, v1); }
                    else if (pn < 9) {
                        const int idx = 2 * (pn - 6) + bj, g = c8 >> 6, d = c8 & 63, b = row >> 12, t = row & 4095;
                        h16* base = (h16*)(ws + (idx == 0 ? WS_KCT : idx == 1 ? WS_VCT : idx == 2 ? WS_KS : idx == 3 ? WS_VS : idx == 4 ? WS_KW : WS_VW));
                        *(h16x8*)(base + ((size_t)(b * 2 + g) * T + t) * 64 + d) = pack8(v0, v1); }
                    else if (bj == 0 && c8 < 24) {
                        float* gp = (float*)(ws + WS_GATE) + (size_t)row * 24 + c8;
#pragma unroll
                        for (int e = 0; e < 4; ++e) { v0[e] = fsigmoid(v0[e]); v1[e] = fsigmoid(v1[e]); }
                        *(f32x4*)gp = v0; *(f32x4*)(gp + 4) = v1; }
                }
            }
    }
};
struct EpiOutF {
    static constexpr bool PERM = false, AFTER_DRAIN = false, MIDK = true;
    const float* x; float* out; h16* x1h; const float* rsr; const float* ssa2; float* ss2p;
    __device__ __forceinline__ float rsa_of(int row) const { const f32x2 a = *(const f32x2*)(ssa2 + (size_t)row * 2); return 1.0f / sqrtf((a[0] + a[1]) * (1.0f / 512.0f) + EPS); }
    __device__ __forceinline__ void mid(f32x4 (&acc)[2][2][4][2], const pg8::Unit& u, int wr, int wc, int fr, int fq) const {
        int row0 = u.pm * 256 + wr * 64 + fr; asm volatile("" : "+v"(row0));
#pragma unroll
        for (int ai = 0; ai < 2; ++ai)
#pragma unroll
            for (int m = 0; m < 4; ++m) { const int row = row0 + ai * 128 + m * 16; const float ratio = rsr[row] / rsa_of(row);
#pragma unroll
                for (int bj = 0; bj < 2; ++bj)
#pragma unroll
                    for (int n = 0; n < 2; ++n) acc[ai][bj][m][n] *= ratio; }
    }
    __device__ __forceinline__ void operator()(const f32x4 (&acc)[2][2][4][2], const pg8::Unit& u, int wr, int wc, int fr, int fq) const {
        const int row0 = u.pm * 256 + wr * 64 + fr, col0 = u.pn * 256 + wc * 32 + 4 * fq;
#pragma unroll
        for (int ai = 0; ai < 2; ++ai)
#pragma unroll
            for (int m = 0; m < 4; ++m) { const int row = row0 + ai * 128 + m * 16; const float s2 = rsa_of(row); float ss = 0.f;
#pragma unroll
                for (int bj = 0; bj < 2; ++bj)
#pragma unroll
                    for (int n = 0; n < 2; ++n) { const size_t off = (size_t)row * D + col0 + bj * 128 + n * 16;
                        const f32x4 v = *(const f32x4*)(x + off) + acc[ai][bj][m][n] * s2;
                        *(f32x4*)(out + off) = v; h16x4 h; h[0] = (h16)v[0]; h[1] = (h16)v[1]; h[2] = (h16)v[2]; h[3] = (h16)v[3]; *(h16x4*)(x1h + off) = h;
                        ss += (v[0] * v[0] + v[1] * v[1]) + (v[2] * v[2] + v[3] * v[3]); }
                ss += __shfl_xor(ss, 16); ss += __shfl_xor(ss, 32);
                if (fq == 0) ss2p[(size_t)row * 16 + u.pn * 4 + wc] = ss;
                if (m & 1) asm volatile("" ::: "memory"); }
    }
};
struct EpiGUF {
    static constexpr bool PERM = true, AFTER_DRAIN = false, MIDK = false;
    h16* hm; const float* ss2p;
    __device__ __forceinline__ void operator()(const f32x4 (&acc)[2][2][4][2], const pg8::Unit& u, int wr, int wc, int fr, int fq) const {
        const int row0 = u.pm * 256 + wr * 64 + fr, col = u.pn * 128 + wc * 32 + 8 * fq;
#pragma unroll
        for (int ai = 0; ai < 2; ++ai)
#pragma unroll
            for (int m = 0; m < 4; ++m) { const int row = row0 + ai * 128 + m * 16; const f32x4* sp = (const f32x4*)(ss2p + (size_t)row * 16);
                const f32x4 s0 = sp[0], s1 = sp[1], s2 = sp[2], s3 = sp[3];
                const float tot = ((s0[0] + s0[1]) + (s0[2] + s0[3])) + ((s1[0] + s1[1]) + (s1[2] + s1[3])) + ((s2[0] + s2[1]) + (s2[2] + s2[3])) + ((s3[0] + s3[1]) + (s3[2] + s3[3]));
                const float rs = 1.0f / sqrtf(tot * (1.0f / D) + EPS);
                f32x4 o[2];
#pragma unroll
                for (int n = 0; n < 2; ++n) { const f32x4 g = acc[ai][0][m][n] * rs, uu = acc[ai][1][m][n] * rs;
#pragma unroll
                    for (int e = 0; e < 4; ++e) o[n][e] = g[e] * fsigmoid(g[e]) * uu[e]; }
                *(h16x8*)(hm + (size_t)row * DFF + col) = pack8(o[0], o[1]); }
    }
};
struct EpiDownF {
    static constexpr bool PERM = false, AFTER_DRAIN = false, MIDK = false;
    float* out;
    __device__ __forceinline__ void operator()(const f32x4 (&acc)[2][2][4][2], const pg8::Unit& u, int wr, int wc, int fr, int fq) const {
        const int row0 = u.pm * 256 + wr * 64 + fr, col0 = u.pn * 256 + wc * 32 + 4 * fq;
#pragma unroll
        for (int ai = 0; ai < 2; ++ai)
#pragma unroll
            for (int m = 0; m < 4; ++m) { const int row = row0 + ai * 128 + m * 16;
#pragma unroll
                for (int bj = 0; bj < 2; ++bj)
#pragma unroll
                    for (int n = 0; n < 2; ++n) { float* p = out + (size_t)row * D + col0 + bj * 128 + n * 16; *(f32x4*)p = *(const f32x4*)p + acc[ai][bj][m][n]; } }
    }
};

__device__ __forceinline__ void normrope_rows(const Params& P, int gw, int ngw, int lane) {
    unsigned char* ws = P.ws;
    const float* ROPE = (const float*)(ws + WS_ROPE);
    const int sub = lane & 7;
    for (int m = gw; m < M; m += ngw) {
        const int b = m >> 12, t = m & 4095;
        float cs[8], sn[8];
#pragma unroll
        for (int i = 0; i < 8; ++i) { cs[i] = ROPE[m * 16 + i]; sn[i] = ROPE[m * 16 + 8 + i]; }
#pragma unroll
        for (int which = 0; which < 3; ++which) {
            h16* p; const float* nw; float scale;
            bool act = true;
            if (which == 0) { p = (h16*)(ws + WS_Q) + (size_t)m * 512 + (lane >> 3) * 64 + sub * 8; nw = P.q_norm_w; scale = C2; }
            else { act = lane < 16; const int g = (lane >> 3) & 1; p = (h16*)(ws + (which == 1 ? WS_KS : WS_KW)) + ((size_t)(b * 2 + g) * T + t) * 64 + sub * 8; nw = P.k_norm_w; scale = 1.0f; }
            float v[8]; float ss = 0.f;
            if (act) { const h16x8 h = *(const h16x8*)p;
#pragma unroll
                for (int e = 0; e < 8; ++e) { v[e] = (float)h[e]; ss += v[e] * v[e]; } }
            else {
#pragma unroll
                for (int e = 0; e < 8; ++e) v[e] = 0.f; }
            ss += __shfl_xor(ss, 1); ss += __shfl_xor(ss, 2); ss += __shfl_xor(ss, 4);
            const float rstd = 1.0f / sqrtf(ss * (1.0f / 64.0f) + EPS);
#pragma unroll
            for (int e = 0; e < 8; ++e) v[e] = v[e] * rstd * nw[sub * 8 + e];
            float o[8];
#pragma unroll
            for (int e = 0; e < 8; ++e) {
                const float other = __shfl_xor(v[e], 1);
                if (sub == 0) o[e] = v[e] * cs[e] - other * sn[e];
                else if (sub == 1) o[e] = v[e] * cs[e] + other * sn[e];
                else o[e] = v[e];
            }
            if (act) { h16x8 h;
#pragma unroll
                for (int e = 0; e < 8; ++e) h[e] = (h16)(o[e] * scale);
                *(h16x8*)p = h; }
        }
    }
}

constexpr int RL_WT = 0;
constexpr int RL_XCF = 16384;
constexpr int RL_AGW = RL_XCF + 8 * 16 * 68 * 4;
constexpr int RL_TRS = RL_AGW + 2 * 8 * 2 * 64 * 4;
constexpr int RL_END = RL_TRS + 8 * 2048;
__device__ __forceinline__ void rglru_local(const Params& P, unsigned char* lds_g, int tid_in, int lane_in, int wave, int bid, int nb) {
    unsigned char* ws = P.ws;
    LAS3 unsigned char* lds = (LAS3 unsigned char*)lds_g;
    const h16* XR = (const h16*)(ws + WS_XR);
    h16* HL = (h16*)(ws + WS_HL); h16* AC = (h16*)(ws + WS_AC); float* AGG = (float*)(ws + WS_AGG);
    int n_loaded = -1, it = 0;
    for (int item = bid; item < 8 * 8 * 32; item += nb, ++it) {
        int lane = lane_in; asm volatile("" : "+v"(lane));
        const int tid = wave * 64 + lane, fr = lane & 15, fq = lane >> 4;
        const int n = item & 7, b = (item >> 3) & 7, ck = item >> 6;
        if (n != n_loaded) {
            __syncthreads();
            LAS3 h16* WT = (LAS3 h16*)(lds + RL_WT);
            for (int e = tid; e < 8192; e += NTHREADS) { const int gte = e >> 12, d = (e >> 6) & 63, eo = e & 63;
                WT[gte * 4096 + eo * 64 + d] = (h16)(gte ? P.gate_x_w : P.gate_a_w)[n * 4096 + d * 64 + eo]; }
            LDS_WAIT(); __syncthreads(); n_loaded = n;
        }
        const size_t m0 = (size_t)b * T + ck * 128 + wave * 16;
        const int tloc = ck * 128 + wave * 16 + fr;
        h16x8 af[2];
        LAS3 float* XCF = (LAS3 float*)(lds + RL_XCF) + wave * (16 * 68);
#pragma unroll
        for (int s = 0; s < 2; ++s) {
            const int cb = n * 64 + 32 * s + 8 * fq;
            float xc[8];
            { const f32x4 b0 = *(const f32x4*)(P.conv_b + cb), b1 = *(const f32x4*)(P.conv_b + cb + 4);
              xc[0] = b0[0]; xc[1] = b0[1]; xc[2] = b0[2]; xc[3] = b0[3]; xc[4] = b1[0]; xc[5] = b1[1]; xc[6] = b1[2]; xc[7] = b1[3]; }
#pragma unroll
            for (int k = 0; k < 4; ++k) {
                h16x8 xv;
#pragma unroll
                for (int e = 0; e < 8; ++e) xv[e] = (h16)0.f;
                if (tloc - 3 + k >= 0) xv = *(const h16x8*)(XR + (m0 + fr - 3 + k) * 512 + cb);
                const f32x4 w0 = *(const f32x4*)(P.conv_w + k * 512 + cb), w1 = *(const f32x4*)(P.conv_w + k * 512 + cb + 4);
#pragma unroll
                for (int e = 0; e < 4; ++e) { xc[e] += w0[e] * (float)xv[e]; xc[4 + e] += w1[e] * (float)xv[4 + e]; }
            }
#pragma unroll
            for (int e = 0; e < 8; ++e) af[s][e] = (h16)xc[e];
            *(LAS3 f32x4*)(XCF + fr * 68 + 32 * s + 8 * fq) = (f32x4){xc[0], xc[1], xc[2], xc[3]};
            *(LAS3 f32x4*)(XCF + fr * 68 + 32 * s + 8 * fq + 4) = (f32x4){xc[4], xc[5], xc[6], xc[7]};
        }
        f32x4 ga[4], gx[4];
        { const LAS3 h16* WT = (const LAS3 h16*)(lds + RL_WT);
#pragma unroll
          for (int nt = 0; nt < 4; ++nt) {
              ga[nt] = (f32x4){0.f, 0.f, 0.f, 0.f}; gx[nt] = ga[nt];
#pragma unroll
              for (int s = 0; s < 2; ++s) {
                  const h16x8 ba_ = *(const LAS3 h16x8*)(WT + (16 * nt + fr) * 64 + 32 * s + 8 * fq);
                  const h16x8 bx_ = *(const LAS3 h16x8*)(WT + 4096 + (16 * nt + fr) * 64 + 32 * s + 8 * fq);
                  ga[nt] = __builtin_amdgcn_mfma_f32_16x16x32_f16(af[s], ba_, ga[nt], 0, 0, 0);
                  gx[nt] = __builtin_amdgcn_mfma_f32_16x16x32_f16(af[s], bx_, gx[nt], 0, 0, 0);
              }
          } }
        LDS_WAIT();
        float hl_[4][4], ac_[4][4], A4[4], H4[4];
#pragma unroll
        for (int nt = 0; nt < 4; ++nt) {
            const int ch = n * 64 + 16 * nt + fr;
            const float bav = P.gate_a_b[ch], bxv = P.gate_x_b[ch], sp8 = -8.0f * log1pf(__expf(-P.lru_lambda[ch]));
            float h = 0.f, A = 1.0f;
#pragma unroll
            for (int r = 0; r < 4; ++r) {
                const float xcv = XCF[(4 * fq + r) * 68 + 16 * nt + fr];
                const float rg = fsigmoid(ga[nt][r] + bav), ig = fsigmoid(gx[nt][r] + bxv);
                const float la = sp8 * rg, a = __builtin_amdgcn_exp2f(la * 1.4426950408889634f);
                const float x2 = 2.0f * la;
                const float poly = -x2 * (1.0f + x2 * (0.5f + x2 * (0.16666667f + x2 * (0.041666668f + x2 * (0.0083333338f + x2 * 0.0013888889f)))));
                const float em = (x2 > -0.25f) ? poly : (1.0f - a * a);
                const float bq = sqrtf(em) * (ig * xcv);
                h = a * h + bq; A *= a;
                hl_[nt][r] = h; ac_[nt][r] = A;
            }
            A4[nt] = A; H4[nt] = h;
        }
        float Ap[4], Hp[4], A16[4], H16[4];
#pragma unroll
        for (int nt = 0; nt < 4; ++nt) {
            float Aq = 1.0f, Hq = 0.f; Ap[nt] = 1.0f; Hp[nt] = 0.f;
#pragma unroll
            for (int q = 0; q < 4; ++q) {
                const float aq = __shfl(A4[nt], fr + 16 * q), hq = __shfl(H4[nt], fr + 16 * q);
                if (q == fq) { Ap[nt] = Aq; Hp[nt] = Hq; }
                Hq = aq * Hq + hq; Aq = aq * Aq;
            }
            A16[nt] = Aq; H16[nt] = Hq;
        }
        LAS3 float* AGW = (LAS3 float*)(lds + RL_AGW) + (it & 1) * (8 * 128);
        if (fq == 0) {
#pragma unroll
            for (int nt = 0; nt < 4; ++nt) { AGW[wave * 128 + 16 * nt + fr] = A16[nt]; AGW[wave * 128 + 64 + 16 * nt + fr] = H16[nt]; }
        }
        LDS_WAIT(); __syncthreads();
        LAS3 h16* TRS = (LAS3 h16*)(lds + RL_TRS) + wave * 1024;
        float S0[4], Apre[4];
#pragma unroll
        for (int nt = 0; nt < 4; ++nt) {
            float Aw = 1.0f, Hw = 0.f, At = 1.0f, Ht = 0.f;
#pragma unroll
            for (int w2 = 0; w2 < 8; ++w2) {
                const float aw = AGW[w2 * 128 + 16 * nt + fr], hw = AGW[w2 * 128 + 64 + 16 * nt + fr];
                if (w2 == wave) { Aw = At; Hw = Ht; }
                Ht = aw * Ht + hw; At = aw * At;
            }
            S0[nt] = Ap[nt] * Hw + Hp[nt]; Apre[nt] = Ap[nt] * Aw;
            if (wave == 0 && fq == 0) { float* ag = AGG + ((size_t)(b * 8 + n) * 32 + ck) * 128; ag[16 * nt + fr] = At; ag[64 + 16 * nt + fr] = Ht; }
        }
#pragma unroll
        for (int arr = 0; arr < 2; ++arr) {
            LDS_WAIT();
#pragma unroll
            for (int nt = 0; nt < 4; ++nt)
#pragma unroll
                for (int r = 0; r < 4; ++r) {
                    const float v = arr ? ac_[nt][r] * Apre[nt] : hl_[nt][r] + ac_[nt][r] * S0[nt];
                    TRS[(4 * fq + r) * 64 + 16 * nt + fr] = (h16)v; }
            LDS_WAIT();
            h16* dst = (arr ? AC : HL) + (m0 + (lane >> 2)) * 512 + n * 64 + (lane & 3) * 16;
            const h16x8 v0 = *(const LAS3 h16x8*)(TRS + (lane >> 2) * 64 + (lane & 3) * 16), v1 = *(const LAS3 h16x8*)(TRS + (lane >> 2) * 64 + (lane & 3) * 16 + 8);
            *(h16x8*)dst = v0; *(h16x8*)(dst + 8) = v1;
        }
    }
    __syncthreads();
}

__device__ __forceinline__ void rglru_fixup(const Params& P, int gw, int ngw, int lane) {
    unsigned char* ws = P.ws;
    const h16* HL = (const h16*)(ws + WS_HL); const h16* AC = (const h16*)(ws + WS_AC); const h16* GRG = (const h16*)(ws + WS_GRG);
    const float* AGG = (const float*)(ws + WS_AGG);
    h16* Y = (h16*)(ws + WS_Y); float* RSR = (float*)(ws + WS_SSR);
    for (int item = gw; item < 8 * 256; item += ngw) {
        const int seg = item & 255, b = item >> 8, ck = seg >> 3, n = lane >> 3, c8 = (lane & 7) * 8;
        const float* ag = AGG + ((size_t)(b * 8 + n) * 32) * 128 + c8;
        float carry[8];
#pragma unroll
        for (int e = 0; e < 8; ++e) carry[e] = 0.f;
        for (int c0 = 0; c0 < ck; c0 += 4) {
            f32x4 a_[4][2], h_[4][2];
#pragma unroll
            for (int u = 0; u < 4; ++u) { const int cc = min(c0 + u, ck - 1); const float* p = ag + (size_t)cc * 128;
                a_[u][0] = *(const f32x4*)p; a_[u][1] = *(const f32x4*)(p + 4); h_[u][0] = *(const f32x4*)(p + 64); h_[u][1] = *(const f32x4*)(p + 68); }
#pragma unroll
            for (int u = 0; u < 4; ++u) if (c0 + u < ck) {
#pragma unroll
                for (int e = 0; e < 8; ++e) carry[e] = a_[u][e >> 2][e & 3] * carry[e] + h_[u][e >> 2][e & 3]; }
        }
        const size_t mrow = (size_t)b * T + seg * 16;
        const int ch = n * 64 + c8;
#pragma unroll 4
        for (int tt = 0; tt < 16; ++tt) {
            const size_t m = mrow + tt;
            const h16x8 hv = *(const h16x8*)(HL + m * 512 + ch), av = *(const h16x8*)(AC + m * 512 + ch), gv = *(const h16x8*)(GRG + m * 512 + ch);
            h16x8 yo; float ss = 0.f;
#pragma unroll
            for (int e = 0; e < 8; ++e) { const float y = (float)gv[e] * ((float)hv[e] + (float)av[e] * carry[e]); yo[e] = (h16)y; ss += y * y; }
            *(h16x8*)(Y + m * 1024 + ch) = yo;
            ss = wave_sum(ss);
            if (lane == 0) RSR[m] = 1.0f / sqrtf(ss * (1.0f / 512.0f) + EPS);
        }
    }
}

__device__ __forceinline__ void compress_finish(const Params& P, int gw, int ngw, int lane) {
    unsigned char* ws = P.ws;
    const float* CR = (const float*)(ws + WS_CRAW); const float* ROPE = (const float*)(ws + WS_ROPE);
    h16* KCC = (h16*)(ws + WS_KCC); h16* VCC = (h16*)(ws + WS_VCC);
    for (int r = gw; r < 4096; r += ngw) {
        const int bg = r >> 8, c = r & 255, b = bg >> 1;
        float kv = CR[(size_t)r * 64 + lane], vv = CR[(size_t)(4096 + r) * 64 + lane];
        if (c == 255) { KCC[(size_t)r * 64 + lane] = (h16)0.f; VCC[(size_t)r * 64 + lane] = (h16)0.f; continue; }
        const float ss = wave_sum(kv * kv);
        kv = kv * (1.0f / sqrtf(ss * (1.0f / 64.0f) + EPS)) * P.k_norm_w[lane];
        const int mp = b * T + 16 * c + 31;
        const float other = __shfl_xor(kv, 8);
        float o = kv;
        if (lane < 8) o = kv * ROPE[mp * 16 + lane] - other * ROPE[mp * 16 + 8 + lane];
        else if (lane < 16) o = kv * ROPE[mp * 16 + lane - 8] + other * ROPE[mp * 16 + 8 + lane - 8];
        KCC[(size_t)r * 64 + lane] = (h16)o; VCC[(size_t)r * 64 + lane] = (h16)vv;
    }
}


constexpr int CU_H1 = 0;
constexpr int CU_O = 64 * 264 * 2;
constexpr int CU_END = CU_O + 64 * 68 * 4;
__device__ __forceinline__ void compress_unit(const Params& P, unsigned char* lds_g, int unit, int lane_in, int wave) {
    int lane = lane_in; asm volatile("" : "+v"(lane));
    unsigned char* ws = P.ws;
    LAS3 unsigned char* lds = (LAS3 unsigned char*)lds_g;
    const int fr = lane & 15, fq = lane >> 4, tid = wave * 64 + lane;
    const int which = unit >> 6, bg = (unit >> 2) & 15, rt = unit & 3, b = bg >> 1;
    const h16* A = (const h16*)(ws + (which ? WS_VCT : WS_KCT)) + ((size_t)bg * 4096 + 1024 * rt) * 64;
    const h16* W1 = (const h16*)(ws + (which ? WS_W1V : WS_W1K));
    const h16* W2 = (const h16*)(ws + (which ? WS_W2V : WS_W2K));
    const float* b1 = (const float*)(ws + WS_B1) + which * 256;
    f32x4 acc[4][2];
#pragma unroll
    for (int i = 0; i < 4; ++i) { acc[i][0] = (f32x4){0.f, 0.f, 0.f, 0.f}; acc[i][1] = acc[i][0]; }
    const h16* ap = A + (size_t)fr * 1024 + fq * 8;
    const h16* bp = W1 + (size_t)(32 * wave + fr) * CMPK + fq * 8;
    h16x8 a0[4], b0[2], a1[4], b1f[2];
#define CU_LOAD(a, bb, k0) do { _Pragma("unroll") for (int i = 0; i < 4; ++i) a[i] = *(const h16x8*)(ap + (size_t)i * 16 * 1024 + (k0)); \
        bb[0] = *(const h16x8*)(bp + (k0)); bb[1] = *(const h16x8*)(bp + (size_t)16 * CMPK + (k0)); } while (0)
#define CU_MMA(a, bb) do { _Pragma("unroll") for (int i = 0; i < 4; ++i) { acc[i][0] = __builtin_amdgcn_mfma_f32_16x16x32_f16(a[i], bb[0], acc[i][0], 0, 0, 0); \
        acc[i][1] = __builtin_amdgcn_mfma_f32_16x16x32_f16(a[i], bb[1], acc[i][1], 0, 0, 0); } } while (0)
    CU_LOAD(a0, b0, 0); CU_LOAD(a1, b1f, 32);
    for (int k0 = 0; k0 < CMPK; k0 += 64) {
        CU_MMA(a0, b0); if (k0 + 64 < CMPK) CU_LOAD(a0, b0, k0 + 64);
        CU_MMA(a1, b1f); if (k0 + 96 < CMPK) CU_LOAD(a1, b1f, k0 + 96);
    }
#undef CU_LOAD
#undef CU_MMA
    LAS3 h16* H1s = (LAS3 h16*)(lds + CU_H1); LAS3 float* Os = (LAS3 float*)(lds + CU_O);
#pragma unroll
    for (int j = 0; j < 2; ++j) { const int col = 32 * wave + 16 * j + fr; const float bv = b1[col];
#pragma unroll
        for (int i = 0; i < 4; ++i)
#pragma unroll
            for (int r = 0; r < 4; ++r) H1s[(16 * i + 4 * fq + r) * 264 + col] = (h16)fgelu_tanh(acc[i][j][r] + bv); }
    LDS_WAIT(); __syncthreads();
    {
        const int mi = wave & 3, nj0 = 2 * (wave >> 2);
        f32x4 o2[2] = {(f32x4){0.f, 0.f, 0.f, 0.f}, (f32x4){0.f, 0.f, 0.f, 0.f}};
#pragma unroll
        for (int ks = 0; ks < 8; ++ks) {
            const h16x8 af = *(const LAS3 h16x8*)(H1s + (16 * mi + fr) * 264 + 32 * ks + 8 * fq);
#pragma unroll
            for (int j = 0; j < 2; ++j) { const h16x8 bf = *(const h16x8*)(W2 + (size_t)(16 * (nj0 + j) + fr) * CMPH + 32 * ks + 8 * fq);
                o2[j] = __builtin_amdgcn_mfma_f32_16x16x32_f16(af, bf, o2[j], 0, 0, 0); }
        }
#pragma unroll
        for (int j = 0; j < 2; ++j)
#pragma unroll
            for (int r = 0; r < 4; ++r) Os[(16 * mi + 4 * fq + r) * 68 + 16 * (nj0 + j) + fr] = o2[j][r];
    }
    LDS_WAIT(); __syncthreads();
    {
        const int row = tid >> 3, sub = tid & 7, c = 64 * rt + row;
        const f32x4 v0 = *(const LAS3 f32x4*)(Os + row * 68 + 8 * sub), v1 = *(const LAS3 f32x4*)(Os + row * 68 + 8 * sub + 4);
        float v[8] = {v0[0], v0[1], v0[2], v0[3], v1[0], v1[1], v1[2], v1[3]};
        if (which == 0) {
            float ss = 0.f;
#pragma unroll
            for (int e = 0; e < 8; ++e) ss += v[e] * v[e];
            ss += __shfl_xor(ss, 1); ss += __shfl_xor(ss, 2); ss += __shfl_xor(ss, 4);
            const float rstd = 1.0f / sqrtf(ss * (1.0f / 64.0f) + EPS);
            const float* rp = (const float*)(ws + WS_ROPE) + ((size_t)b * T + 16 * min(c, 254) + 31) * 16;
#pragma unroll
            for (int e = 0; e < 8; ++e) v[e] = v[e] * rstd * P.k_norm_w[8 * sub + e];
#pragma unroll
            for (int e = 0; e < 8; ++e) { const float other = __shfl_xor(v[e], 1);
                if (sub == 0) v[e] = v[e] * rp[e] - other * rp[8 + e]; else if (sub == 1) v[e] = v[e] * rp[e] + other * rp[8 + e]; }
        }
        h16x8 o;
#pragma unroll
        for (int e = 0; e < 8; ++e) o[e] = (c == 255) ? (h16)0.f : (h16)v[e];
        *(h16x8*)((h16*)(ws + (which ? WS_VCC : WS_KCC)) + ((size_t)bg * 256 + c) * 64 + 8 * sub) = o;
    }
    __syncthreads();
}

__device__ __forceinline__ void qk4(const h16* krow, const float* qs, float (&s)[4]) {
    s[0] = s[1] = s[2] = s[3] = 0.f;
#pragma unroll
    for (int c = 0; c < 8; ++c) {
        const h16x8 k8 = *(const h16x8*)(krow + c * 8);
#pragma unroll
        for (int e = 0; e < 8; ++e) { const float kf = (float)k8[e];
#pragma unroll
            for (int h = 0; h < 4; ++h) s[h] += qs[h * 64 + c * 8 + e] * kf; }
    }
}
__device__ __forceinline__ void attn_group(const h16* Kb, const h16* Vb, int key, bool valid, int nk, const float* qs, float* ps,
                                           float (&mx)[4], float (&l)[4], float (&o)[4], int lane) {
    float s[4];
    qk4(Kb + (size_t)(valid ? key : 0) * 64, qs, s);
    float p[4];
#pragma unroll
    for (int h = 0; h < 4; ++h) {
        const float sv = valid ? s[h] : -INFINITY;
        const float mn = fmaxf(mx[h], wave_max(sv));
        const float f = exp2f(mx[h] - mn);
        p[h] = exp2f(sv - mn);
        l[h] = l[h] * f + wave_sum(p[h]); o[h] *= f; mx[h] = mn;
    }
    LDS_WAIT();
    *(f32x4*)(ps + lane * 4) = (f32x4){p[0], p[1], p[2], p[3]};
    LDS_WAIT();
    const int k0 = key - lane;
    for (int kk = 0; kk < nk; ++kk) {
        const float v = (float)Vb[(size_t)(k0 + kk) * 64 + lane];
        const f32x4 pv = *(const f32x4*)(ps + kk * 4);
        o[0] += pv.x * v; o[1] += pv.y * v; o[2] += pv.z * v; o[3] += pv.w * v;
    }
}
__device__ __forceinline__ void attn_naive(const Params& P, unsigned char* lds, int lane, int wave, int gw, int ngw) {
    unsigned char* ws = P.ws;
    float* qs = (float*)lds + wave * (256 + 1024);
    float* ps = qs + 256;
    const h16* QN = (const h16*)(ws + WS_Q);
    const h16* KCC = (const h16*)(ws + WS_KCC); const h16* VCC = (const h16*)(ws + WS_VCC);
    const h16* KS = (const h16*)(ws + WS_KS); const h16* VS = (const h16*)(ws + WS_VS);
    const h16* KW = (const h16*)(ws + WS_KW); const h16* VW = (const h16*)(ws + WS_VW);
    const float* GATE = (const float*)(ws + WS_GATE);
    h16* Y = (h16*)(ws + WS_Y); float* SSA = (float*)(ws + WS_SSA);
    for (int item = gw; item < M * 2; item += ngw) {
        const int g = item & 1, m = item >> 1, b = m >> 12, t = m & 4095, bg = b * 2 + g;
        LDS_WAIT();
#pragma unroll
        for (int h = 0; h < 4; ++h) qs[h * 64 + lane] = (float)QN[(size_t)m * 512 + (4 * g + h) * 64 + lane];
        LDS_WAIT();
        const int nvalid = (t >= 31) ? ((t - 31) >> 4) + 1 : 0;
        float sc[4][4];
#pragma unroll
        for (int i = 0; i < 4; ++i) {
            const int c = lane + 64 * i;
            float s[4]; qk4(KCC + ((size_t)bg * 256 + c) * 64, qs, s);
#pragma unroll
            for (int h = 0; h < 4; ++h) sc[i][h] = (c < nvalid) ? s[h] : -INFINITY;
        }
#pragma unroll
        for (int h = 0; h < 4; ++h) {
            float mxv = fmaxf(fmaxf(sc[0][h], sc[1][h]), fmaxf(sc[2][h], sc[3][h]));
            mxv = wave_max(mxv);
            if (!(mxv > -INFINITY)) mxv = 0.f;
            float ls = 0.f;
#pragma unroll
            for (int i = 0; i < 4; ++i) { sc[i][h] = exp2f(sc[i][h] - mxv); ls += sc[i][h]; }
            ls = wave_sum(ls);
            const float inv = 1.0f / fmaxf(ls, 1e-30f);
#pragma unroll
            for (int i = 0; i < 4; ++i) sc[i][h] *= inv;
        }
#pragma unroll
        for (int i = 0; i < 4; ++i) *(f32x4*)(ps + (lane + 64 * i) * 4) = (f32x4){sc[i][0], sc[i][1], sc[i][2], sc[i][3]};
        LDS_WAIT();
        float ocmp[4] = {0.f, 0.f, 0.f, 0.f};
        for (int c = 0; c < nvalid; ++c) {
            const float v = (float)VCC[((size_t)bg * 256 + c) * 64 + lane];
            const f32x4 pv = *(const f32x4*)(ps + c * 4);
            ocmp[0] += pv.x * v; ocmp[1] += pv.y * v; ocmp[2] += pv.z * v; ocmp[3] += pv.w * v;
        }
        float imp = 0.f;
        {
#pragma unroll
            for (int e = 0; e < 4; ++e) { const f32x4 pv = *(const f32x4*)(ps + (4 * lane + e) * 4); const float sh = (pv.x + pv.y) + (pv.z + pv.w); imp += (e == 3) ? 0.5f * sh : sh; }
            if (lane >= 1) { const f32x4 pv = *(const f32x4*)(ps + (4 * lane - 1) * 4); imp += 0.5f * ((pv.x + pv.y) + (pv.z + pv.w)); }
        }
        const int cur = t >> 6;
        const bool forced = (lane == 0) || (lane == cur) || (lane == cur - 1);
        const bool cand = !forced && lane < cur - 1;
        const int quota = 16 - (1 + (cur >= 1 ? 1 : 0) + (cur >= 2 ? 1 : 0));
        int rank = 0;
        for (int j2 = 0; j2 < 64; ++j2) {
            const float io = __shfl(imp, j2); const int co = __shfl((int)cand, j2);
            if (co && (io > imp || (io == imp && j2 < lane))) ++rank;
        }
        const bool sel = forced || (cand && rank < quota);
        unsigned long long mask = __ballot(sel);
        float mx[4] = {-INFINITY, -INFINITY, -INFINITY, -INFINITY}, ls[4] = {0.f, 0.f, 0.f, 0.f}, os[4] = {0.f, 0.f, 0.f, 0.f};
        while (mask) {
            const int j = __builtin_ctzll(mask); mask &= mask - 1;
            const int key = 64 * j + lane; const int nk = min(64, t - 64 * j + 1);
            attn_group(KS + (size_t)bg * T * 64, VS + (size_t)bg * T * 64, key, key <= t, nk, qs, ps, mx, ls, os, lane);
        }
        float mw[4] = {-INFINITY, -INFINITY, -INFINITY, -INFINITY}, lw[4] = {0.f, 0.f, 0.f, 0.f}, ow[4] = {0.f, 0.f, 0.f, 0.f};
        for (int k0 = max(0, t - 511); k0 <= t; k0 += 64) {
            const int key = k0 + lane; const int nk = min(64, t - k0 + 1);
            attn_group(KW + (size_t)bg * T * 64, VW + (size_t)bg * T * 64, key, key <= t, nk, qs, ps, mw, lw, ow, lane);
        }
        float ssq = 0.f;
#pragma unroll
        for (int h = 0; h < 4; ++h) {
            const float* gp = GATE + (size_t)m * 24 + (4 * g + h) * 3;
            const float o = gp[0] * ocmp[h] + gp[1] * os[h] / ls[h] + gp[2] * ow[h] / lw[h];
            Y[(size_t)m * 1024 + 512 + (4 * g + h) * 64 + lane] = (h16)o;
            ssq += o * o;
        }
        ssq = wave_sum(ssq);
        if (lane == 0) SSA[m * 2 + g] = ssq;
    }
}


typedef float f32x16 __attribute__((ext_vector_type(16)));
typedef short s16x4 __attribute__((ext_vector_type(4)));
constexpr int AT_KV = 0;
constexpr int AT_IMPH = 32768;
constexpr int AT_IMPS = AT_IMPH + 65536;
constexpr int AT_MASK = AT_IMPS + 16384;
constexpr int AT_WSF = AT_MASK + 512;
constexpr int AT_SSQ = AT_WSF + 2048;
constexpr int AT_STG = AT_SSQ + 1024;
constexpr int AT_END = AT_STG + 32768;
__device__ __forceinline__ int crow(int r, int hi) { return (r & 3) + 8 * (r >> 2) + 4 * hi; }
__device__ __forceinline__ float fexp2(float x) { return __builtin_amdgcn_exp2f(x); }

__device__ __forceinline__ void at_qkt(f32x16& p0, f32x16& p1, const LAS3 unsigned char* kb, const h16x8 (&qr)[4], float cinit, int r32, int hi) {
    const LAS3 unsigned char* kp = kb + hi * 1024 + r32 * 16;
#pragma unroll
    for (int r = 0; r < 16; ++r) p0[r] = cinit;
    p1 = p0;
#pragma unroll
    for (int d0 = 0; d0 < 4; ++d0) {
        const h16x8 b0 = *(const LAS3 h16x8*)(kp + d0 * 2048), b1 = *(const LAS3 h16x8*)(kp + d0 * 2048 + 512);
        p0 = __builtin_amdgcn_mfma_f32_32x32x16_f16(b0, qr[d0], p0, 0, 0, 0);
        p1 = __builtin_amdgcn_mfma_f32_32x32x16_f16(b1, qr[d0], p1, 0, 0, 0);
    }
}
__device__ __forceinline__ void at_mask(f32x16& p0, f32x16& p1, int lo, int hb, int hi) {
#pragma unroll
    for (int r = 0; r < 16; ++r) { const int kv = crow(r, hi);
        if (kv < lo || kv >= hb) p0[r] = -INFINITY;
        if (kv + 32 < lo || kv + 32 >= hb) p1[r] = -INFINITY; }
}
__device__ __forceinline__ float at_rowmax(const f32x16& p0, const f32x16& p1) {
    float a = __builtin_fmaxf(__builtin_fmaxf(p0[0], p0[1]), p1[0]), b = __builtin_fmaxf(__builtin_fmaxf(p0[2], p0[3]), p1[1]);
    a = __builtin_fmaxf(__builtin_fmaxf(a, p1[2]), p1[3]);
#pragma unroll
    for (int r = 4; r < 16; r += 4) { a = __builtin_fmaxf(__builtin_fmaxf(a, p0[r]), p0[r + 1]); b = __builtin_fmaxf(__builtin_fmaxf(b, p0[r + 2]), p0[r + 3]);
        a = __builtin_fmaxf(__builtin_fmaxf(a, p1[r]), p1[r + 1]); b = __builtin_fmaxf(__builtin_fmaxf(b, p1[r + 2]), p1[r + 3]); }
    a = __builtin_fmaxf(a, b);
    return __builtin_fmaxf(a, __shfl_xor(a, 32));
}
__device__ __forceinline__ h16x8 at_pack(const f32x16& p, int b) {
    typedef __fp16 fp16x2 __attribute__((ext_vector_type(2)));
    typedef unsigned u32x4_ __attribute__((ext_vector_type(4)));
    u32x4_ w;
#pragma unroll
    for (int j = 0; j < 4; ++j) { const fp16x2 h = __builtin_amdgcn_cvt_pkrtz(p[b + 2 * j], p[b + 2 * j + 1]); w[j] = __builtin_bit_cast(unsigned, h); }
    return __builtin_bit_cast(h16x8, w);
}
__device__ __forceinline__ void at_pv(f32x16& o0, f32x16& o1, const LAS3 unsigned char* vb, const f32x16& p0, const f32x16& p1, int lane, int hi) {
    const LAS3 unsigned char* vp = vb + ((lane >> 4) & 1) * 32 + (lane & 3) * 8 + (4 * hi + ((lane & 15) >> 2)) * 64;
    const h16x8 pw0 = at_pack(p0, 0), pw1 = at_pack(p0, 8), pw2 = at_pack(p1, 0), pw3 = at_pack(p1, 8);
#pragma unroll
    for (int dh = 0; dh < 2; ++dh) {
        h16x8 vf[4];
#pragma unroll
        for (int kg = 0; kg < 4; ++kg) {
            const s16x4 lo4 = __builtin_amdgcn_ds_read_tr16_b64_v4i16((LAS3 s16x4*)(vp + dh * 4096 + kg * 1024));
            const s16x4 hi4 = __builtin_amdgcn_ds_read_tr16_b64_v4i16((LAS3 s16x4*)(vp + dh * 4096 + kg * 1024 + 512));
            typedef short s16x8 __attribute__((ext_vector_type(8)));
            const s16x8 w = (s16x8){lo4[0], lo4[1], lo4[2], lo4[3], hi4[0], hi4[1], hi4[2], hi4[3]};
            vf[kg] = __builtin_bit_cast(h16x8, w);
        }
        f32x16& o = dh ? o1 : o0;
        o = __builtin_amdgcn_mfma_f32_32x32x16_f16(pw0, vf[0], o, 0, 0, 0);
        o = __builtin_amdgcn_mfma_f32_32x32x16_f16(pw1, vf[1], o, 0, 0, 0);
        o = __builtin_amdgcn_mfma_f32_32x32x16_f16(pw2, vf[2], o, 0, 0, 0);
        o = __builtin_amdgcn_mfma_f32_32x32x16_f16(pw3, vf[3], o, 0, 0, 0);
    }
}
__device__ __forceinline__ void at_scale_rows(f32x16& o0, f32x16& o1, float f, LAS3 float* wsf, int r32, int hi) {
    LDS_WAIT();
    if (hi == 0) wsf[r32] = f;
    LDS_WAIT();
#pragma unroll
    for (int r = 0; r < 16; ++r) { const float fr = wsf[crow(r, hi)]; o0[r] *= fr; o1[r] *= fr; }
}
__device__ __forceinline__ void at_step(f32x16& p0, f32x16& p1, f32x16& o0, f32x16& o1, float& m, float& l, const LAS3 unsigned char* vb, LAS3 float* wsf, int lane, int r32, int hi) {
    const float rm = at_rowmax(p0, p1);
    if (__any(rm > 0.f)) { const float dl = __builtin_fmaxf(rm, 0.f), f = fexp2(-dl); m += dl; l *= f;
#pragma unroll
        for (int r = 0; r < 16; ++r) { p0[r] -= dl; p1[r] -= dl; }
        at_scale_rows(o0, o1, f, wsf, r32, hi); }
    float s0 = 0.f, s1 = 0.f;
#pragma unroll
    for (int r = 0; r < 16; ++r) { p0[r] = fexp2(p0[r]); p1[r] = fexp2(p1[r]); s0 += p0[r]; s1 += p1[r]; }
    l += s0 + s1;
    at_pv(o0, o1, vb, p0, p1, lane, hi);
}

__device__ __forceinline__ void attn_unit(const Params& P, unsigned char* lds_g, int bg, int qb, int tid_in, int lane_in, int wave) {
    int lane = lane_in; asm volatile("" : "+v"(lane));
    const int tid = wave * 64 + lane; (void)tid_in;
    unsigned char* ws = P.ws;
    LAS3 unsigned char* lds = (LAS3 unsigned char*)lds_g;
    const int r32 = lane & 31, hi = lane >> 5, hl = wave >> 1, th = wave & 1;
    const int b = bg >> 1, g = bg & 1;
    const int tok = 32 * th + r32;
    const int t = 64 * qb + tok;
    const size_t m = (size_t)b * T + t;
    const h16* KCC = (const h16*)(ws + WS_KCC) + (size_t)bg * 256 * 64; const h16* VCC = (const h16*)(ws + WS_VCC) + (size_t)bg * 256 * 64;
    const h16* KS = (const h16*)(ws + WS_KS) + (size_t)bg * T * 64; const h16* VS = (const h16*)(ws + WS_VS) + (size_t)bg * T * 64;
    const h16* KW = (const h16*)(ws + WS_KW) + (size_t)bg * T * 64; const h16* VW = (const h16*)(ws + WS_VW) + (size_t)bg * T * 64;
    LAS3 float* wsf = (LAS3 float*)(lds + AT_WSF) + wave * 64;
    LAS3 float* IMPH = (LAS3 float*)(lds + AT_IMPH); LAS3 float* IMPS = (LAS3 float*)(lds + AT_IMPS);
    const int ntc = (4 * qb + 3 + 63) >> 6, nsl = qb + 1, nwn = min(qb + 1, 9), nt = 2 * ntc + nsl + nwn;
#define AT_KOFF (lane * 64 + wave * 8)
#define AT_VOFF ((16 * (wave & 3) + (lane >> 2)) * 64 + (wave >> 2) * 32 + (lane & 3) * 8)
#define AT_ISSUE(i) do { const int i_ = (i); const h16* ks_; const h16* vs_ = nullptr; int key0_; \
        if (i_ < ntc) { ks_ = KCC; key0_ = 64 * i_; } else if (i_ < 2 * ntc) { ks_ = KCC; vs_ = VCC; key0_ = 64 * (i_ - ntc); } \
        else if (i_ < 2 * ntc + nsl) { ks_ = KS; vs_ = VS; key0_ = 64 * (i_ - 2 * ntc); } else { ks_ = KW; vs_ = VW; key0_ = 64 * (qb - (i_ - 2 * ntc - nsl)); } \
        LAS3 unsigned char* dst_ = lds + AT_KV + (i_ & 1) * 16384 + wave * 1024; \
        __builtin_amdgcn_global_load_lds((const unsigned*)(ks_ + (size_t)key0_ * 64 + AT_KOFF), (LAS3 unsigned*)dst_, 16, 0, 0); \
        if (vs_) __builtin_amdgcn_global_load_lds((const unsigned*)(vs_ + (size_t)key0_ * 64 + AT_VOFF), (LAS3 unsigned*)(dst_ + 8192), 16, 0, 0); } while (0)
    AT_ISSUE(0);
    h16x8 qr[4];
    { const h16* qp = (const h16*)(ws + WS_Q) + m * 512 + (4 * g + hl) * 64 + hi * 8;
#pragma unroll
      for (int d0 = 0; d0 < 4; ++d0) qr[d0] = *(const h16x8*)(qp + d0 * 16); }
    float gt[3];
    { const float* gp = (const float*)(ws + WS_GATE) + m * 24 + (4 * g + hl) * 3; gt[0] = gp[0]; gt[1] = gp[1]; gt[2] = gp[2]; }
    const int nvalid = (t >= 31) ? ((t - 31) >> 4) + 1 : 0;
    f32x16 ot0, ot1, o0, o1;
#pragma unroll
    for (int r = 0; r < 16; ++r) { ot0[r] = 0.f; ot1[r] = 0.f; o0[r] = 0.f; o1[r] = 0.f; }
    float mx = 0.f, l = 0.f, cinv = 0.f, carry = 0.f;
    unsigned selw0 = 0u, selw1 = 0u;
    asm volatile("s_waitcnt vmcnt(0)" ::: "memory"); __syncthreads();
    const int lane_outer = lane, r32_outer = r32, hi_outer = hi, tok_outer = tok, tid_outer = tid;
    for (int i = 0; i < nt; ++i) {
        int lane = lane_outer; asm volatile("" : "+v"(lane));
        const int r32 = lane & 31, hi = lane >> 5, tok = 32 * th + r32, tid = wave * 64 + lane;
        if (i + 1 < nt) AT_ISSUE(i + 1);
        const LAS3 unsigned char* kb = lds + AT_KV + (i & 1) * 16384; const LAS3 unsigned char* vb = kb + 8192;
        f32x16 p0, p1;
        if (i < ntc) {
            const int nvl = nvalid - 64 * i;
            at_qkt(p0, p1, kb, qr, nvl > 0 ? -mx : -INFINITY, r32, hi);
            if (__any(nvl > 0 && nvl < 64)) at_mask(p0, p1, 0, nvl, hi);
            const float rm = at_rowmax(p0, p1);
            if (__any(rm > 0.f)) { const float dl = __builtin_fmaxf(rm, 0.f); mx += dl; l *= fexp2(-dl);
#pragma unroll
                for (int r = 0; r < 16; ++r) { p0[r] -= dl; p1[r] -= dl; } }
            float s = 0.f;
#pragma unroll
            for (int r = 0; r < 16; ++r) s += fexp2(p0[r]) + fexp2(p1[r]);
            l += s;
            if (i == ntc - 1) { const float lt = l + __shfl_xor(l, 32); cinv = 1.0f / fmaxf(lt, 1e-30f); }
        } else if (i < 2 * ntc) {
            const int tl = i - ntc, nvl = nvalid - 64 * tl;
            at_qkt(p0, p1, kb, qr, nvl > 0 ? -mx : -INFINITY, r32, hi);
            if (__any(nvl > 0 && nvl < 64)) at_mask(p0, p1, 0, nvl, hi);
#pragma unroll
            for (int r = 0; r < 16; ++r) { p0[r] = fexp2(p0[r]) * cinv; p1[r] = fexp2(p1[r]) * cinv; }
#pragma unroll
            for (int gq = 0; gq < 2; ++gq) {
                const f32x16& p = gq ? p1 : p0;
                float tot[4], x[4];
#pragma unroll
                for (int R = 0; R < 4; ++R) { const float sp = 0.5f * p[4 * R + 3]; tot[R] = (p[4 * R] + p[4 * R + 1]) + (p[4 * R + 2] + sp); x[R] = __shfl_xor(sp, 32); }
                if (hi) {
#pragma unroll
                    for (int R = 0; R < 4; ++R) tot[R] += x[R];
                } else { tot[0] += carry; tot[1] += x[0]; tot[2] += x[1]; tot[3] += x[2]; carry = x[3]; }
#pragma unroll
                for (int R = 0; R < 4; ++R) IMPH[(hl * 64 + 16 * tl + 8 * gq + 2 * R + hi) * 64 + tok] = tot[R];
            }
            at_pv(o0, o1, vb, p0, p1, lane, hi);
            if (i == 2 * ntc - 1) {
                at_scale_rows(o0, o1, gt[0], wsf, r32, hi);
#pragma unroll
                for (int r = 0; r < 16; ++r) { ot0[r] += o0[r]; ot1[r] += o1[r]; o0[r] = 0.f; o1[r] = 0.f; }
                mx = 0.f; l = 0.f;
                LDS_WAIT(); __syncthreads();
                { const int tk = tid & 63, part = tid >> 6;
                  float own[8];
#pragma unroll
                  for (int e = 0; e < 8; ++e) { const int j = 8 * part + e; float v = 0.f;
                      if (j < 16 * ntc) v = (IMPH[(0 * 64 + j) * 64 + tk] + IMPH[(1 * 64 + j) * 64 + tk]) + (IMPH[(2 * 64 + j) * 64 + tk] + IMPH[(3 * 64 + j) * 64 + tk]);
                      own[e] = v; IMPS[j * 64 + tk] = v; }
                  LDS_WAIT(); __syncthreads();
                  int rank[8];
#pragma unroll
                  for (int e = 0; e < 8; ++e) rank[e] = 0;
                  for (int j2 = 1; j2 <= qb - 2; ++j2) { const float v2 = IMPS[j2 * 64 + tk];
#pragma unroll
                      for (int e = 0; e < 8; ++e) { const int j = 8 * part + e; rank[e] += (v2 > own[e] || (v2 == own[e] && j2 < j)) ? 1 : 0; } }
                  const int quota = 16 - (1 + (qb >= 1 ? 1 : 0) + (qb >= 2 ? 1 : 0));
                  unsigned bits = 0u;
#pragma unroll
                  for (int e = 0; e < 8; ++e) { const int j = 8 * part + e; const bool forced = (j == 0) || (j == qb) || (j == qb - 1); const bool cand = !forced && j >= 1 && j <= qb - 2;
                      if (forced || (cand && rank[e] < quota)) bits |= 1u << e; }
                  ((LAS3 unsigned char*)(lds + AT_MASK))[tk * 8 + part] = (unsigned char)bits;
                  LDS_WAIT(); __syncthreads();
                  const LAS3 unsigned* mp = (const LAS3 unsigned*)(lds + AT_MASK) + tok * 2; selw0 = mp[0]; selw1 = mp[1]; }
            }
        } else if (i < 2 * ntc + nsl) {
            const int j = i - 2 * ntc;
            const bool sel = ((j < 32 ? (selw0 >> j) : (selw1 >> (j - 32))) & 1u) != 0u;
            at_qkt(p0, p1, kb, qr, sel ? -mx : -INFINITY, r32, hi);
            if (j == qb) at_mask(p0, p1, 0, tok + 1, hi);
            at_step(p0, p1, o0, o1, mx, l, vb, wsf, lane, r32, hi);
            if (j == qb) {
                const float lt = l + __shfl_xor(l, 32);
                at_scale_rows(o0, o1, gt[1] / lt, wsf, r32, hi);
#pragma unroll
                for (int r = 0; r < 16; ++r) { ot0[r] += o0[r]; ot1[r] += o1[r]; o0[r] = 0.f; o1[r] = 0.f; }
                mx = 0.f; l = 0.f;
            }
        } else {
            const int jj = i - 2 * ntc - nsl;
            at_qkt(p0, p1, kb, qr, -mx, r32, hi);
            if (jj == 0) at_mask(p0, p1, 0, tok + 1, hi);
            if (jj == 8) at_mask(p0, p1, tok + 1, 64, hi);
            at_step(p0, p1, o0, o1, mx, l, vb, wsf, lane, r32, hi);
            if (i == nt - 1) {
                const float lt = l + __shfl_xor(l, 32);
                at_scale_rows(o0, o1, gt[2] / lt, wsf, r32, hi);
#pragma unroll
                for (int r = 0; r < 16; ++r) { ot0[r] += o0[r]; ot1[r] += o1[r]; }
            }
        }
        asm volatile("s_waitcnt vmcnt(0)" ::: "memory"); __syncthreads();
    }
#undef AT_ISSUE
#undef AT_KOFF
#undef AT_VOFF
    (void)r32_outer; (void)hi_outer; (void)tok_outer; (void)tid_outer;
    LAS3 h16* stg = (LAS3 h16*)(lds + AT_STG) + wave * 2048;
#pragma unroll
    for (int r = 0; r < 16; ++r) { const int orow = crow(r, hi); stg[orow * 64 + r32] = (h16)ot0[r]; stg[orow * 64 + 32 + r32] = (h16)ot1[r]; }
    LDS_WAIT();
    LAS3 float* SSQ = (LAS3 float*)(lds + AT_SSQ);
    h16* Yb = (h16*)(ws + WS_Y) + ((size_t)b * T + 64 * qb + 32 * th) * 1024 + 512 + (4 * g + hl) * 64;
#pragma unroll
    for (int i2 = 0; i2 < 4; ++i2) { const int row = i2 * 8 + (lane >> 3), ch = lane & 7;
        const h16x8 v = *(const LAS3 h16x8*)(stg + row * 64 + ch * 8);
        *(h16x8*)(Yb + (size_t)row * 1024 + ch * 8) = v;
        float ss = 0.f;
#pragma unroll
        for (int e = 0; e < 8; ++e) { const float f = (float)v[e]; ss += f * f; }
        ss += __shfl_xor(ss, 1); ss += __shfl_xor(ss, 2); ss += __shfl_xor(ss, 4);
        if (ch == 0) SSQ[hl * 64 + 32 * th + row] = ss; }
    LDS_WAIT(); __syncthreads();
    if (tid < 64) ((float*)(ws + WS_SSA))[((size_t)b * T + 64 * qb + tid) * 2 + g] = (SSQ[tid] + SSQ[64 + tid]) + (SSQ[128 + tid] + SSQ[192 + tid]);
    __syncthreads();
}
__device__ __forceinline__ void attn_mfma_phase(const Params& P, unsigned char* lds, int tid, int lane, int wave, int bid, int nb) {
    const bool deal = (nb == 256);
    const int v = (bid & 7) * 32 + (bid >> 3);
    const int nu = deal ? 4 : (1024 - bid + nb - 1) / nb;
    for (int k = 0; k < nu; ++k) {
        int bg, qb;
        if (deal) { const int s = v & 15; bg = v >> 4; qb = (k == 0) ? 63 - s : (k == 1) ? 32 + s : (k == 2) ? 31 - s : s; }
        else { const int u = bid + k * nb; bg = u >> 6; qb = 63 - (u & 63); }
        attn_unit(P, lds, bg, qb, tid, lane, wave);
    }
}


#define XLAS __attribute__((address_space(3)))
#define XB_TMO      128
#define XB_XCNT(j)  (256  + 64 * (j))
#define XB_XSUB(j)  (1280 + 64 * (j))
#define XB_XGEN(j)  (2304 + 64 * (j))
#define XB_TOP      3328
#define XB_TOPGEN   3392
#define XCD_BAR_WORDS 3456
#define XB_SPIN_CAP (1u << 18)

__device__ __forceinline__ unsigned xb_ld(unsigned* p)              { return __hip_atomic_load(p, __ATOMIC_RELAXED, __HIP_MEMORY_SCOPE_AGENT); }
__device__ __forceinline__ unsigned xb_add(unsigned* p, unsigned v) { return __hip_atomic_fetch_add(p, v, __ATOMIC_RELAXED, __HIP_MEMORY_SCOPE_AGENT); }
__device__ __forceinline__ unsigned xb_xcc_id() { return (unsigned)__builtin_amdgcn_s_getreg((3 << 11) | 20) & 0xFu; }
#define XB_SPIN(cond, bar) do { unsigned _sp = 0; while (cond) { __builtin_amdgcn_s_sleep(1); \
    if ((++_sp & 255u) == 0u) { if (xb_ld(&(bar)[XB_TMO])) break; if (_sp > XB_SPIN_CAP) { atomicAdd(&(bar)[XB_TMO], 1u); break; } } } } while (0)

struct XcdBarrier {
    unsigned* bar; unsigned x;
    volatile XLAS unsigned* st;
};

__device__ __forceinline__ XcdBarrier xcd_barrier_post(unsigned* bar, volatile XLAS unsigned* st) {
    XcdBarrier b; b.bar = bar; b.x = xb_xcc_id(); b.st = st;
    if (threadIdx.x == 0) (void)xb_add(&bar[XB_XCNT(b.x)], 1u);
    return b;
}
__device__ __forceinline__ void xcd_barrier_complete(unsigned* bar, unsigned x, unsigned& nloc, unsigned& nx) {
    const unsigned G = gridDim.x * gridDim.y * gridDim.z;
    unsigned sum, cnt, mine, sp = 0u;
    for (;;) {
        sum = 0u; cnt = 0u; mine = 0u;
#pragma unroll
        for (unsigned j = 0; j < 16; ++j) { const unsigned c = xb_ld(&bar[XB_XCNT(j)]); sum += c; cnt += (c > 0u) ? 1u : 0u; mine = (j == x) ? c : mine; }
        if (sum == G) break;
        __builtin_amdgcn_s_sleep(1);
        if ((++sp & 255u) == 0u) { if (xb_ld(&bar[XB_TMO])) break; if (sp > XB_SPIN_CAP) { atomicAdd(&bar[XB_TMO], 1u); break; } }
    }
    nloc = mine > 0u ? mine : 1u; nx = cnt > 0u ? cnt : 1u;
}

__device__ __forceinline__ void xcd_barrier(const XcdBarrier& b) {
    asm volatile("s_waitcnt vmcnt(0)" ::: "memory");
    __syncthreads();
    if (threadIdx.x == 0) {
        unsigned* bar = b.bar;
        __builtin_amdgcn_s_waitcnt(0);
        unsigned nloc = b.st[0], nx = b.st[1];
        if (nloc == 0u) { xcd_barrier_complete(bar, b.x, nloc, nx); b.st[0] = nloc; b.st[1] = nx; }
        const unsigned old = xb_add(&bar[XB_XSUB(b.x)], 1u);
        const unsigned gen = old / nloc;
        if (old + 1u == (gen + 1u) * nloc) {
            __builtin_amdgcn_fence(__ATOMIC_RELEASE, "agent");
            asm volatile("s_waitcnt vmcnt(0)" ::: "memory");
            const unsigned og = xb_add(&bar[XB_TOP], 1u);
            const unsigned tg = og / nx;
            if (og + 1u == (tg + 1u) * nx) xb_add(&bar[XB_TOPGEN], 1u);
            else XB_SPIN(xb_ld(&bar[XB_TOPGEN]) == tg, bar);
            __builtin_amdgcn_fence(__ATOMIC_ACQUIRE, "agent");
            xb_add(&bar[XB_XGEN(b.x)], 1u);
            asm volatile("s_waitcnt vmcnt(0)" ::: "memory");
        } else {
            XB_SPIN(xb_ld(&bar[XB_XGEN(b.x)]) == gen, bar);
            __builtin_amdgcn_fence(__ATOMIC_ACQUIRE, "agent");
            asm volatile("s_waitcnt vmcnt(0)" ::: "memory");
        }
    }
    __syncthreads();
}

#ifndef PHMASK
#define PHMASK 0x7f
#endif
constexpr int NPHASE = 7;
#ifndef FAST_GEMM
#define FAST_GEMM 7
#endif
#ifndef FAST_ATTN
#define FAST_ATTN 1
#endif
#ifndef DUPMASK
#define DUPMASK 0
#endif
#define REP(bit) for (int rep_ = 0; rep_ < ((DUPMASK >> (bit)) & 1) + 1; ++rep_)
constexpr int LDS_BYTES = 155648, LDS_MISC = LDS_BYTES - 64;
static_assert(RL_END <= LDS_MISC && CU_END <= LDS_MISC && AT_END <= LDS_MISC && pg8::STAGE_BYTES <= LDS_BYTES, "LDS map");
__global__ void __launch_bounds__(NTHREADS, 2) hymba_fwd(Params P) {
    extern __shared__ __attribute__((aligned(16))) unsigned char lds[];
    cg::grid_group grid = cg::this_grid();
    const int tid = threadIdx.x, lane = tid & 63, wave = __builtin_amdgcn_readfirstlane(tid >> 6);
    const int bid = blockIdx.x, nb = gridDim.x;
    const int gw = bid * NWAVES + wave, ngw = nb * NWAVES;
    unsigned char* ws = P.ws;
    const int lo = P.ph_lo, hi = P.ph_hi;
    volatile XLAS unsigned* misc = (volatile XLAS unsigned*)((XLAS unsigned char*)lds + LDS_MISC);
    if (tid < 16) misc[tid] = 0u;
    __syncthreads();
    XcdBarrier bar = xcd_barrier_post((unsigned*)(ws + WS_CTL), misc);
    if (hi < 0) grid.sync();
#define PH_BEGIN(k) if (lo <= (k) && (k) < hi) { if ((k) > lo) xcd_barrier(bar);
#define PH_END }
#if PHMASK & (1 << 0)
        PH_BEGIN(0) REP(0) phase0(P, lds, tid, lane, wave, bid, nb); PH_END
#endif
#if PHMASK & (1 << 1)
        PH_BEGIN(1) {
#if FAST_GEMM & 1
            {
            pg8::Gemm g{(const pg8::bf16_t*)(ws + WS_XH), (const pg8::bf16_t*)(ws + WS_WIN), M, NP1, 1024}; pg8::StaticOrder S; S.init(M, NP1, nb, bid);
            pg8::gemm_phase<EpiProjF, pg8::StaticOrder, true, true>((PG8_LAS unsigned char*)lds, g, S, EpiProjF{ws});
            }
#if (DUPMASK >> 1) & 1
            {
            pg8::Gemm g{(const pg8::bf16_t*)(ws + WS_XH), (const pg8::bf16_t*)(ws + WS_WIN), M, NP1, 1024}; pg8::StaticOrder S; S.init(M, NP1, nb, bid);
            pg8::gemm_phase<EpiProjF, pg8::StaticOrder, true, true>((PG8_LAS unsigned char*)lds, g, S, EpiProjF{ws});
            }
#endif
#else
            GemmN g{(const h16*)(ws + WS_XH), 1024, (const h16*)(ws + WS_WIN), 1024, 1024, nullptr, 0, nullptr, 0, 0, M, NP1, 0};
            gemm_naive<false>(g, EpiProj{ws}, gw, ngw, lane);
#endif
        } PH_END
#endif
#if PHMASK & (1 << 2)
        PH_BEGIN(2) {
            normrope_rows(P, gw, ngw, lane);
            REP(2) rglru_local(P, lds, tid, lane, wave, bid, nb);
            REP(3) for (int u = (bid + nb / 2) % nb; u < 128; u += nb) compress_unit(P, lds, u, lane, wave);
        } PH_END
#endif
#if PHMASK & (1 << 3)
        PH_BEGIN(3) {
            REP(5) rglru_fixup(P, gw, ngw, lane);
#if FAST_ATTN
            REP(6) attn_mfma_phase(P, lds, tid, lane, wave, bid, nb);
#else
            attn_naive(P, lds, lane, wave, gw, ngw);
#endif
        } PH_END
#endif
#if PHMASK & (1 << 4)
        PH_BEGIN(4) {
#if FAST_GEMM & 2
            {
            pg8::Gemm g{(const pg8::bf16_t*)(ws + WS_Y), (const pg8::bf16_t*)(ws + WS_WOUT), M, D, 1024}; pg8::StaticOrder S; S.init(M, D, nb, bid);
            pg8::gemm_phase<EpiOutF, pg8::StaticOrder, true, true>((PG8_LAS unsigned char*)lds, g, S,
                EpiOutF{P.x, P.out, (h16*)(ws + WS_X1H), (const float*)(ws + WS_SSR), (const float*)(ws + WS_SSA), (float*)(ws + WS_SS2P)});
            }
#if (DUPMASK >> 7) & 1
            {
            pg8::Gemm g{(const pg8::bf16_t*)(ws + WS_Y), (const pg8::bf16_t*)(ws + WS_WOUT), M, D, 1024}; pg8::StaticOrder S; S.init(M, D, nb, bid);
            pg8::gemm_phase<EpiOutF, pg8::StaticOrder, true, true>((PG8_LAS unsigned char*)lds, g, S,
                EpiOutF{P.x, P.out, (h16*)(ws + WS_X1H), (const float*)(ws + WS_SSR), (const float*)(ws + WS_SSA), (float*)(ws + WS_SS2P)});
            }
#endif
#else
            const h16* Y = (const h16*)(ws + WS_Y); const h16* W = (const h16*)(ws + WS_WOUT);
            GemmN g{Y, 1024, W, 1024, 512, Y + 512, 1024, W + 512, 1024, 512, M, D, 0};
            gemm_naive<true>(g, EpiOut{P.x, P.out, (h16*)(ws + WS_X1H), (const float*)(ws + WS_SSR), (const float*)(ws + WS_SSA)}, gw, ngw, lane);
#endif
        } PH_END
#endif
#if PHMASK & (1 << 5)
        PH_BEGIN(5) {
#if FAST_GEMM & 2
            REP(8) {
            pg8::Gemm g{(const pg8::bf16_t*)(ws + WS_X1H), (const pg8::bf16_t*)(ws + WS_WGU), M, 2 * DFF, 1024}; pg8::StaticOrder S; S.init(M, 2 * DFF, nb, bid);
            pg8::gemm_phase<EpiGUF, pg8::StaticOrder, true, true>((PG8_LAS unsigned char*)lds, g, S, EpiGUF{(h16*)(ws + WS_HM), (const float*)(ws + WS_SS2P)});
            }
#else
            const h16* A = (const h16*)(ws + WS_X1H); const h16* W = (const h16*)(ws + WS_WGU);
            GemmN g{A, 1024, W, 1024, 1024, A, 1024, W, 1024, 1024, M, DFF, 1};
            gemm_naive<true>(g, EpiGU{(h16*)(ws + WS_HM), (const float*)(ws + WS_RSTD2)}, gw, ngw, lane);
#endif
        } PH_END
#endif
#if PHMASK & (1 << 6)
        PH_BEGIN(6) {
#if FAST_GEMM & 4
            pg8::Gemm g{(const pg8::bf16_t*)(ws + WS_HM), (const pg8::bf16_t*)(ws + WS_WD), M, D, DFF}; pg8::StaticOrder S; S.init(M, D, nb, bid);
            pg8::gemm_phase<EpiDownF, pg8::StaticOrder, true, true>((PG8_LAS unsigned char*)lds, g, S, EpiDownF{P.out});
#else
            GemmN g{(const h16*)(ws + WS_HM), DFF, (const h16*)(ws + WS_WD), DFF, DFF, nullptr, 0, nullptr, 0, 0, M, D, 0};
            gemm_naive<false>(g, EpiDown{P.out}, gw, ngw, lane);
#endif
        } PH_END
#endif
}

#ifndef N_LAUNCH_PER_PHASE
#define N_LAUNCH_PER_PHASE 0
#endif
extern "C" void kernel_launch(void* const* d_in, const int* in_sizes, int n_in, void* d_out, int out_size, void* d_ws, size_t ws_size, hipStream_t stream) {
    static int grid = 0;
    if (grid == 0) {
        if (n_in != 25 || in_sizes[0] != M * D || out_size != M * D || ws_size < WS_END) {
            fprintf(stderr, "kernel_launch: unexpected problem (n_in %d, in0 %d, out %d, ws %zu)\n", n_in, n_in > 0 ? in_sizes[0] : -1, out_size, ws_size); grid = -1; return; }
        int dev = 0, cus = 0, per_cu = 0;
        hipGetDevice(&dev);
        hipDeviceGetAttribute(&cus, hipDeviceAttributeMultiprocessorCount, dev);
        hipFuncSetAttribute((const void*)hymba_fwd, hipFuncAttributeMaxDynamicSharedMemorySize, LDS_BYTES);
        hipOccupancyMaxActiveBlocksPerMultiprocessor(&per_cu, (const void*)hymba_fwd, NTHREADS, LDS_BYTES);
        if (per_cu < 1) { fprintf(stderr, "kernel_launch: occupancy query says %d blocks per CU\n", per_cu); grid = -1; return; }
        grid = cus;
    }
    if (grid < 0) return;
    if (hipMemsetAsync((char*)d_ws + WS_CTL, 0, CTL_BYTES, stream) != hipSuccess) { fprintf(stderr, "kernel_launch: memset failed\n"); return; }
    Params p{};
    const float** pf = (const float**)&p;
    for (int i = 0; i < 25; ++i) pf[i] = (const float*)d_in[i];
    p.out = (float*)d_out; p.ws = (unsigned char*)d_ws;
#if N_LAUNCH_PER_PHASE
    for (int ph = 0; ph < NPHASE; ++ph) {
        p.ph_lo = ph; p.ph_hi = ph + 1;
        void* args[] = {&p};
        hipError_t e = hipLaunchCooperativeKernel((const void*)hymba_fwd, dim3(grid), dim3(NTHREADS), args, LDS_BYTES, stream);
        if (e != hipSuccess) { fprintf(stderr, "launch failed: %s\n", hipGetErrorString(e)); return; }
    }
#else
    p.ph_lo = 0; p.ph_hi = NPHASE;
    void* args[] = {&p};
    hipError_t e = hipLaunchCooperativeKernel((const void*)hymba_fwd, dim3(grid), dim3(NTHREADS), args, LDS_BYTES, stream);
    if (e != hipSuccess) fprintf(stderr, "launch failed: %s\n", hipGetErrorString(e));
#endif
}
```
